# Optimizing an MI355X kernel written in HIP

```python
import math
import jax, jax.numpy as jnp
from jax import lax
import numpy as np

D_MODEL = 4096
BATCH = 2
SEQ = 8192
DEPTH = 2

D_MIX = D_MODEL
HEAD_DIM = 128
ATTN_GROUPS = ((128, 1), (512, 4), (2048, 16))
ATTN_HEADS_PER_GROUP = 4
ATTN_HEADS = ATTN_HEADS_PER_GROUP * len(ATTN_GROUPS)
D_ATTN = ATTN_HEADS * HEAD_DIM
ATTN_BLOCK = 128
ROPE_THETA = 500000.0
ROPE_DIM = HEAD_DIM // 4
D_SSM = 1536
SSM_HEAD_DIM = 64
SSM_HEADS = D_SSM // SSM_HEAD_DIM
SSM_GROUPS = 4
SSM_STATE = 128
SSM_CONV = 4
SSM_CHUNK = 128
D_XBC = D_SSM + 2 * SSM_GROUPS * SSM_STATE
D_SC = D_MIX - D_ATTN - D_SSM
SC_CONV = 3
D_IN = 3 * D_ATTN + D_SSM + D_XBC + SSM_HEADS + 3 * D_SC
D_FF = 4 * D_MODEL
D_PLE = 256
DN_ALPHA = (2.0 * DEPTH) ** 0.25
DN_BETA = (8.0 * DEPTH) ** -0.25
LN_EPS = 1e-5
RMS_EPS = 1e-5

kernel_name = 'hymba_ssd_shortconv_dilated_attn_deepnorm'


def layer_norm(x, g, b):
    xf = x.astype(jnp.float32)
    mu = jnp.mean(xf, axis=-1, keepdims=True)
    var = jnp.mean(jnp.square(xf - mu), axis=-1, keepdims=True)
    return ((xf - mu) * lax.rsqrt(var + LN_EPS) * g.astype(jnp.float32) + b.astype(jnp.float32)).astype(x.dtype)


def causal_dwconv(x, w, b=None):
    k_len, ch = w.shape
    y = lax.conv_general_dilated(x, w[:, None, :].astype(x.dtype), window_strides=(1,),
                                 padding=[(k_len - 1, 0)],
                                 dimension_numbers=('NWC', 'WIO', 'NWC'),
                                 feature_group_count=ch)
    if b is not None:
        y = y + b.astype(x.dtype)
    return y


def split_projection(u):
    sizes = (D_ATTN, D_ATTN, D_ATTN, D_SSM, D_XBC, SSM_HEADS, D_SC, D_SC, D_SC)
    offs = []
    acc = 0
    for s in sizes[:-1]:
        acc += s
        offs.append(acc)
    return jnp.split(u, offs, axis=-1)


def partial_rope(x, pos):
    half = ROPE_DIM // 2
    inv_freq = ROPE_THETA ** (-jnp.arange(half, dtype=jnp.float32) / half)
    ang = pos.astype(jnp.float32)[:, None] * inv_freq[None, :]
    cos = jnp.cos(ang)[None, :, None, :]
    sin = jnp.sin(ang)[None, :, None, :]
    x1 = x[..., :half].astype(jnp.float32)
    x2 = x[..., half:ROPE_DIM].astype(jnp.float32)
    rot = jnp.concatenate([x1 * cos - x2 * sin, x2 * cos + x1 * sin], axis=-1).astype(x.dtype)
    return jnp.concatenate([rot, x[..., ROPE_DIM:]], axis=-1)


def dilated_window_attention(q, k, v, window, dilation):
    bsz, s_len, n_h, d_h = q.shape
    n_back = window // dilation
    blk = ATTN_BLOCK
    assert n_back <= blk
    span = dilation * blk
    s_pad = -(-s_len // span) * span
    sub_len = s_pad // dilation
    n_blk = sub_len // blk

    def to_blocks(t):
        t = jnp.pad(t, ((0, 0), (0, s_pad - s_len), (0, 0), (0, 0)))
        t = t.reshape(bsz, sub_len, dilation, n_h, d_h).swapaxes(1, 2)
        return t.reshape(bsz, dilation, n_blk, blk, n_h, d_h)

    def with_prev(t):
        prev = jnp.pad(t, ((0, 0), (0, 0), (1, 0), (0, 0), (0, 0), (0, 0)))[:, :, :-1]
        return jnp.concatenate([prev, t], axis=3)

    qb = to_blocks(q)
    kb = with_prev(to_blocks(k))
    vb = with_prev(to_blocks(v))
    scores = jnp.einsum('brnqhd,brnkhd->brnhqk', qb, kb,
                        preferred_element_type=jnp.float32) * (d_h ** -0.5)
    qi = jnp.arange(blk)[:, None]
    ki = jnp.arange(2 * blk)[None, :]
    dist = blk + qi - ki
    first = jnp.arange(n_blk)[:, None, None] == 0
    valid = (dist >= 0) & (dist <= n_back) & ~(first & (ki < blk))
    scores = jnp.where(valid[None, None, :, None], scores, -jnp.inf)
    m = jnp.max(scores, axis=-1, keepdims=True)
    w = jnp.exp(scores - m)
    den = jnp.sum(w, axis=-1, keepdims=True)
    o = jnp.einsum('brnhqk,brnkhd->brnqhd', w, vb.astype(jnp.float32)) / jnp.swapaxes(den, 3, 4)
    lse = jnp.swapaxes((m + jnp.log(den))[..., 0], 3, 4)

    def from_blocks(t):
        rest = t.shape[4:]
        t = t.reshape(bsz, dilation, sub_len, *rest).swapaxes(1, 2)
        return t.reshape(bsz, s_pad, *rest)[:, :s_len]

    return from_blocks(o).astype(q.dtype), from_blocks(lse)


def dilated_attention_mixer(q, k, v, pos):
    bsz, s_len, _ = q.shape
    q = partial_rope(q.reshape(bsz, s_len, ATTN_HEADS, HEAD_DIM), pos)
    k = partial_rope(k.reshape(bsz, s_len, ATTN_HEADS, HEAD_DIM), pos)
    v = v.reshape(bsz, s_len, ATTN_HEADS, HEAD_DIM)
    outs, lses = [], []
    for g, (window, dil) in enumerate(ATTN_GROUPS):
        hs = slice(g * ATTN_HEADS_PER_GROUP, (g + 1) * ATTN_HEADS_PER_GROUP)
        o, l = dilated_window_attention(q[:, :, hs], k[:, :, hs], v[:, :, hs], window, dil)
        outs.append(o)
        lses.append(l)
    mix_w = jax.nn.softmax(jnp.stack(lses, axis=2), axis=2)
    o = jnp.stack(outs, axis=2).astype(jnp.float32) * mix_w[..., None]
    return o.reshape(bsz, s_len, D_ATTN).astype(q.dtype)


def ssd_chunked(x, dt, a, b_in, c_in):
    bsz, s_len, n_h, hd = x.shape
    n_g, n_s = b_in.shape[2], b_in.shape[3]
    hpg = n_h // n_g
    q_len = SSM_CHUNK
    n_c = s_len // q_len
    xdt = (x.astype(jnp.float32) * dt[..., None]).reshape(bsz, n_c, q_len, n_g, hpg, hd)
    adt = (dt * a).reshape(bsz, n_c, q_len, n_g, hpg)
    bc = b_in.astype(jnp.float32).reshape(bsz, n_c, q_len, n_g, n_s)
    cc = c_in.astype(jnp.float32).reshape(bsz, n_c, q_len, n_g, n_s)
    a_cs = jnp.cumsum(adt, axis=2)
    seg = a_cs[:, :, :, None] - a_cs[:, :, None, :]
    causal = jnp.tril(jnp.ones((q_len, q_len), dtype=bool))[:, :, None, None]
    decay = jnp.exp(jnp.where(causal, seg, -jnp.inf))
    cb = jnp.einsum('bclgn,bcsgn->bclsg', cc, bc)
    y_diag = jnp.einsum('bclsg,bclsgj,bcsgjp->bclgjp', cb, decay, xdt)
    decay_to_end = jnp.exp(a_cs[:, :, -1:] - a_cs)
    states = jnp.einsum('bcsgn,bcsgj,bcsgjp->bcgjpn', bc, decay_to_end, xdt)
    chunk_decay = jnp.exp(a_cs[:, :, -1])

    def step(h, inp):
        st, dec = inp
        return h * dec[..., None, None] + st, h

    h0 = jnp.zeros((bsz, n_g, hpg, hd, n_s), jnp.float32)
    _, prev = lax.scan(step, h0, (states.swapaxes(0, 1), chunk_decay.swapaxes(0, 1)))
    prev = prev.swapaxes(0, 1)
    y_off = jnp.einsum('bclgn,bcgjpn,bclgj->bclgjp', cc, prev, jnp.exp(a_cs))
    return (y_diag + y_off).reshape(bsz, s_len, n_h, hd)


def ssd_mixer(z, xbc, dt_raw, conv_w, conv_b, dt_bias, a_log, d_skip, norm_w):
    bsz, s_len, _ = z.shape
    xbc = jax.nn.silu(causal_dwconv(xbc, conv_w, conv_b))
    xs, bs, cs = jnp.split(xbc, [D_SSM, D_SSM + SSM_GROUPS * SSM_STATE], axis=-1)
    xs = xs.reshape(bsz, s_len, SSM_HEADS, SSM_HEAD_DIM)
    bs = bs.reshape(bsz, s_len, SSM_GROUPS, SSM_STATE)
    cs = cs.reshape(bsz, s_len, SSM_GROUPS, SSM_STATE)
    dt = jax.nn.softplus(dt_raw.astype(jnp.float32) + dt_bias.astype(jnp.float32))
    a = -jnp.exp(a_log.astype(jnp.float32))
    y = ssd_chunked(xs, dt, a, bs, cs) + d_skip.astype(jnp.float32)[:, None] * xs.astype(jnp.float32)
    y = y.reshape(bsz, s_len, D_SSM) * jax.nn.silu(z.astype(jnp.float32))
    yg = y.reshape(bsz, s_len, SSM_GROUPS, D_SSM // SSM_GROUPS)
    yg = yg * lax.rsqrt(jnp.mean(jnp.square(yg), axis=-1, keepdims=True) + RMS_EPS)
    return (yg.reshape(bsz, s_len, D_SSM) * norm_w.astype(jnp.float32)).astype(z.dtype)


def short_conv_mixer(b_gate, c_gate, h, conv_w):
    return b_gate * causal_dwconv(c_gate * h, conv_w)


def setup_inputs(seed: int = 0) -> dict:
    key = jax.random.key(seed)
    ks = jax.random.split(key, 24)
    f32 = jnp.float32
    nrm = lambda k, shape, scale: jax.random.normal(k, shape, f32) * scale
    x = nrm(ks[0], (BATCH, SEQ, D_MODEL), 1.0)
    p = nrm(ks[1], (DEPTH, BATCH, SEQ, D_PLE), 1.0)
    w_in = nrm(ks[2], (DEPTH, D_MODEL, D_IN), D_MODEL ** -0.5)
    ssm_conv_w = nrm(ks[3], (DEPTH, SSM_CONV, D_XBC), SSM_CONV ** -0.5)
    ssm_conv_b = nrm(ks[4], (DEPTH, D_XBC), 0.02)
    dt0 = jnp.exp(jax.random.uniform(ks[5], (DEPTH, SSM_HEADS), f32,
                                     minval=math.log(1e-3), maxval=math.log(1e-1)))
    ssm_dt_bias = dt0 + jnp.log(-jnp.expm1(-dt0))
    ssm_a_log = jnp.log(jax.random.uniform(ks[6], (DEPTH, SSM_HEADS), f32, minval=1.0, maxval=16.0))
    ssm_d = 1.0 + nrm(ks[7], (DEPTH, SSM_HEADS), 0.1)
    ssm_norm_w = 1.0 + nrm(ks[8], (DEPTH, D_SSM), 0.1)
    sc_conv_w = nrm(ks[9], (DEPTH, SC_CONV, D_SC), SC_CONV ** -0.5)
    w_out = nrm(ks[10], (DEPTH, D_MIX, D_MODEL), DN_BETA * D_MIX ** -0.5)
    ln1_g = 1.0 + nrm(ks[11], (DEPTH, D_MODEL), 0.05)
    ln1_b = nrm(ks[12], (DEPTH, D_MODEL), 0.02)
    w_up = nrm(ks[13], (DEPTH, D_MODEL, D_FF), D_MODEL ** -0.5)
    w_down = nrm(ks[14], (DEPTH, D_FF, D_MODEL), DN_BETA * D_FF ** -0.5)
    ln2_g = 1.0 + nrm(ks[15], (DEPTH, D_MODEL), 0.05)
    ln2_b = nrm(ks[16], (DEPTH, D_MODEL), 0.02)
    w_pe = nrm(ks[17], (DEPTH, D_PLE, D_MODEL), DN_BETA * D_PLE ** -0.5)
    w_gate = nrm(ks[18], (DEPTH, D_MODEL, D_MODEL), D_MODEL ** -0.5)
    ln3_g = 1.0 + nrm(ks[19], (DEPTH, D_MODEL), 0.05)
    ln3_b = nrm(ks[20], (DEPTH, D_MODEL), 0.02)
    return {'x': x, 'p': p, 'w_in': w_in, 'ssm_conv_w': ssm_conv_w, 'ssm_conv_b': ssm_conv_b,
            'ssm_dt_bias': ssm_dt_bias, 'ssm_a_log': ssm_a_log, 'ssm_d': ssm_d,
            'ssm_norm_w': ssm_norm_w, 'sc_conv_w': sc_conv_w, 'w_out': w_out,
            'ln1_g': ln1_g, 'ln1_b': ln1_b, 'w_up': w_up, 'w_down': w_down,
            'ln2_g': ln2_g, 'ln2_b': ln2_b, 'w_pe': w_pe, 'w_gate': w_gate,
            'ln3_g': ln3_g, 'ln3_b': ln3_b}


def reference(x, p, w_in, ssm_conv_w, ssm_conv_b, ssm_dt_bias, ssm_a_log, ssm_d, ssm_norm_w,
              sc_conv_w, w_out, ln1_g, ln1_b, w_up, w_down, ln2_g, ln2_b, w_pe, w_gate,
              ln3_g, ln3_b):
    s_len = x.shape[1]
    pos = jnp.arange(s_len, dtype=jnp.int32)
    for i in range(DEPTH):
        u = jnp.einsum('bsd,de->bse', x, w_in[i])
        q, k, v, z, xbc, dt_raw, sc_b, sc_c, sc_h = split_projection(u)
        y_attn = dilated_attention_mixer(q, k, v, pos)
        y_ssm = ssd_mixer(z, xbc, dt_raw, ssm_conv_w[i], ssm_conv_b[i], ssm_dt_bias[i],
                          ssm_a_log[i], ssm_d[i], ssm_norm_w[i])
        y_sc = short_conv_mixer(sc_b, sc_c, sc_h, sc_conv_w[i])
        mixed = jnp.einsum('bse,ed->bsd', jnp.concatenate([y_attn, y_ssm, y_sc], axis=-1), w_out[i])
        x = layer_norm(DN_ALPHA * x + mixed, ln1_g[i], ln1_b[i])
        hid = jnp.square(jax.nn.relu(jnp.einsum('bsd,df->bsf', x, w_up[i])))
        x = layer_norm(DN_ALPHA * x + jnp.einsum('bsf,fd->bsd', hid, w_down[i]), ln2_g[i], ln2_b[i])
        gate = jax.nn.sigmoid(jnp.einsum('bsd,de->bse', x, w_gate[i]))
        emb = jnp.einsum('bsk,kd->bsd', p[i], w_pe[i])
        x = layer_norm(DN_ALPHA * x + gate * emb, ln3_g[i], ln3_b[i])
    return x
```

```cpp
#ifndef EMU
#include <hip/hip_runtime.h>
#endif
#include <cstdio>
#include <cstdint>
#include <type_traits>

#ifndef CFG_BATCH
#define CFG_BATCH 2
#endif
#ifndef CFG_SEQ
#define CFG_SEQ 8192
#endif
#ifndef CFG_DM
#define CFG_DM 4096
#endif
#ifndef CFG_DFF
#define CFG_DFF 16384
#endif
#ifndef ONE_LAUNCH
#define ONE_LAUNCH 1
#endif

#ifdef EMU
#define LAS
#define GAS
#define WAIT_VM0() ((void)0)
#define WAIT_LGKM0() ((void)0)
#define WAVE_SYNC() emu::wave_barrier()
#define CFENCE() ((void)0)
#else
#define LAS __attribute__((address_space(3)))
#define GAS __attribute__((address_space(1)))
#define WAIT_VM0() asm volatile("s_waitcnt vmcnt(0)" ::: "memory")
#define WAIT_LGKM0() asm volatile("s_waitcnt lgkmcnt(0)" ::: "memory")
#define WAVE_SYNC() do { asm volatile("s_waitcnt lgkmcnt(0)" ::: "memory"); __builtin_amdgcn_wave_barrier(); asm volatile("" ::: "memory"); } while (0)
#define CFENCE() asm volatile("" ::: "memory")
#endif
#define DI __device__ __forceinline__
#ifndef ATT_FP8
#define ATT_FP8 1
#endif
#ifndef QKV_FP8
#define QKV_FP8 1
#endif
#ifndef UP_INT8
#define UP_INT8 3
#endif
#ifndef GATE_INT8
#define GATE_INT8 1
#endif
#ifndef GATE_FP8
#define GATE_FP8 1
#endif
#ifndef USE_NT
#define USE_NT 1
#endif
#if USE_NT
#define NT_LOAD(p) __builtin_nontemporal_load(p)
#else
#define NT_LOAD(p) (*(p))
#endif
#ifdef EMU
#define F8_PAD() ((void)0)
#else
#define F8_PAD() asm volatile("s_nop 15\n\ts_nop 15" ::: "memory")
#endif
#define PHASE_FN __device__ __forceinline__ void
#ifdef EMU
#define OPAQUE_V(x) ((void)0)
#define OPAQUE_S(x) ((void)0)
#else
#define OPAQUE_V(x) asm volatile("" : "+v"(x))
#define OPAQUE_S(x) asm volatile("" : "+s"(x))
#endif

namespace pg8 {
#define PG8_LAS LAS
typedef unsigned short bf16_t;
typedef short bf16x8 __attribute__((ext_vector_type(8)));
typedef float f32x4 __attribute__((ext_vector_type(4)));
typedef unsigned u32x4 __attribute__((ext_vector_type(4)));
typedef int i32x4_t __attribute__((ext_vector_type(4)));
typedef int v8i_t __attribute__((ext_vector_type(8)));
constexpr int BM = 256, BK = 64, HALF = 128, HTB = HALF * BK * 2  , STAGE_BYTES = 8 * HTB, NXCD = 8, WGM = 8;

__host__ __device__ __forceinline__ int lds_byte(int r, int c) { const int st = (r >> 4) * 2 + (c >> 5), rr = r & 15, cc = c & 31, ob = rr * 64 + cc * 2; return st * 1024 + (ob ^ (((ob >> 9) & 1) << 5)); }
__host__ __device__ __forceinline__ void stage_rc(int b, int& R, int& C) { const int st = b / 1024, sb = b % 1024, swz = sb ^ (((sb >> 9) & 1) << 5); R = (st >> 1) * 16 + swz / 64; C = (st & 1) * 32 + (swz % 64) / 2; }
__host__ __device__ __forceinline__ int perm32(int rho) { const int n = rho >> 4, i = rho & 15; return 8 * (i >> 2) + 4 * n + (i & 3); }

struct Unit { int pm, pn; };
struct Gemm { const bf16_t* A; const bf16_t* Bt; int M, N, K; };

struct StaticOrder {
    int nM, nN, nwg, G, c;
    __host__ __device__ void init(int M, int N, int G_, int c_) { nM = M / BM; nN = N / BM; nwg = nM * nN; G = G_; c = c_; }
    __host__ __device__ bool next(int i, Unit& u) const {
        const long L = (long)i * G + c; if (L >= nwg) return false;
        int wgid = (int)L; { const int q = nwg / NXCD, r = nwg % NXCD, xcd = wgid % NXCD, off = wgid / NXCD; wgid = (xcd < r ? xcd * (q + 1) : r * (q + 1) + (xcd - r) * q) + off; }
        const int nig = WGM * nN, gid = wgid / nig, fm = gid * WGM, gsz = (nM - fm) < WGM ? (nM - fm) : WGM;
        u.pm = fm + ((wgid % nig) % gsz); u.pn = (wgid % nig) / gsz; return true;
    }
    __device__ __forceinline__ void a_ready(const Unit&) const {}
    __device__ __forceinline__ void done(const Unit&) const {}
};


#ifdef EMU
__device__ __forceinline__ unsigned cvt_pk_bf16(float lo, float hi) { unsigned a = __float_as_uint(lo), b = __float_as_uint(hi); a = (a + 0x7fffu + ((a >> 16) & 1u)) >> 16; b = (b + 0x7fffu + ((b >> 16) & 1u)) >> 16; return a | (b << 16); }
#else
__device__ __forceinline__ unsigned cvt_pk_bf16(float lo, float hi) { unsigned r; asm volatile("v_cvt_pk_bf16_f32 %0, %1, %2" : "=v"(r) : "v"(lo), "v"(hi)); return r; }
#endif
typedef unsigned u32x2 __attribute__((ext_vector_type(2)));
template <int ACT> struct EpiBf16 {
    static constexpr bool PERM = true, AFTER_DRAIN = false;
    bf16_t* O; int ldc;
    __device__ __forceinline__ void operator()(const f32x4 (&acc)[2][2][4][2], const Unit& u, int wr, int wc, int fr, int fq) const {
        const int row0 = u.pm * BM + wr * 64 + fr, col0 = u.pn * BM + wc * 32 + 8 * fq;
#pragma unroll
        for (int ai = 0; ai < 2; ++ai)
#pragma unroll
            for (int m = 0; m < 4; ++m) { bf16_t* rowp = O + (size_t)(row0 + ai * HALF + m * 16) * ldc + col0;
#pragma unroll
                for (int bj = 0; bj < 2; ++bj) { f32x4 v0 = acc[ai][bj][m][0], v1 = acc[ai][bj][m][1];
                    if (ACT == 1) {
#pragma unroll
                        for (int j = 0; j < 4; ++j) { const float a = v0[j] > 0.f ? v0[j] : 0.f, b = v1[j] > 0.f ? v1[j] : 0.f; v0[j] = a * a; v1[j] = b * b; } }
                    if (ACT == 2) { v0 = v0 * 0.015625f; v1 = v1 * 0.015625f; }
                    u32x4 w; w.x = cvt_pk_bf16(v0[0], v0[1]); w.y = cvt_pk_bf16(v0[2], v0[3]); w.z = cvt_pk_bf16(v1[0], v1[1]); w.w = cvt_pk_bf16(v1[2], v1[3]);
                    *(u32x4*)(rowp + bj * HALF) = w; } }
    }
};
template <bool I8> struct AccSel { typedef f32x4 type; };
template <> struct AccSel<true> { typedef i32x4_t type; };
template <int ACT  > struct EpiI8 {
    static constexpr bool PERM = true, AFTER_DRAIN = false;
    bf16_t* O; int ldc; const float* sa; const float* sw;
    __device__ __forceinline__ void operator()(const i32x4_t (&acc)[2][2][4][2], const Unit& u, int wr, int wc, int fr, int fq) const {
        const int row0 = u.pm * BM + wr * 64 + fr, col0 = u.pn * BM + wc * 32 + 8 * fq;
        f32x4 cs[2][2];
#pragma unroll
        for (int bj = 0; bj < 2; ++bj) { cs[bj][0] = *(const f32x4*)(sw + col0 + bj * HALF); cs[bj][1] = *(const f32x4*)(sw + col0 + bj * HALF + 4); }
#pragma unroll
        for (int ai = 0; ai < 2; ++ai)
#pragma unroll
            for (int m = 0; m < 4; ++m) { const int row = row0 + ai * HALF + m * 16; const float ra = sa[row]; bf16_t* rowp = O + (size_t)row * ldc + col0;
#pragma unroll
                for (int bj = 0; bj < 2; ++bj) { f32x4 v0, v1;
#pragma unroll
                    for (int j = 0; j < 4; ++j) { const float a = (float)acc[ai][bj][m][0][j] * ra * cs[bj][0][j], b = (float)acc[ai][bj][m][1][j] * ra * cs[bj][1][j];
                        if (ACT == 1) { const float ap = fmaxf(a, 0.f), bp = fmaxf(b, 0.f); v0[j] = ap * ap; v1[j] = bp * bp; } else { v0[j] = a; v1[j] = b; } }
                    u32x4 w; w.x = cvt_pk_bf16(v0[0], v0[1]); w.y = cvt_pk_bf16(v0[2], v0[3]); w.z = cvt_pk_bf16(v1[0], v1[1]); w.w = cvt_pk_bf16(v1[2], v1[3]);
                    *(u32x4*)(rowp + bj * HALF) = w; } }
    }
};
template <bool GATE> struct EpiRes {
    static constexpr bool PERM = false, AFTER_DRAIN = false;
    const float* base; float* out; int ldc; float alpha; const bf16_t* emb;
    __device__ __forceinline__ void operator()(const f32x4 (&acc)[2][2][4][2], const Unit& u, int wr, int wc, int fr, int fq) const {
        const int row0 = u.pm * BM + wr * 64 + fr, col0 = u.pn * BM + wc * 32 + 4 * fq;
#pragma unroll
        for (int ai = 0; ai < 2; ++ai)
#pragma unroll
            for (int m = 0; m < 4; ++m) { const size_t off = (size_t)(row0 + ai * HALF + m * 16) * ldc + col0;
#pragma unroll
                for (int bj = 0; bj < 2; ++bj)
#pragma unroll
                    for (int n = 0; n < 2; ++n) { const size_t o = off + bj * HALF + n * 16; const f32x4 bs = *(const f32x4*)(base + o); f32x4 v = acc[ai][bj][m][n];
                        if (GATE) { const u32x2 e = *(const u32x2*)(emb + o);
                            const float e0 = __uint_as_float(e.x << 16), e1 = __uint_as_float(e.x & 0xffff0000u), e2 = __uint_as_float(e.y << 16), e3 = __uint_as_float(e.y & 0xffff0000u);
                            v[0] = e0 / (1.f + __expf(-v[0])); v[1] = e1 / (1.f + __expf(-v[1])); v[2] = e2 / (1.f + __expf(-v[2])); v[3] = e3 / (1.f + __expf(-v[3])); }
                        *(f32x4*)(out + o) = bs * alpha + v; } }
    }
};

#ifdef EMU
__device__ __forceinline__ void mfma_f8_acc(f32x4& c, v8i_t a, v8i_t b, int) { c = __builtin_amdgcn_mfma_scale_f32_16x16x128_f8f6f4(a, b, c, 0, 0, 0, 0x7f7f7f7f, 0, 0x7f7f7f7f); }
#else
__device__ __forceinline__ void mfma_f8_acc(f32x4& c, v8i_t a, v8i_t b, int sc) { asm volatile("v_mfma_scale_f32_16x16x128_f8f6f4 %0, %1, %2, %0, %3, %3 op_sel_hi:[0,0,0]" : "+v"(c) : "v"(a), "v"(b), "v"(sc)); }
#endif
#ifdef EMU
__device__ __forceinline__ void mfma_f8_acc2(f32x4& c, v8i_t a, v8i_t b, int sa, int sb, int, int) { c = __builtin_amdgcn_mfma_scale_f32_16x16x128_f8f6f4(a, b, c, 0, 0, 0, sa, 0, sb); }
#else
__device__ __forceinline__ void mfma_f8_acc2(f32x4& c, v8i_t a, v8i_t b, int, int, int va, int vb) { asm volatile("v_mfma_scale_f32_16x16x128_f8f6f4 %0, %1, %2, %0, %3, %4 op_sel_hi:[0,0,0]" : "+v"(c) : "v"(a), "v"(b), "v"(va), "v"(vb)); }
#endif
template <class Epi, class Sched, bool ALIGN_EPI = false, bool SP2 = false, int QM = 0>
__device__ __forceinline__ void gemm_phase(PG8_LAS unsigned char* lds, const Gemm g, const Sched& S, const Epi& E) {
    int tid_o = threadIdx.x; OPAQUE_V(tid_o);
    constexpr bool MX = (QM == 3), F8 = (QM == 1) || MX, I8 = (QM == 2); typedef typename AccSel<I8>::type acc_v;
    constexpr int NT8 = 12;
    const int tid = tid_o, wid = __builtin_amdgcn_readfirstlane(tid >> 6), lane = tid & 63, wr = wid >> 2, wc = wid & 3, fr = lane & 15, fq = lane >> 4;
    const int K = g.K, nt = K / BK;
    unsigned voffA[2], voffB[2];
#pragma unroll
    for (int i = 0; i < 2; ++i) { int R, C; stage_rc(tid * 16 + i * 8192, R, C); const int Rb = Epi::PERM ? ((R & ~31) + perm32(R & 31)) : R;
        voffA[i] = (unsigned)(R * K + C) * 2u; voffB[i] = (unsigned)(Rb * K + C) * 2u; }
    const size_t kstep = (size_t)(BK * 2);
    const size_t hstep = (size_t)HALF * K * 2;
    const size_t tstep = 2 * hstep;
    const unsigned ldsw = (unsigned)wid * 1024u;
    const int aoff = lds_byte(wr * 64 + fr, fq * 8), boff = lds_byte(wc * 32 + fr, fq * 8);
#define PG8_SA(b, h) (((b) * 2 + (h)) * HTB)
#define PG8_SB(b, h) ((4 + (b) * 2 + (h)) * HTB)
#define PG8_STAGE(bufoff, gbase, voff) do { _Pragma("unroll") for (int _i = 0; _i < 2; ++_i) \
        __builtin_amdgcn_global_load_lds((const unsigned*)((const char*)(gbase) + (voff)[_i]), (PG8_LAS unsigned*)(lds + (bufoff) + ldsw + _i * 8192), 16, 0, 0); } while (0)
#define PG8_LDA(dst, b, h) do { if constexpr (F8) { _Pragma("unroll") for (int m = 0; m < 4; ++m) dst##8[m] = __builtin_shufflevector(*(const PG8_LAS i32x4_t*)(lds + PG8_SA(b, h) + aoff + m * 2048), *(const PG8_LAS i32x4_t*)(lds + PG8_SA(b, h) + aoff + m * 2048 + 1024), 0, 1, 2, 3, 4, 5, 6, 7); } \
        else { _Pragma("unroll") for (int m = 0; m < 4; ++m) _Pragma("unroll") for (int k = 0; k < 2; ++k) dst[m][k] = *(const PG8_LAS bf16x8*)(lds + PG8_SA(b, h) + aoff + m * 2048 + k * 1024); } } while (0)
#define PG8_LDB(dst, b, h) do { if constexpr (F8) { _Pragma("unroll") for (int n = 0; n < 2; ++n) dst##8[n] = __builtin_shufflevector(*(const PG8_LAS i32x4_t*)(lds + PG8_SB(b, h) + boff + n * 2048), *(const PG8_LAS i32x4_t*)(lds + PG8_SB(b, h) + boff + n * 2048 + 1024), 0, 1, 2, 3, 4, 5, 6, 7); } \
        else { _Pragma("unroll") for (int n = 0; n < 2; ++n) _Pragma("unroll") for (int k = 0; k < 2; ++k) dst[n][k] = *(const PG8_LAS bf16x8*)(lds + PG8_SB(b, h) + boff + n * 2048 + k * 1024); } } while (0)
#ifndef GEMM_PRIO
#define GEMM_PRIO 1
#endif
#define PG8_MMA(ai, bj, At, Bt) do { if (GEMM_PRIO) __builtin_amdgcn_s_setprio(GEMM_PRIO); \
        if constexpr (MX) { if constexpr (mx8) { _Pragma("unroll") for (int m = 0; m < 4; ++m) _Pragma("unroll") for (int n = 0; n < 2; ++n) mfma_f8_acc2(acc[ai][bj][m][n], Bt##8[n], At##8[m], 0x79797979, 0x7b7b7b7b, mx_sw, mx_sa); } \
            else { _Pragma("unroll") for (int m = 0; m < 4; ++m) _Pragma("unroll") for (int n = 0; n < 2; ++n) { \
                acc[ai][bj][m][n] = __builtin_amdgcn_mfma_f32_16x16x32_bf16(__builtin_bit_cast(bf16x8, __builtin_shufflevector(Bt##8[n], Bt##8[n], 0, 1, 2, 3)), __builtin_bit_cast(bf16x8, __builtin_shufflevector(At##8[m], At##8[m], 0, 1, 2, 3)), acc[ai][bj][m][n], 0, 0, 0); \
                acc[ai][bj][m][n] = __builtin_amdgcn_mfma_f32_16x16x32_bf16(__builtin_bit_cast(bf16x8, __builtin_shufflevector(Bt##8[n], Bt##8[n], 4, 5, 6, 7)), __builtin_bit_cast(bf16x8, __builtin_shufflevector(At##8[m], At##8[m], 4, 5, 6, 7)), acc[ai][bj][m][n], 0, 0, 0); } } } \
        else if constexpr (F8) { _Pragma("unroll") for (int m = 0; m < 4; ++m) _Pragma("unroll") for (int n = 0; n < 2; ++n) \
            mfma_f8_acc(acc[ai][bj][m][n], Bt##8[n], At##8[m], f8_scale); } \
        else if constexpr (I8) { _Pragma("unroll") for (int m = 0; m < 4; ++m) _Pragma("unroll") for (int n = 0; n < 2; ++n) _Pragma("unroll") for (int k = 0; k < 2; ++k) \
            acc[ai][bj][m][n] = __builtin_amdgcn_mfma_i32_16x16x64_i8(__builtin_bit_cast(i32x4_t, Bt[n][k]), __builtin_bit_cast(i32x4_t, At[m][k]), acc[ai][bj][m][n], 0, 0, 0); } \
        else { _Pragma("unroll") for (int m = 0; m < 4; ++m) _Pragma("unroll") for (int n = 0; n < 2; ++n) _Pragma("unroll") for (int k = 0; k < 2; ++k) \
            acc[ai][bj][m][n] = __builtin_amdgcn_mfma_f32_16x16x32_bf16(Bt[n][k], At[m][k], acc[ai][bj][m][n], 0, 0, 0); } \
        if (GEMM_PRIO) __builtin_amdgcn_s_setprio(0); } while (0)
#ifdef EMU
#define PG8_WAIT_V(n) ((void)0)
#define PG8_WAIT_L(n) ((void)0)
#else
#define PG8_WAIT_V(n) asm volatile("s_waitcnt vmcnt(" #n ")" ::: "memory")
#define PG8_WAIT_L(n) asm volatile("s_waitcnt lgkmcnt(" #n ")" ::: "memory")
#endif
#define PG8_BAR __builtin_amdgcn_s_barrier()
#define PG8_SCHED __builtin_amdgcn_sched_barrier(0)
    Unit cur, nxt; int ui = 0;
    if (!S.next(0, cur)) return;
    acc_v acc[2][2][4][2];
#pragma unroll
    for (int a = 0; a < 2; ++a)
#pragma unroll
        for (int b = 0; b < 2; ++b)
#pragma unroll
            for (int m = 0; m < 4; ++m)
#pragma unroll
                for (int n = 0; n < 2; ++n) acc[a][b][m][n] = (acc_v){0, 0, 0, 0};
    int f8_scale = 0x7f7f7f7f; OPAQUE_V(f8_scale);
    int mx_sw = 0x79797979, mx_sa = 0x7b7b7b7b; OPAQUE_V(mx_sw); OPAQUE_V(mx_sa);
    bf16x8 At[4][2], B0[2][2], B1[2][2]; v8i_t At8[4], B08[2], B18[2];
    const char* cA = (const char*)g.A + (size_t)cur.pm * tstep; const char* cB = (const char*)g.Bt + (size_t)cur.pn * tstep;
    S.a_ready(cur);
    if constexpr (SP2) {
        PG8_STAGE(PG8_SB(0, 0), cB, voffB); PG8_STAGE(PG8_SB(0, 1), cB + hstep, voffB); PG8_STAGE(PG8_SA(0, 0), cA, voffA); PG8_STAGE(PG8_SA(0, 1), cA + hstep, voffA);
        if (wr == 1) PG8_BAR;
        PG8_WAIT_V(2); PG8_BAR;
        PG8_STAGE(PG8_SB(1, 0), cB + kstep, voffB); PG8_STAGE(PG8_SA(1, 0), cA + kstep, voffA); PG8_STAGE(PG8_SB(1, 1), cB + hstep + kstep, voffB);
        PG8_WAIT_V(6); PG8_BAR;
    } else {
        PG8_STAGE(PG8_SB(0, 0), cB, voffB); PG8_STAGE(PG8_SA(0, 0), cA, voffA); PG8_STAGE(PG8_SB(0, 1), cB + hstep, voffB); PG8_STAGE(PG8_SA(0, 1), cA + hstep, voffA);
        if (wr == 1) PG8_BAR;
        PG8_WAIT_V(4); PG8_BAR;
        PG8_STAGE(PG8_SB(1, 0), cB + kstep, voffB); PG8_STAGE(PG8_SA(1, 0), cA + kstep, voffA); PG8_STAGE(PG8_SB(1, 1), cB + hstep + kstep, voffB);
        PG8_WAIT_V(6); PG8_BAR;
    }
    for (;;) {
        const bool has_next = S.next(ui + 1, nxt);
        const char* nA = has_next ? (const char*)g.A + (size_t)nxt.pm * tstep : cA; const char* nB = has_next ? (const char*)g.Bt + (size_t)nxt.pn * tstep : cB;
        auto kiter = [&](auto mxtag, const int t) __attribute__((always_inline)) {
            constexpr bool mx8 = MX && decltype(mxtag)::value; (void)mx8;
            const bool last = (t == nt - 2);
            const char* a1 = cA + (size_t)(t + 1) * kstep;
            const char* a2 = last ? nA : cA + (size_t)(t + 2) * kstep; const char* b2 = last ? nB : cB + (size_t)(t + 2) * kstep;
            const char* a3 = a2 + kstep; const char* b3 = b2 + kstep;
            if (last && has_next) S.a_ready(nxt);
            if constexpr (SP2) {
            PG8_LDB(B0, 0, 0); PG8_LDB(B1, 0, 1); PG8_SCHED; PG8_LDA(At, 0, 0); PG8_STAGE(PG8_SA(1, 1), a1 + hstep, voffA);
            PG8_WAIT_V(8); PG8_WAIT_L(0); PG8_BAR; PG8_MMA(0, 0, At, B0); PG8_MMA(0, 1, At, B1); PG8_BAR; PG8_SCHED;
            PG8_LDA(At, 0, 1); PG8_STAGE(PG8_SB(0, 0), b2, voffB); PG8_STAGE(PG8_SB(0, 1), b2 + hstep, voffB); PG8_STAGE(PG8_SA(0, 0), a2, voffA);
            PG8_WAIT_V(8); PG8_WAIT_L(0); PG8_BAR; PG8_MMA(1, 0, At, B0); PG8_MMA(1, 1, At, B1); PG8_BAR; PG8_SCHED;
            PG8_LDB(B0, 1, 0); PG8_LDB(B1, 1, 1); PG8_SCHED; PG8_LDA(At, 1, 0); PG8_STAGE(PG8_SA(0, 1), a2 + hstep, voffA);
            PG8_WAIT_V(8); PG8_WAIT_L(0); PG8_BAR; PG8_MMA(0, 0, At, B0); PG8_MMA(0, 1, At, B1); PG8_BAR; PG8_SCHED;
            PG8_LDA(At, 1, 1); PG8_STAGE(PG8_SB(1, 0), b3, voffB); PG8_STAGE(PG8_SB(1, 1), b3 + hstep, voffB); PG8_STAGE(PG8_SA(1, 0), a3, voffA);
            PG8_WAIT_V(8); PG8_WAIT_L(0); PG8_BAR; PG8_MMA(1, 0, At, B0); PG8_MMA(1, 1, At, B1); PG8_BAR; PG8_SCHED;
            } else {
            PG8_LDB(B0, 0, 0); PG8_SCHED; PG8_LDA(At, 0, 0); PG8_STAGE(PG8_SA(1, 1), a1 + hstep, voffA);
            PG8_WAIT_L(8); PG8_BAR; PG8_WAIT_L(0); PG8_MMA(0, 0, At, B0); PG8_BAR; PG8_SCHED;
            PG8_LDB(B1, 0, 1); PG8_STAGE(PG8_SB(0, 0), b2, voffB);
            PG8_BAR; PG8_WAIT_L(0); PG8_MMA(0, 1, At, B1); PG8_BAR;
            PG8_LDA(At, 0, 1); PG8_STAGE(PG8_SA(0, 0), a2, voffA);
            PG8_BAR; PG8_WAIT_L(0); PG8_MMA(1, 0, At, B0); PG8_BAR; PG8_SCHED;
            PG8_STAGE(PG8_SB(0, 1), b2 + hstep, voffB);
            PG8_WAIT_V(6); PG8_BAR; PG8_MMA(1, 1, At, B1); PG8_BAR;
            PG8_LDB(B0, 1, 0); PG8_SCHED; PG8_LDA(At, 1, 0); PG8_STAGE(PG8_SA(0, 1), a2 + hstep, voffA);
            PG8_WAIT_L(8); PG8_BAR; PG8_WAIT_L(0); PG8_MMA(0, 0, At, B0); PG8_BAR; PG8_SCHED;
            PG8_LDB(B1, 1, 1); PG8_STAGE(PG8_SB(1, 0), b3, voffB);
            PG8_BAR; PG8_WAIT_L(0); PG8_MMA(0, 1, At, B1); PG8_BAR;
            PG8_LDA(At, 1, 1); PG8_STAGE(PG8_SA(1, 0), a3, voffA);
            PG8_BAR; PG8_WAIT_L(0); PG8_MMA(1, 0, At, B0); PG8_BAR; PG8_SCHED;
            PG8_STAGE(PG8_SB(1, 1), b3 + hstep, voffB);
            PG8_WAIT_V(6); PG8_BAR; PG8_MMA(1, 1, At, B1); PG8_BAR;
            }
        };
        if constexpr (MX) { for (int t = 0; t < NT8; t += 2) kiter(std::true_type{}, t); for (int t = NT8; t < nt; t += 2) kiter(std::false_type{}, t); }
        else { for (int t = 0; t < nt; t += 2) kiter(std::false_type{}, t); }
        if constexpr (ALIGN_EPI) { if (wr == 0) PG8_BAR; }
        if constexpr (F8) { F8_PAD(); }
        if constexpr (!Epi::AFTER_DRAIN) { E(acc, cur, wr, wc, fr, fq); S.done(cur); }
        if (!has_next) break;
#pragma unroll
        for (int a = 0; a < 2; ++a)
#pragma unroll
            for (int b = 0; b < 2; ++b)
#pragma unroll
                for (int m = 0; m < 4; ++m)
#pragma unroll
                    for (int n = 0; n < 2; ++n) acc[a][b][m][n] = (acc_v){0, 0, 0, 0};
        cur = nxt; cA = nA; cB = nB; ++ui;
        if constexpr (ALIGN_EPI) { if (wr == 1) PG8_BAR; }
    }
    PG8_WAIT_V(0);
    if constexpr (!ALIGN_EPI) { if (wr == 0) PG8_BAR; }
    PG8_BAR;
    if constexpr (Epi::AFTER_DRAIN) { E.fused(acc, cur, wr, wc, fr, fq, lds, wid, lane); S.done(cur); }
#undef PG8_SA
#undef PG8_SB
#undef PG8_STAGE
#undef PG8_LDA
#undef PG8_LDB
#undef PG8_MMA
#undef PG8_WAIT_V
#undef PG8_WAIT_L
#undef PG8_BAR
#undef PG8_SCHED
}
}


constexpr int BATCH = CFG_BATCH, SEQ = CFG_SEQ, DM = CFG_DM, DFF = CFG_DFF, DEPTH = 2;
constexpr int M = BATCH * SEQ, NCH = SEQ / 128;
constexpr int DMIX = 4096, DPLE = 256, D_IN = 11800;
constexpr int NU = 12032;
constexpr int UQ = 0, UK = 1536, UV = 3072, UZ = 4608, UX = 6144, UB = 7680, UC = 8192, USB = 8704, USC = 9728, USH = 10752, UDT = 11776;
constexpr float LN_EPS = 1e-5f, RMS_EPS = 1e-5f, DN_ALPHA = 1.41421356237f, ATT_SCALE = 0.08838834764831845f;
static_assert(SEQ % 2048 == 0 && M % 256 == 0 && DM % 256 == 0 && DFF % 256 == 0 && DM <= DMIX, "shape");
constexpr int NQKV = 4608, NREST = NU - NQKV;
constexpr size_t WINB_OFF = (size_t)NQKV * DM;
DI int remap_u(int n) { return n < 8704 ? n : (n < 8728 ? UDT + (n - 8704) : n - 24); }

constexpr int CAT_PITCH = ATT_FP8 ? 3328 : 4096;
constexpr int CAT_SSM = ATT_FP8 ? 768 : 1536, CAT_SC = CAT_SSM + 1536;
constexpr int ATT_PITCH = ATT_FP8 ? 1536 : CAT_PITCH;
typedef pg8::bf16_t bf16;
typedef pg8::f32x4 f32x4;
typedef pg8::u32x4 u32x4;
typedef pg8::bf16x8 bf16x8;
typedef pg8::u32x2 u32x2;
typedef short s16x4 __attribute__((ext_vector_type(4)));

constexpr size_t al256(size_t x) { return (x + 255) & ~(size_t)255; }
constexpr size_t WS_CTL = 0, CTL_BYTES = 1u << 20;
constexpr size_t WS_WIN = WS_CTL + CTL_BYTES;
constexpr size_t WS_WOUT = WS_WIN + al256((size_t)NU * DM * 2);
constexpr size_t WS_WUP = WS_WOUT + al256((size_t)DM * DMIX * 2);
constexpr size_t WS_WDN = WS_WUP + al256((size_t)DFF * DM * 2);
constexpr size_t WS_WGT = WS_WDN + al256((size_t)DM * DFF * 2);
constexpr size_t WS_WPE = WS_WGT + al256((size_t)DM * DM * 2);
constexpr size_t WS_XB = WS_WPE + al256((size_t)DM * DPLE * 2);
constexpr size_t WS_XF = WS_XB + al256((size_t)M * DM * 2);
constexpr size_t WS_CAT = WS_XF + al256((size_t)M * DM * 2);
constexpr size_t WS_PB = WS_CAT + al256((size_t)M * DMIX * 2);
constexpr size_t WS_LSE = WS_PB + al256((size_t)DEPTH * M * DPLE * 2);
constexpr size_t WS_ROPE = WS_LSE + al256((size_t)M * 12 * 4);
constexpr size_t WS_CD = WS_ROPE + al256((size_t)SEQ * 32 * 4);
constexpr size_t WS_EMB = WS_CD + al256((size_t)BATCH * NCH * 24 * 4);
constexpr size_t WS_YS = WS_EMB + al256((size_t)M * DM * 2);
constexpr size_t WS_XC = WS_YS + al256((size_t)256 * 6 * 16 * 512 * 4);
constexpr size_t WS_PVB = WS_XC + al256((size_t)M * 2560 * 2);
constexpr size_t WS_X8 = WS_PVB + al256((size_t)BATCH * NCH * 24 * 8192 * 2);
constexpr size_t WS_SA = WS_X8 + al256((size_t)M * DM);
constexpr size_t WS_SW = WS_SA + al256((size_t)M * 4);
constexpr size_t WS_SWG = WS_SW + al256((size_t)DFF * 4);
constexpr size_t WS_ATT = WS_SWG + al256((size_t)DM * 4);
constexpr size_t WS_BIG = WS_ATT + al256((size_t)M * 1536 * 2);
constexpr size_t BIG_U_BYTES = al256((size_t)M * NU * 2), BIG_ST_BYTES = al256((size_t)BATCH * NCH * 24 * 64 * 128 * 4), BIG_H_BYTES = al256((size_t)M * DFF * 2);
constexpr size_t BIG_BYTES = (BIG_U_BYTES + BIG_ST_BYTES) > BIG_H_BYTES ? (BIG_U_BYTES + BIG_ST_BYTES) : BIG_H_BYTES;
constexpr size_t WS_END = WS_BIG + BIG_BYTES;

constexpr int RING_BYTES = 139264;
constexpr int MISC_OFF = RING_BYTES;
constexpr int LDS_BYTES = 147456;

DI float bf2f(unsigned short b) { return __uint_as_float(((unsigned)b) << 16); }
DI unsigned short f2bf(float f) { unsigned u = __float_as_uint(f); return (unsigned short)((u + 0x7fffu + ((u >> 16) & 1u)) >> 16); }
DI unsigned pk2(float lo, float hi) { return (unsigned)f2bf(lo) | ((unsigned)f2bf(hi) << 16); }
DI float rcp_f(float x) { return __builtin_amdgcn_rcpf(x); }
DI float silu_f(float x) { return x * rcp_f(1.f + __expf(-x)); }
DI float softplus_f(float x) { return (x > 0.f ? x : 0.f) + log1pf(__expf(-fabsf(x))); }
#ifdef EMU
DI bf16x8 tr_read2(const bf16* p_lo, const bf16* p_hi) { const emu_s16x4 a = emu_tr_read_b64(p_lo), b = emu_tr_read_b64(p_hi); return __builtin_shufflevector(a, b, 0, 1, 2, 3, 4, 5, 6, 7); }
#else
DI bf16x8 tr_read2(const LAS bf16* p_lo, const LAS bf16* p_hi) { s16x4 a, b;
    asm volatile("ds_read_b64_tr_b16 %0, %2\n\tds_read_b64_tr_b16 %1, %3\n\ts_waitcnt lgkmcnt(0)" : "=&v"(a), "=&v"(b) : "v"((unsigned)(size_t)p_lo), "v"((unsigned)(size_t)p_hi) : "memory");
    return __builtin_shufflevector(a, b, 0, 1, 2, 3, 4, 5, 6, 7); }
#endif
#ifdef EMU
DI float shfl_f(float v, int src) { return emu::shfl_idx(v, src); }
#else
DI float shfl_f(float v, int src) { return __int_as_float(__builtin_amdgcn_ds_bpermute(src << 2, __float_as_int(v))); }
#endif
DI float wave_sum(float v, int lane) {
#pragma unroll
    for (int o = 1; o < 64; o <<= 1) v += shfl_f(v, lane ^ o);
    return v; }
DI float wave_max(float v, int lane) {
#pragma unroll
    for (int o = 1; o < 64; o <<= 1) v = fmaxf(v, shfl_f(v, lane ^ o));
    return v; }

#ifdef EMU
DI unsigned char* ld_ws(unsigned char* p) { return p; }
DI float* ld_out(float* p) { return p; }
DI int ld_grid() { return (int)gridDim.x; }
#else
DI int ld_grid() { int v; asm volatile("s_load_dword %0, %1, 0xc0\n\ts_waitcnt lgkmcnt(0)" : "=s"(v) : "s"(__builtin_amdgcn_kernarg_segment_ptr())); return v; }
DI unsigned long long karg_u64_168() { unsigned long long v; asm volatile("s_load_dwordx2 %0, %1, 0xa8\n\ts_waitcnt lgkmcnt(0)" : "=s"(v) : "s"(__builtin_amdgcn_kernarg_segment_ptr())); return v; }
DI unsigned long long karg_u64_176() { unsigned long long v; asm volatile("s_load_dwordx2 %0, %1, 0xb0\n\ts_waitcnt lgkmcnt(0)" : "=s"(v) : "s"(__builtin_amdgcn_kernarg_segment_ptr())); return v; }
DI unsigned char* ld_ws(unsigned char*) { return (unsigned char*)(GAS unsigned char*)karg_u64_176(); }
DI float* ld_out(float*) { return (float*)(GAS float*)karg_u64_168(); }
#endif
#define XB_TMO      128
#define XB_XCNT(j)  (256  + 64 * (j))
#define XB_XSUB(j)  (1280 + 64 * (j))
#define XB_XGEN(j)  (2304 + 64 * (j))
#define XB_TOP      3328
#define XB_TOPGEN   3392
#define XCD_BAR_WORDS 3456
#define XB_SPIN_CAP (1u << 18)

__device__ __forceinline__ unsigned xb_ld(unsigned* p)              { return __hip_atomic_load(p, __ATOMIC_RELAXED, __HIP_MEMORY_SCOPE_AGENT); }
__device__ __forceinline__ unsigned xb_add(unsigned* p, unsigned v) { return __hip_atomic_fetch_add(p, v, __ATOMIC_RELAXED, __HIP_MEMORY_SCOPE_AGENT); }
__device__ __forceinline__ unsigned xb_xcc_id() { return (unsigned)__builtin_amdgcn_s_getreg((3 << 11) | 20) & 0xFu; }
#define XB_SPIN(cond, bar) do { unsigned _sp = 0; while (cond) { __builtin_amdgcn_s_sleep(1); \
    if ((++_sp & 255u) == 0u) { if (xb_ld(&(bar)[XB_TMO])) break; if (_sp > XB_SPIN_CAP) { atomicAdd(&(bar)[XB_TMO], 1u); break; } } } } while (0)

struct XcdBarrier {
    unsigned* bar; unsigned x;
    volatile LAS unsigned* st;
};

__device__ __forceinline__ XcdBarrier xcd_barrier_post(unsigned* bar, volatile LAS unsigned* st) {
    XcdBarrier b; b.bar = bar; b.x = xb_xcc_id(); b.st = st;
    if (threadIdx.x == 0) (void)xb_add(&bar[XB_XCNT(b.x)], 1u);
    return b;
}
__device__ __forceinline__ void xcd_barrier_complete(unsigned* bar, unsigned x, unsigned& nloc, unsigned& nx) {
    const unsigned G = (unsigned)ld_grid();
    unsigned sum, cnt, mine, sp = 0u;
    for (;;) {
        sum = 0u; cnt = 0u; mine = 0u;
#pragma unroll
        for (unsigned j = 0; j < 16; ++j) { const unsigned c = xb_ld(&bar[XB_XCNT(j)]); sum += c; cnt += (c > 0u) ? 1u : 0u; mine = (j == x) ? c : mine; }
        if (sum == G) break;
        __builtin_amdgcn_s_sleep(1);
        if ((++sp & 255u) == 0u) { if (xb_ld(&bar[XB_TMO])) break; if (sp > XB_SPIN_CAP) { atomicAdd(&bar[XB_TMO], 1u); break; } }
    }
    nloc = mine > 0u ? mine : 1u; nx = cnt > 0u ? cnt : 1u;
}

__device__ __forceinline__ void xcd_barrier(const XcdBarrier& b) {
    WAIT_VM0();
    __syncthreads();
    if (threadIdx.x == 0) {
        unsigned* bar = b.bar;
        __builtin_amdgcn_s_waitcnt(0);
        unsigned nloc = b.st[0], nx = b.st[1];
        if (nloc == 0u) { xcd_barrier_complete(bar, b.x, nloc, nx); b.st[0] = nloc; b.st[1] = nx; }
        const unsigned old = xb_add(&bar[XB_XSUB(b.x)], 1u);
        const unsigned gen = old / nloc;
        if (old + 1u == (gen + 1u) * nloc) {
            __builtin_amdgcn_fence(__ATOMIC_RELEASE, "agent");
            WAIT_VM0();
            const unsigned og = xb_add(&bar[XB_TOP], 1u);
            const unsigned tg = og / nx;
            if (og + 1u == (tg + 1u) * nx) xb_add(&bar[XB_TOPGEN], 1u);
            else XB_SPIN(xb_ld(&bar[XB_TOPGEN]) == tg, bar);
            __builtin_amdgcn_fence(__ATOMIC_ACQUIRE, "agent");
            xb_add(&bar[XB_XGEN(b.x)], 1u);
            WAIT_VM0();
        } else {
            XB_SPIN(xb_ld(&bar[XB_XGEN(b.x)]) == gen, bar);
            __builtin_amdgcn_fence(__ATOMIC_ACQUIRE, "agent");
            WAIT_VM0();
        }
    }
    __syncthreads();
}

constexpr int PTAB_OFF = MISC_OFF + 256;
DI const float* inp(LAS unsigned char* lds, int i) { const LAS unsigned* t = (const LAS unsigned*)(lds + PTAB_OFF) + 2 * i;
    const unsigned lo = __builtin_amdgcn_readfirstlane(t[0]), hi = __builtin_amdgcn_readfirstlane(t[1]); return (const float*)(const GAS float*)(((unsigned long long)hi << 32) | (unsigned long long)lo); }
DI unsigned char* opq(unsigned char* p) { unsigned lo = __builtin_amdgcn_readfirstlane((unsigned)(size_t)p), hi = __builtin_amdgcn_readfirstlane((unsigned)((size_t)p >> 32)); OPAQUE_S(lo); OPAQUE_S(hi); return (unsigned char*)(GAS unsigned char*)(((size_t)hi << 32) | (size_t)lo); }
struct Params { const float* in[21]; float* out; unsigned char* ws; int ph_lo, ph_hi; int grid, pad; };
enum { I_X = 0, I_P, I_WIN, I_CW, I_CB, I_DTB, I_ALOG, I_SD, I_NW, I_SCW, I_WOUT, I_L1G, I_L1B, I_WUP, I_WDN, I_L2G, I_L2B, I_WPE, I_WGT, I_L3G, I_L3B };

template <bool REMAP> DI void transpose_item(const float* W, int K, int N, bf16* WT, LAS float* scr, int item, int lane, int row_off = 0, int dpitch = 0, int koff = 0) {
    const int nblk = (N + 63) / 64, kb = item / nblk, nb = item % nblk, k0 = 64 * kb, n0 = 64 * nb;
    const int r4 = lane >> 4, c4 = lane & 15, nl = n0 + 4 * c4;
    f32x4 v[16];
#pragma unroll
    for (int i = 0; i < 16; ++i) v[i] = nl < N ? NT_LOAD((const f32x4*)(W + (size_t)(k0 + 4 * i + r4) * N + nl)) : (f32x4){0.f, 0.f, 0.f, 0.f};
#pragma unroll
    for (int i = 0; i < 16; ++i) { LAS float* d = scr + (4 * i + r4) * 65 + 4 * c4; d[0] = v[i][0]; d[1] = v[i][1]; d[2] = v[i][2]; d[3] = v[i][3]; }
    WAVE_SYNC();
#pragma unroll
    for (int j = 0; j < 8; ++j) { const int chunk = lane + 64 * j, nn = chunk >> 3, kc = chunk & 7, n = n0 + nn; const LAS float* s = scr + (8 * kc) * 65 + nn;
        u32x4 o; o.x = pk2(s[0 * 65], s[1 * 65]); o.y = pk2(s[2 * 65], s[3 * 65]); o.z = pk2(s[4 * 65], s[5 * 65]); o.w = pk2(s[6 * 65], s[7 * 65]);
        if (n < N) { const int row = (REMAP ? remap_u(n) : n) - row_off; *(u32x4*)(WT + (size_t)row * (dpitch ? dpitch : K) + k0 + koff + 8 * kc) = o; } }
    WAVE_SYNC();
}
DI unsigned pk4_fp8(float a, float b, float c, float d) { int w = 0; w = __builtin_amdgcn_cvt_pk_fp8_f32(a, b, w, false); w = __builtin_amdgcn_cvt_pk_fp8_f32(c, d, w, true); return (unsigned)w; }
DI void transpose_item_fp8(const float* W, int K, int N, unsigned char* WT8, LAS float* scr, int item, int lane, int dpitch = 0) {
    const int nblk = (N + 63) / 64, kb = item / nblk, nb = item % nblk, k0 = 64 * kb, n0 = 64 * nb;
    const int r4 = lane >> 4, c4 = lane & 15, nl = n0 + 4 * c4;
    f32x4 v[16];
#pragma unroll
    for (int i = 0; i < 16; ++i) v[i] = nl < N ? NT_LOAD((const f32x4*)(W + (size_t)(k0 + 4 * i + r4) * N + nl)) : (f32x4){0.f, 0.f, 0.f, 0.f};
#pragma unroll
    for (int i = 0; i < 16; ++i) { LAS float* d = scr + (4 * i + r4) * 65 + 4 * c4; d[0] = v[i][0]; d[1] = v[i][1]; d[2] = v[i][2]; d[3] = v[i][3]; }
    WAVE_SYNC();
#pragma unroll
    for (int j = 0; j < 4; ++j) { const int chunk = lane + 64 * j, nn = chunk >> 2, kc = chunk & 3, n = n0 + nn; const LAS float* s = scr + (16 * kc) * 65 + nn;
        u32x4 o;
#pragma unroll
        for (int e = 0; e < 4; ++e) o[e] = pk4_fp8(s[(4 * e) * 65] * 64.f, s[(4 * e + 1) * 65] * 64.f, s[(4 * e + 2) * 65] * 64.f, s[(4 * e + 3) * 65] * 64.f);
        if (n < N) *(u32x4*)(WT8 + (size_t)n * (dpitch ? dpitch : K) + k0 + 16 * kc) = o; }
    WAVE_SYNC();
}
DI void upq_strips(const float* W, int K, int N, signed char* WT8, float* sw_out, LAS unsigned char* lds, int BID, int GSZ, int wave, int lane) {
    LAS float* scr = (LAS float*)(lds + wave * 16640); LAS float* cmx = (LAS float*)(lds + 8 * 16640); LAS float* inv = cmx + 8 * 64;
    const int r4 = lane >> 4, c4 = lane & 15, ntile = K / 64;
    for (int s = BID; s < N / 64; s += GSZ) { const int n0 = 64 * s;
        f32x4 mx = {0.f, 0.f, 0.f, 0.f};
        for (int kb = wave; kb < ntile; kb += 8) {
#pragma unroll
            for (int i = 0; i < 16; ++i) { const f32x4 v = *(const f32x4*)(W + (size_t)(64 * kb + 4 * i + r4) * N + n0 + 4 * c4);
#pragma unroll
                for (int e = 0; e < 4; ++e) mx[e] = fmaxf(mx[e], fabsf(v[e])); } }
#pragma unroll
        for (int e = 0; e < 4; ++e) { mx[e] = fmaxf(mx[e], shfl_f(mx[e], lane ^ 16)); mx[e] = fmaxf(mx[e], shfl_f(mx[e], lane ^ 32)); }
        if (r4 == 0) { cmx[wave * 64 + 4 * c4] = mx[0]; cmx[wave * 64 + 4 * c4 + 1] = mx[1]; cmx[wave * 64 + 4 * c4 + 2] = mx[2]; cmx[wave * 64 + 4 * c4 + 3] = mx[3]; }
        __syncthreads();
        if (wave == 0) { float m = 0.f;
#pragma unroll
            for (int w = 0; w < 8; ++w) m = fmaxf(m, cmx[w * 64 + lane]);
            m = fmaxf(m, 1e-30f); inv[lane] = 127.f / m; sw_out[n0 + lane] = m * (1.f / 127.f); }
        __syncthreads();
        for (int kb = wave; kb < ntile; kb += 8) { const int k0 = 64 * kb;
            f32x4 v[16];
#pragma unroll
            for (int i = 0; i < 16; ++i) v[i] = *(const f32x4*)(W + (size_t)(k0 + 4 * i + r4) * N + n0 + 4 * c4);
#pragma unroll
            for (int i = 0; i < 16; ++i) { LAS float* d = scr + (4 * i + r4) * 65 + 4 * c4; d[0] = v[i][0]; d[1] = v[i][1]; d[2] = v[i][2]; d[3] = v[i][3]; }
            WAVE_SYNC();
#pragma unroll
            for (int j = 0; j < 4; ++j) { const int chunk = lane + 64 * j, nn = chunk >> 2, kc = chunk & 3; const LAS float* sp = scr + (16 * kc) * 65 + nn; const float iv = inv[nn];
                u32x4 o;
#pragma unroll
                for (int e = 0; e < 4; ++e) { unsigned w = 0;
#pragma unroll
                    for (int b = 0; b < 4; ++b) w |= ((unsigned)(__float2int_rn(sp[(4 * e + b) * 65] * iv) & 0xff)) << (8 * b);
                    o[e] = w; }
                *(u32x4*)(WT8 + (size_t)(n0 + nn) * K + k0 + 16 * kc) = o; }
            WAVE_SYNC(); }
        __syncthreads();
    }
}
PHASE_FN phase_weights(unsigned char* wsarg, int L, LAS unsigned char* lds) {
    int BID = blockIdx.x, GSZ = ld_grid(); OPAQUE_S(BID); OPAQUE_S(GSZ); OPAQUE_S(lds);
    unsigned char* const WSQ = ld_ws(wsarg);
    int tid_o = threadIdx.x; OPAQUE_V(tid_o);
    const int tid = tid_o, lane = tid & 63, wave = __builtin_amdgcn_readfirstlane(tid >> 6);
    LAS float* scr = (LAS float*)(lds + wave * 16640);
    const int gw = BID * 8 + wave, NGW = GSZ * 8;
    unsigned char* ws = WSQ;
    const float* win = inp(lds, I_WIN) + (size_t)L * DM * D_IN; const float* wout = inp(lds, I_WOUT) + (size_t)L * DMIX * DM; const float* wup = inp(lds, I_WUP) + (size_t)L * DM * DFF;
    const float* wdn = inp(lds, I_WDN) + (size_t)L * DFF * DM; const float* wgt = inp(lds, I_WGT) + (size_t)L * DM * DM; const float* wpe = inp(lds, I_WPE) + (size_t)L * DPLE * DM;
    constexpr int I_1 = (DM / 64) * ((D_IN + 63) / 64), I_2 = (DMIX / 64) * (DM / 64), I_3 = (DM / 64) * (DFF / 64), I_4 = (DFF / 64) * (DM / 64), I_5 = (DM / 64) * (DM / 64), I_6 = (DPLE / 64) * (DM / 64);
    static_assert(8 * 16640 + 8 * 64 * 4 + 256 <= RING_BYTES && D_IN % 4 == 0 && DM % 64 == 0 && DFF % 64 == 0, "weights phase tiles");
    constexpr int NIT = I_1 + I_2 + I_3 + I_4 + I_5 + I_6;
    for (int it = gw; it < NIT; it += NGW) {
        int r = it;
        if (r < I_1) { if (QKV_FP8) { if (r % ((D_IN + 63) / 64) < NQKV / 64) transpose_item_fp8(win, DM, D_IN, ws + WS_WIN, scr, r, lane); else transpose_item<true>(win, DM, D_IN, (bf16*)(ws + WS_WIN + WINB_OFF), scr, r, lane, NQKV); }
                       else transpose_item<true>(win, DM, D_IN, (bf16*)(ws + WS_WIN), scr, r, lane); continue; } r -= I_1;
        if (r < I_2) { if (ATT_FP8) { if (r / (DM / 64) < 1536 / 64) transpose_item_fp8(wout, DMIX, DM, ws + WS_WOUT, scr, r, lane, CAT_PITCH * 2); else transpose_item<false>(wout, DMIX, DM, (bf16*)(ws + WS_WOUT), scr, r, lane, 0, CAT_PITCH, -768); }
                       else transpose_item<false>(wout, DMIX, DM, (bf16*)(ws + WS_WOUT), scr, r, lane); continue; } r -= I_2;
        if (r < I_3) { if (!((UP_INT8 >> L) & 1)) transpose_item<false>(wup, DM, DFF, (bf16*)(ws + WS_WUP), scr, r, lane); continue; } r -= I_3;
        if (r < I_4) { transpose_item<false>(wdn, DFF, DM, (bf16*)(ws + WS_WDN), scr, r, lane); continue; } r -= I_4;
        if (r < I_5) { if (GATE_INT8) {} else if (GATE_FP8) transpose_item_fp8(wgt, DM, DM, ws + WS_WGT, scr, r, lane); else transpose_item<false>(wgt, DM, DM, (bf16*)(ws + WS_WGT), scr, r, lane); continue; } r -= I_5;
        transpose_item<false>(wpe, DPLE, DM, (bf16*)(ws + WS_WPE), scr, r, lane);
    }
    if ((UP_INT8 >> L) & 1) { __syncthreads(); upq_strips(wup, DM, DFF, (signed char*)(ws + WS_WUP), (float*)(ws + WS_SW), lds, BID, GSZ, wave, lane); }
    if (GATE_INT8) { __syncthreads(); upq_strips(wgt, DM, DM, (signed char*)(ws + WS_WGT), (float*)(ws + WS_SWG), lds, (BID + GSZ / 2) % GSZ, GSZ, wave, lane); }
    const size_t gt = (size_t)BID * 512 + tid, GT = (size_t)GSZ * 512;
    if (L == 0) {
        { u32x4* z = QKV_FP8 ? (u32x4*)((bf16*)(ws + WS_WIN + WINB_OFF) + (size_t)(D_IN - NQKV) * DM) : (u32x4*)((bf16*)(ws + WS_WIN) + (size_t)D_IN * DM); const size_t n16 = (size_t)(NU - D_IN) * DM / 8; for (size_t i = gt; i < n16; i += GT) z[i] = (u32x4){0u, 0u, 0u, 0u}; }
        { const f32x4* x4 = (const f32x4*)inp(lds, I_X); u32x2* o = (u32x2*)(ws + WS_XB); unsigned* o8 = (unsigned*)(ws + WS_X8); for (size_t i = gt; i < (size_t)M * DM / 4; i += GT) { const f32x4 v = x4[i]; u32x2 w; w.x = pk2(v[0], v[1]); w.y = pk2(v[2], v[3]); o[i] = w; if (QKV_FP8) o8[i] = pk4_fp8(v[0], v[1], v[2], v[3]); } }
        { const f32x4* p4 = (const f32x4*)inp(lds, I_P); u32x2* o = (u32x2*)(ws + WS_PB); for (size_t i = gt; i < (size_t)DEPTH * M * DPLE / 4; i += GT) { const f32x4 v = p4[i]; u32x2 w; w.x = pk2(v[0], v[1]); w.y = pk2(v[2], v[3]); o[i] = w; } }
        { float* rt = (float*)(ws + WS_ROPE); for (size_t i = gt; i < (size_t)SEQ * 16; i += GT) { const int pos = (int)(i >> 4), k = (int)(i & 15);
            const float inv = exp2f(-(float)k * (18.931568569324174f / 16.0f)); const float ang = (float)pos * inv; rt[pos * 32 + k] = cosf(ang); rt[pos * 32 + 16 + k] = sinf(ang); } }
    }
}

PHASE_FN phase_rope(unsigned char* wsarg, LAS unsigned char* lds) {
    int BID = blockIdx.x, GSZ = ld_grid(); OPAQUE_S(BID); OPAQUE_S(GSZ); OPAQUE_S(lds);
    unsigned char* const WSQ = ld_ws(wsarg);
    bf16* U = (bf16*)(WSQ + WS_BIG); const float* rt = (const float*)(WSQ + WS_ROPE);
    int tid_o = threadIdx.x; OPAQUE_V(tid_o);
    const size_t gt = (size_t)BID * 512 + tid_o, GT = (size_t)GSZ * 512;
    for (size_t i = gt; i < (size_t)M * 24; i += GT) {
        const int m = (int)(i / 24), hh = (int)(i % 24), pos = m % SEQ;
        bf16* p = U + (size_t)m * NU + (hh < 12 ? UQ + hh * 128 : UK + (hh - 12) * 128);
        const float* cs = rt + pos * 32;
#pragma unroll
        for (int h2 = 0; h2 < 2; ++h2) { u32x4 a = *(u32x4*)(p + 8 * h2), bq = *(u32x4*)(p + 16 + 8 * h2);
#pragma unroll
            for (int w = 0; w < 4; ++w) { const int k = h2 * 8 + w * 2; const unsigned xa = a[w], xb = bq[w];
                const float x1l = __uint_as_float(xa << 16), x1h = __uint_as_float(xa & 0xffff0000u), x2l = __uint_as_float(xb << 16), x2h = __uint_as_float(xb & 0xffff0000u);
                const float c0 = cs[k], c1 = cs[k + 1], s0 = cs[16 + k], s1 = cs[16 + k + 1];
                a[w] = pk2(x1l * c0 - x2l * s0, x1h * c1 - x2h * s1); bq[w] = pk2(x2l * c0 + x1l * s0, x2h * c1 + x1h * s1); }
            *(u32x4*)(p + 8 * h2) = a; *(u32x4*)(p + 16 + 8 * h2) = bq; }
    }
}

PHASE_FN phase_attn_naive(unsigned char* wsarg, LAS unsigned char* lds) {
    int BID = blockIdx.x, GSZ = ld_grid(); OPAQUE_S(BID); OPAQUE_S(GSZ); OPAQUE_S(lds);
    unsigned char* const WSQ = ld_ws(wsarg);
    int tid_o = threadIdx.x; OPAQUE_V(tid_o);
    const int tid = tid_o, lane = tid & 63, wave = __builtin_amdgcn_readfirstlane(tid >> 6);
    LAS float* qs = (LAS float*)(lds + wave * 2048); LAS float* ps = qs + 128;
    const bf16* U = (const bf16*)(WSQ + WS_BIG); bf16* AO = (bf16*)(WSQ + (ATT_FP8 ? WS_ATT : WS_CAT)); float* LSE = (float*)(WSQ + WS_LSE);
    const int gw = BID * 8 + wave, NGW = GSZ * 8;
    for (int it = gw; it < M * 12; it += NGW) {
        const int head = it % 12, m = it / 12, t = m % SEQ, g = head >> 2, d = g == 0 ? 1 : (g == 1 ? 4 : 16);
        { const unsigned qq = *(const unsigned*)(U + (size_t)m * NU + UQ + head * 128 + 2 * lane); qs[2 * lane] = __uint_as_float(qq << 16) * ATT_SCALE; qs[2 * lane + 1] = __uint_as_float(qq & 0xffff0000u) * ATT_SCALE; }
        WAVE_SYNC();
        float sc[3];
#pragma unroll
        for (int r = 0; r < 3; ++r) { const int j = lane + 64 * r; const bool ok = (j <= 128) && (t - j * d >= 0); float s = -INFINITY;
            if (ok) { const bf16* kr = U + (size_t)(m - j * d) * NU + UK + head * 128; s = 0.f;
                for (int c = 0; c < 16; ++c) { const u32x4 kv = *(const u32x4*)(kr + 8 * c);
#pragma unroll
                    for (int w = 0; w < 4; ++w) s += qs[8 * c + 2 * w] * __uint_as_float(kv[w] << 16) + qs[8 * c + 2 * w + 1] * __uint_as_float(kv[w] & 0xffff0000u); } }
            sc[r] = s; }
        const float mx = wave_max(fmaxf(fmaxf(sc[0], sc[1]), sc[2]), lane);
        float psum = 0.f;
#pragma unroll
        for (int r = 0; r < 3; ++r) { const int j = lane + 64 * r; const float p = (sc[r] == -INFINITY) ? 0.f : __expf(sc[r] - mx); psum += p; if (j <= 128) ps[j] = p; }
        const float den = wave_sum(psum, lane);
        WAVE_SYNC();
        float a0 = 0.f, a1 = 0.f;
        for (int j = 0; j <= 128; ++j) { if (t - j * d < 0) break; const float pj = ps[j]; const unsigned vv = *(const unsigned*)(U + (size_t)(m - j * d) * NU + UV + head * 128 + 2 * lane);
            a0 += pj * __uint_as_float(vv << 16); a1 += pj * __uint_as_float(vv & 0xffff0000u); }
        const float inv = 1.f / den;
        *(unsigned*)(AO + (size_t)m * ATT_PITCH + head * 128 + 2 * lane) = pk2(a0 * inv, a1 * inv);
        if (lane == 0) LSE[(size_t)m * 12 + head] = mx + __logf(den);
        WAVE_SYNC();
    }
}

constexpr int AK_STRIDE = 136, AV_STRIDE = 264;
constexpr int AL_K = 0, AL_V = 256 * AK_STRIDE * 2, AL_END = AL_V + 128 * AV_STRIDE * 2;
PHASE_FN phase_attn_mfma(unsigned char* wsarg, LAS unsigned char* lds) {
    int BID = blockIdx.x, GSZ = ld_grid(); OPAQUE_S(BID); OPAQUE_S(GSZ); OPAQUE_S(lds);
    unsigned char* const WSQ = ld_ws(wsarg);
    int tid_o = threadIdx.x; OPAQUE_V(tid_o);
    const int tid = tid_o, lane = tid & 63, wave = tid >> 6, li = lane & 15, q = lane >> 4;
    const bf16* U = (const bf16*)(WSQ + WS_BIG); bf16* AO = (bf16*)(WSQ + (ATT_FP8 ? WS_ATT : WS_CAT)); float* LSE = (float*)(WSQ + WS_LSE);
    LAS bf16* KS = (LAS bf16*)(lds + AL_K); LAS bf16* VT = (LAS bf16*)(lds + AL_V);
    constexpr int UPH = SEQ / 128, NUNITS = BATCH * 12 * UPH;
    const int per = (NUNITS + (int)GSZ - 1) / (int)GSZ;
    const int u_lo = (int)BID * per, u_hi = (u_lo + per < NUNITS) ? u_lo + per : NUNITS;
    for (int uid = u_lo; uid < u_hi; ++uid) {
        const int idx = uid % UPH, bh = uid / UPH, head = bh % 12, b = bh / 12, g = head >> 2, dsh = 2 * g, d = 1 << dsh;
        const int nblk = UPH >> dsh, r = idx / nblk, n = idx % nblk, u0 = 128 * n;
        const size_t rowbase = (size_t)b * SEQ + r;
#pragma unroll
        for (int i = 0; i < 4; ++i) { const int pidx = tid + 512 * i, rp = pidx >> 4, ch = pidx & 15, k0 = 2 * rp;
            u32x4 ka = {0u, 0u, 0u, 0u}, kb = ka, va = ka, vb = ka;
            if (n > 0 || k0 >= 128) { const bf16* r0 = U + (rowbase + (size_t)(u0 - 128 + k0) * d) * NU + head * 128 + 8 * ch; const bf16* r1 = r0 + (size_t)d * NU;
                ka = *(const u32x4*)(r0 + UK); kb = *(const u32x4*)(r1 + UK); va = *(const u32x4*)(r0 + UV); vb = *(const u32x4*)(r1 + UV); }
            *(LAS u32x4*)(KS + k0 * AK_STRIDE + 8 * ch) = ka; *(LAS u32x4*)(KS + (k0 + 1) * AK_STRIDE + 8 * ch) = kb;
#pragma unroll
            for (int w = 0; w < 4; ++w) {
                *(LAS unsigned*)(VT + (8 * ch + 2 * w) * AV_STRIDE + k0) = (va[w] & 0xffffu) | (vb[w] << 16);
                *(LAS unsigned*)(VT + (8 * ch + 2 * w + 1) * AV_STRIDE + k0) = (va[w] >> 16) | (vb[w] & 0xffff0000u); } }
        int qi_o = 16 * wave + li; OPAQUE_V(qi_o);
        const int qi = qi_o; const size_t qrow = rowbase + (size_t)(u0 + qi) * d;
        bf16x8 qf[4];
#pragma unroll
        for (int ks = 0; ks < 4; ++ks) qf[ks] = *(const bf16x8*)(U + qrow * NU + UQ + head * 128 + 32 * ks + 8 * q);
        __syncthreads();
        f32x4 st[10]; float mx = -INFINITY; const int lb = (n > 0) ? qi : max(qi, 128);
#pragma unroll
        for (int t = 0; t < 9; ++t) { const int kt = wave + t; f32x4 a = {0.f, 0.f, 0.f, 0.f};
#pragma unroll
            for (int ks = 0; ks < 4; ++ks) { const bf16x8 kf = *(const LAS bf16x8*)(KS + (16 * kt + li) * AK_STRIDE + 32 * ks + 8 * q); a = __builtin_amdgcn_mfma_f32_16x16x32_bf16(kf, qf[ks], a, 0, 0, 0); }
#pragma unroll
            for (int e = 0; e < 4; ++e) { const int ki = 16 * kt + 4 * q + e;
                const int m01 = min(max(ki - lb + 1, 0), 1) * min(max(qi + 129 - ki, 0), 1); a[e] = fmaf(a[e], ATT_SCALE, (float)(m01 - 1) * 1e30f); mx = fmaxf(mx, a[e]); }
            st[t] = a; }
        st[9] = (f32x4){0.f, 0.f, 0.f, 0.f};
        mx = fmaxf(mx, shfl_f(mx, lane ^ 16)); mx = fmaxf(mx, shfl_f(mx, lane ^ 32));
        float den = 0.f;
#pragma unroll
        for (int t = 0; t < 9; ++t)
#pragma unroll
            for (int e = 0; e < 4; ++e) { const float p = __expf(st[t][e] - mx); st[t][e] = p; den += p; }
        den += shfl_f(den, lane ^ 16); den += shfl_f(den, lane ^ 32);
        f32x4 oacc[8];
#pragma unroll
        for (int dt = 0; dt < 8; ++dt) oacc[dt] = (f32x4){0.f, 0.f, 0.f, 0.f};
#pragma unroll
        for (int a = 0; a < 5; ++a) { u32x4 pw; pw.x = pg8::cvt_pk_bf16(st[2 * a][0], st[2 * a][1]); pw.y = pg8::cvt_pk_bf16(st[2 * a][2], st[2 * a][3]); pw.z = pg8::cvt_pk_bf16(st[2 * a + 1][0], st[2 * a + 1][1]); pw.w = pg8::cvt_pk_bf16(st[2 * a + 1][2], st[2 * a + 1][3]);
            const bf16x8 pf = __builtin_bit_cast(bf16x8, pw);
            const int ke = 16 * (wave + 2 * a) + 4 * q, ko = (a < 4) ? ke + 16 : ke;
#pragma unroll
            for (int dt = 0; dt < 8; ++dt) { const s16x4 lo = *(const LAS s16x4*)(VT + (16 * dt + li) * AV_STRIDE + ke), hi = *(const LAS s16x4*)(VT + (16 * dt + li) * AV_STRIDE + ko);
                const bf16x8 vf = __builtin_shufflevector(lo, hi, 0, 1, 2, 3, 4, 5, 6, 7); oacc[dt] = __builtin_amdgcn_mfma_f32_16x16x32_bf16(vf, pf, oacc[dt], 0, 0, 0); } }
        const float inv = rcp_f(den);
        bf16* orow = AO + qrow * ATT_PITCH + head * 128 + 4 * q;
#pragma unroll
        for (int dt = 0; dt < 8; ++dt) { u32x2 w; w.x = pg8::cvt_pk_bf16(oacc[dt][0] * inv, oacc[dt][1] * inv); w.y = pg8::cvt_pk_bf16(oacc[dt][2] * inv, oacc[dt][3] * inv); *(u32x2*)(orow + 16 * dt) = w; }
        if (q == 0) LSE[qrow * 12 + head] = mx + __logf(den);
        __syncthreads();
    }
}
PHASE_FN phase_attn_mix(unsigned char* wsarg) {
    int BID = blockIdx.x, GSZ = ld_grid(); OPAQUE_S(BID); OPAQUE_S(GSZ);
    unsigned char* const WSQ = ld_ws(wsarg);
    bf16* CAT = (bf16*)(WSQ + WS_CAT); const float* LSE = (const float*)(WSQ + WS_LSE);
    int tid_o = threadIdx.x; OPAQUE_V(tid_o);
    const size_t gt = (size_t)BID * 512 + tid_o, GT = (size_t)GSZ * 512;
    for (size_t i = gt; i < (size_t)M * 64; i += GT) {
        const int m = (int)(i >> 6), h = (int)((i >> 4) & 3), ch = (int)(i & 15);
        const float l0 = LSE[(size_t)m * 12 + h], l1 = LSE[(size_t)m * 12 + 4 + h], l2 = LSE[(size_t)m * 12 + 8 + h];
        const float mx = fmaxf(l0, fmaxf(l1, l2)); const float e0 = __expf(l0 - mx), e1 = __expf(l1 - mx), e2 = __expf(l2 - mx); const float inv = rcp_f(e0 + e1 + e2);
#pragma unroll
        for (int g = 0; g < 3; ++g) { const float wg_ = (g == 0 ? e0 : (g == 1 ? e1 : e2)) * inv;
            if (ATT_FP8) { const u32x4 v = *(const u32x4*)((const bf16*)(WSQ + WS_ATT) + (size_t)m * 1536 + (g * 4 + h) * 128 + ch * 8); const float w16 = wg_ * 16.f; u32x2 o8;
                o8.x = pk4_fp8(__uint_as_float(v[0] << 16) * w16, __uint_as_float(v[0] & 0xffff0000u) * w16, __uint_as_float(v[1] << 16) * w16, __uint_as_float(v[1] & 0xffff0000u) * w16);
                o8.y = pk4_fp8(__uint_as_float(v[2] << 16) * w16, __uint_as_float(v[2] & 0xffff0000u) * w16, __uint_as_float(v[3] << 16) * w16, __uint_as_float(v[3] & 0xffff0000u) * w16);
                *(u32x2*)((unsigned char*)CAT + (size_t)m * (CAT_PITCH * 2) + (g * 4 + h) * 128 + ch * 8) = o8; }
            else { u32x4* p = (u32x4*)(CAT + (size_t)m * CAT_PITCH + (g * 4 + h) * 128 + ch * 8); u32x4 v = *p;
#pragma unroll
                for (int k = 0; k < 4; ++k) v[k] = pk2(__uint_as_float(v[k] << 16) * wg_, __uint_as_float(v[k] & 0xffff0000u) * wg_);
                *p = v; } }
    }
}

PHASE_FN phase_shortconv(unsigned char* wsarg, int L, LAS unsigned char* lds) {
    int BID = blockIdx.x, GSZ = ld_grid(); OPAQUE_S(BID); OPAQUE_S(GSZ); OPAQUE_S(lds);
    unsigned char* const WSQ = ld_ws(wsarg);
    const bf16* U = (const bf16*)(WSQ + WS_BIG); bf16* CAT = (bf16*)(WSQ + WS_CAT); const float* w = inp(lds, I_SCW) + (size_t)L * 3 * 1024;
    int tid_o = threadIdx.x; OPAQUE_V(tid_o);
    const size_t gt = (size_t)BID * 512 + tid_o, GT = (size_t)GSZ * 512;
    for (size_t i = gt; i < (size_t)M * 128; i += GT) {
        const int m = (int)(i >> 7), c0 = (int)(i & 127) * 8, t = m % SEQ;
        float acc[8];
#pragma unroll
        for (int e = 0; e < 8; ++e) acc[e] = 0.f;
#pragma unroll
        for (int k = 0; k < 3; ++k) { if (t - 2 + k < 0) continue; const bf16* r = U + (size_t)(m - 2 + k) * NU;
            const u32x4 cw = *(const u32x4*)(r + USC + c0), hw = *(const u32x4*)(r + USH + c0);
#pragma unroll
            for (int q = 0; q < 4; ++q) { acc[2 * q] += w[k * 1024 + c0 + 2 * q] * (__uint_as_float(cw[q] << 16) * __uint_as_float(hw[q] << 16));
                acc[2 * q + 1] += w[k * 1024 + c0 + 2 * q + 1] * (__uint_as_float(cw[q] & 0xffff0000u) * __uint_as_float(hw[q] & 0xffff0000u)); } }
        const u32x4 bw = *(const u32x4*)(U + (size_t)m * NU + USB + c0); u32x4 ow;
#pragma unroll
        for (int q = 0; q < 4; ++q) ow[q] = pk2(acc[2 * q] * __uint_as_float(bw[q] << 16), acc[2 * q + 1] * __uint_as_float(bw[q] & 0xffff0000u));
        *(u32x4*)(CAT + (size_t)m * CAT_PITCH + CAT_SC + c0) = ow;
    }
}

PHASE_FN phase_conv(unsigned char* wsarg, int L, LAS unsigned char* lds) {
    unsigned char* const WSQ = ld_ws(wsarg);
    int BID = blockIdx.x, GSZ = ld_grid(); OPAQUE_S(BID); OPAQUE_S(GSZ);
    int tid_o = threadIdx.x; OPAQUE_V(tid_o);
    const bf16* U = (const bf16*)(WSQ + WS_BIG); bf16* XC = (bf16*)(WSQ + WS_XC);
    const float* cw = inp(lds, I_CW) + (size_t)L * 4 * 2560; const float* cbv = inp(lds, I_CB) + (size_t)L * 2560;
    const size_t gt = (size_t)BID * 512 + tid_o, GT = (size_t)GSZ * 512;
    for (size_t i = gt; i < (size_t)(M / 16) * 320; i += GT) {
        const int rb = (int)(i / 320), c0 = (int)(i % 320) * 8, m0 = rb * 16, t0 = m0 % SEQ;
        float w[4][8], bs[8];
#pragma unroll
        for (int k = 0; k < 4; ++k) { const f32x4 a0 = *(const f32x4*)(cw + k * 2560 + c0), a1 = *(const f32x4*)(cw + k * 2560 + c0 + 4);
#pragma unroll
            for (int e = 0; e < 4; ++e) { w[k][e] = a0[e]; w[k][4 + e] = a1[e]; } }
        { const f32x4 a0 = *(const f32x4*)(cbv + c0), a1 = *(const f32x4*)(cbv + c0 + 4);
#pragma unroll
          for (int e = 0; e < 4; ++e) { bs[e] = a0[e]; bs[4 + e] = a1[e]; } }
        u32x4 raw[19];
#pragma unroll
        for (int r = 0; r < 19; ++r) raw[r] = (r >= 3 || t0 > 0) ? *(const u32x4*)(U + (size_t)(m0 + r - 3) * NU + UX + c0) : (u32x4){0u, 0u, 0u, 0u};
#pragma unroll
        for (int r = 0; r < 16; ++r) { u32x4 o;
#pragma unroll
            for (int e2 = 0; e2 < 4; ++e2) { float lo = bs[2 * e2], hi = bs[2 * e2 + 1];
#pragma unroll
                for (int k = 0; k < 4; ++k) { const unsigned x = raw[r + k][e2]; lo += w[k][2 * e2] * __uint_as_float(x << 16); hi += w[k][2 * e2 + 1] * __uint_as_float(x & 0xffff0000u); }
                o[e2] = pk2(silu_f(lo), silu_f(hi)); }
            *(u32x4*)(XC + (size_t)(m0 + r) * 2560 + c0) = o; }
    }
}
constexpr int BI_STRIDE = 136, XI_STRIDE = 72;
constexpr int SL_DT = 0, SL_ACS = 4096, SL_BI = 8192, SL_CI = SL_BI + 128 * BI_STRIDE * 2, SL_XI = SL_CI + 128 * BI_STRIDE * 2, SL_PV = SL_XI + 128 * XI_STRIDE * 2, SL_END = SL_PV + 64 * 136 * 2;
constexpr int SL_XI2 = SL_CI;
static_assert(SL_END <= RING_BYTES, "SSD LDS");
DI void ssd_dt_scan(int L, const bf16* U, int m0, int g, LAS unsigned char* lds, int wave, int lane) {
    LAS float* DT = (LAS float*)(lds + SL_DT); LAS float* ACS = (LAS float*)(lds + SL_ACS);
    if (wave < 6) { const int h = g * 6 + wave; const float bias = inp(lds, I_DTB)[L * 24 + h], a = -__expf(inp(lds, I_ALOG)[L * 24 + h]);
        const float d0 = softplus_f(bf2f(U[(size_t)(m0 + lane) * NU + UDT + h]) + bias), d1 = softplus_f(bf2f(U[(size_t)(m0 + 64 + lane) * NU + UDT + h]) + bias);
        float c0 = d0 * a, c1 = d1 * a;
#pragma unroll
        for (int o = 1; o < 64; o <<= 1) { const int src = lane >= o ? lane - o : lane; const float u0 = shfl_f(c0, src), u1 = shfl_f(c1, src); if (lane >= o) { c0 += u0; c1 += u1; } }
        c1 += shfl_f(c0, 63);
        DT[lane * 8 + wave] = d0; DT[(64 + lane) * 8 + wave] = d1; ACS[lane * 8 + wave] = c0; ACS[(64 + lane) * 8 + wave] = c1; }
}
PHASE_FN phase_ssd_states(unsigned char* wsarg, int L, LAS unsigned char* lds) {
    unsigned char* const WSQ = ld_ws(wsarg);
    int BID = blockIdx.x, GSZ = ld_grid(); OPAQUE_S(BID); OPAQUE_S(GSZ); OPAQUE_S(lds);
    int tid_o = threadIdx.x; OPAQUE_V(tid_o);
    const int tid = tid_o, lane = tid & 63, wave = tid >> 6, li = lane & 15, q = lane >> 4;
    const bf16* U = (const bf16*)(WSQ + WS_BIG); const bf16* XC = (const bf16*)(WSQ + WS_XC); float* ST = (float*)(WSQ + WS_BIG + BIG_U_BYTES); float* CD = (float*)(WSQ + WS_CD);
    LAS float* DT = (LAS float*)(lds + SL_DT); LAS float* ACS = (LAS float*)(lds + SL_ACS); LAS bf16* BI = (LAS bf16*)(lds + SL_BI);
    for (int it = BID; it < BATCH * NCH * 4; it += GSZ) {
        const int g = it & 3, c = (it >> 2) % NCH, b = (it >> 2) / NCH, m0 = b * SEQ + c * 128;
        ssd_dt_scan(L, U, m0, g, lds, wave, lane);
#pragma unroll
        for (int i = 0; i < 4; ++i) { const int ci = tid + 512 * i, row = ci >> 4, ch = ci & 15; *(LAS u32x4*)(BI + row * BI_STRIDE + 8 * ch) = *(const u32x4*)(XC + (size_t)(m0 + row) * 2560 + 1536 + g * 128 + 8 * ch); }
        __syncthreads();
        bf16x8 bfr[4];
#pragma unroll
        for (int ks = 0; ks < 4; ++ks) { const LAS bf16* p0 = BI + (32 * ks + 8 * q + (li >> 2)) * BI_STRIDE + 16 * wave + 4 * (li & 3); bfr[ks] = tr_read2(p0, p0 + 4 * BI_STRIDE); }
        u32x4 xr[2];
#pragma unroll
        for (int i = 0; i < 2; ++i) { const int ci = tid + 512 * i; xr[i] = *(const u32x4*)(XC + (size_t)(m0 + (ci >> 3)) * 2560 + (g * 6) * 64 + 8 * (ci & 7)); }
#pragma unroll 1
        for (int j = 0; j < 6; ++j) { const int h = g * 6 + j; LAS bf16* XI = (LAS bf16*)(lds + ((j & 1) ? SL_XI2 : SL_XI));
            { const float alast = ACS[127 * 8 + j];
#pragma unroll
              for (int i = 0; i < 2; ++i) { const int ci = tid + 512 * i, row = ci >> 3, ch = ci & 7;
                  const float wgt = DT[row * 8 + j] * __expf(alast - ACS[row * 8 + j]); u32x4 o;
#pragma unroll
                  for (int e = 0; e < 4; ++e) o[e] = pk2(__uint_as_float(xr[i][e] << 16) * wgt, __uint_as_float(xr[i][e] & 0xffff0000u) * wgt);
                  *(LAS u32x4*)(XI + row * XI_STRIDE + 8 * ch) = o; } }
            __syncthreads();
            if (j < 5) {
#pragma unroll
                for (int i = 0; i < 2; ++i) { const int ci = tid + 512 * i; xr[i] = *(const u32x4*)(XC + (size_t)(m0 + (ci >> 3)) * 2560 + (h + 1) * 64 + 8 * (ci & 7)); } }
            f32x4 acc[4];
#pragma unroll
            for (int pb = 0; pb < 4; ++pb) acc[pb] = (f32x4){0.f, 0.f, 0.f, 0.f};
#pragma unroll
            for (int ks = 0; ks < 4; ++ks)
#pragma unroll
                for (int pb = 0; pb < 4; ++pb) { const LAS bf16* p0 = XI + (32 * ks + 8 * q + (li >> 2)) * XI_STRIDE + 16 * pb + 4 * (li & 3); const bf16x8 afr = tr_read2(p0, p0 + 4 * XI_STRIDE);
                    acc[pb] = __builtin_amdgcn_mfma_f32_16x16x32_bf16(afr, bfr[ks], acc[pb], 0, 0, 0); }
            float* st = ST + ((size_t)((b * NCH + c) * 24 + h) * 64) * 128;
#pragma unroll
            for (int pb = 0; pb < 4; ++pb)
#pragma unroll
                for (int r = 0; r < 4; ++r) st[(size_t)(16 * pb + 4 * q + r) * 128 + 16 * wave + li] = acc[pb][r];
            if (tid == 0) CD[(b * NCH + c) * 24 + h] = __expf(ACS[127 * 8 + j]);
        }
        __syncthreads();
    }
}
PHASE_FN phase_ssd_scan(unsigned char* wsarg, bool dry = false) {
    unsigned char* const WSQ = ld_ws(wsarg);
    int BID = blockIdx.x, GSZ = ld_grid(); OPAQUE_S(BID); OPAQUE_S(GSZ);
    const float* ST = (const float*)(WSQ + WS_BIG + BIG_U_BYTES); const float* CD = (const float*)(WSQ + WS_CD); bf16* SO = dry ? (bf16*)(WSQ + WS_XF) : (bf16*)(WSQ + WS_PVB);
    int tid_o = threadIdx.x; OPAQUE_V(tid_o);
    const size_t gt = (size_t)BID * 512 + tid_o, GT = (size_t)GSZ * 512;
    static_assert(NCH % 8 == 0, "scan batch");
    for (size_t e = gt; e < (size_t)BATCH * 24 * 2048; e += GT) {
        const int b = (int)(e / (24 * 2048)), rem4 = (int)(e % (24 * 2048)), h = rem4 >> 11;
        f32x4 hs = {0.f, 0.f, 0.f, 0.f};
#pragma unroll 1
        for (int c0 = 0; c0 < NCH; c0 += 8) { f32x4 v[8]; float cd[8];
#pragma unroll
            for (int k = 0; k < 8; ++k) { v[k] = *(const f32x4*)(ST + ((size_t)(b * NCH + c0 + k) * 24 * 2048 + rem4) * 4); cd[k] = CD[(b * NCH + c0 + k) * 24 + h]; }
#pragma unroll
            for (int k = 0; k < 8; ++k) { u32x2 w; w.x = pk2(hs[0], hs[1]); w.y = pk2(hs[2], hs[3]); *(u32x2*)(SO + ((size_t)(b * NCH + c0 + k) * 24 * 2048 + rem4) * 4) = w; hs = hs * cd[k] + v[k]; } }
    }
}
PHASE_FN phase_ssd_out(unsigned char* wsarg, int L, LAS unsigned char* lds) {
    int BID = blockIdx.x, GSZ = ld_grid(); OPAQUE_S(BID); OPAQUE_S(GSZ); OPAQUE_S(lds);
    unsigned char* const WSQ = ld_ws(wsarg);
    int tid_o = threadIdx.x; OPAQUE_V(tid_o);
    const int tid = tid_o, lane = tid & 63, wave = tid >> 6, li = lane & 15, q = lane >> 4;
    const bf16* U = (const bf16*)(WSQ + WS_BIG); const bf16* XC = (const bf16*)(WSQ + WS_XC); const bf16* PVB = (const bf16*)(WSQ + WS_PVB); bf16* CAT = (bf16*)(WSQ + WS_CAT);
    const float* nw = inp(lds, I_NW) + (size_t)L * 1536;
    LAS float* DT = (LAS float*)(lds + SL_DT); LAS float* ACS = (LAS float*)(lds + SL_ACS); LAS bf16* CC = (LAS bf16*)(lds + SL_CI); LAS bf16* BC = (LAS bf16*)(lds + SL_BI);
    LAS bf16* XI = (LAS bf16*)(lds + SL_XI); LAS bf16* PV = (LAS bf16*)(lds + SL_PV);
    for (int it = BID; it < BATCH * NCH * 4; it += GSZ) {
        const int g = it & 3, c = (it >> 2) % NCH, b = (it >> 2) / NCH, m0 = b * SEQ + c * 128;
        u32x4 xr[2], pr[2];
#pragma unroll
        for (int i = 0; i < 2; ++i) { const int ci = tid + 512 * i; xr[i] = *(const u32x4*)(XC + (size_t)(m0 + (ci >> 3)) * 2560 + (g * 6) * 64 + 8 * (ci & 7)); pr[i] = *(const u32x4*)(PVB + (size_t)((b * NCH + c) * 24 + g * 6) * 8192 + 8 * ci); }
        ssd_dt_scan(L, U, m0, g, lds, wave, lane);
#pragma unroll
        for (int i = 0; i < 4; ++i) { const int ci = tid + 512 * i, row = ci >> 4, ch = ci & 15; const bf16* src = XC + (size_t)(m0 + row) * 2560 + 1536 + g * 128 + 8 * ch;
            *(LAS u32x4*)(BC + row * BI_STRIDE + 8 * ch) = *(const u32x4*)src; *(LAS u32x4*)(CC + row * BI_STRIDE + 8 * ch) = *(const u32x4*)(src + 512); }
        __syncthreads();
        float* YS = (float*)(WSQ + WS_YS) + (size_t)BID * (6 * 16 * 512) + tid; float ssq[4] = {0.f, 0.f, 0.f, 0.f};
#pragma unroll 1
        for (int j = 0; j < 6; ++j) { const int h = g * 6 + j;
#pragma unroll
            for (int i = 0; i < 2; ++i) { const int ci = tid + 512 * i, row = ci >> 3, ch = ci & 7; const float wgt = DT[row * 8 + j]; u32x4 o;
#pragma unroll
                for (int e = 0; e < 4; ++e) o[e] = pk2(__uint_as_float(xr[i][e] << 16) * wgt, __uint_as_float(xr[i][e] & 0xffff0000u) * wgt);
                *(LAS u32x4*)(XI + row * XI_STRIDE + 8 * ch) = o; *(LAS u32x4*)(PV + (ci >> 4) * 136 + 8 * (ci & 15)) = pr[i]; }
            __syncthreads();
            if (j < 5) {
#pragma unroll
                for (int i = 0; i < 2; ++i) { const int ci = tid + 512 * i; xr[i] = *(const u32x4*)(XC + (size_t)(m0 + (ci >> 3)) * 2560 + (h + 1) * 64 + 8 * (ci & 7)); pr[i] = *(const u32x4*)(PVB + (size_t)((b * NCH + c) * 24 + h + 1) * 8192 + 8 * ci); } }
            unsigned short zr[16];
#pragma unroll
            for (int pb = 0; pb < 4; ++pb)
#pragma unroll
                for (int r = 0; r < 4; ++r) zr[pb * 4 + r] = U[(size_t)(m0 + 16 * wave + 4 * q + r) * NU + UZ + h * 64 + 16 * pb + li];
            f32x4 acc[4];
#pragma unroll
            for (int pb = 0; pb < 4; ++pb) acc[pb] = (f32x4){0.f, 0.f, 0.f, 0.f};
#pragma unroll
            for (int ks = 0; ks < 4; ++ks) { const bf16x8 afr = *(const LAS bf16x8*)(CC + (16 * wave + li) * 136 + 32 * ks + 8 * q);
#pragma unroll
                for (int pb = 0; pb < 4; ++pb) { const bf16x8 bfr = *(const LAS bf16x8*)(PV + (16 * pb + li) * 136 + 32 * ks + 8 * q); acc[pb] = __builtin_amdgcn_mfma_f32_16x16x32_bf16(afr, bfr, acc[pb], 0, 0, 0); } }
#pragma unroll
            for (int r = 0; r < 4; ++r) { const float e = __expf(ACS[(16 * wave + 4 * q + r) * 8 + j]);
#pragma unroll
                for (int pb = 0; pb < 4; ++pb) acc[pb][r] *= e; }
            int l_o = 16 * wave + li; OPAQUE_V(l_o); const int l_a = l_o; const float acs_l = ACS[l_a * 8 + j];
            const float ddt = inp(lds, I_SD)[L * 24 + h] * rcp_f(DT[l_a * 8 + j]);
#pragma unroll
            for (int ks2 = 0; ks2 < 4; ++ks2) {
                if (2 * ks2 <= wave) {
                    f32x4 c0 = {0.f, 0.f, 0.f, 0.f}, c1 = {0.f, 0.f, 0.f, 0.f};
#pragma unroll
                    for (int ks = 0; ks < 4; ++ks) { const bf16x8 bfr = *(const LAS bf16x8*)(CC + (16 * wave + li) * 136 + 32 * ks + 8 * q);
                        const bf16x8 a0 = *(const LAS bf16x8*)(BC + (32 * ks2 + li) * 136 + 32 * ks + 8 * q), a1 = *(const LAS bf16x8*)(BC + (32 * ks2 + 16 + li) * 136 + 32 * ks + 8 * q);
                        c0 = __builtin_amdgcn_mfma_f32_16x16x32_bf16(a0, bfr, c0, 0, 0, 0); c1 = __builtin_amdgcn_mfma_f32_16x16x32_bf16(a1, bfr, c1, 0, 0, 0); }
                    bf16x8 afr;
#pragma unroll
                    for (int e = 0; e < 8; ++e) { const int s = 32 * ks2 + (e < 4 ? 4 * q + e : 16 + 4 * q + (e - 4)); const float cbv_ = e < 4 ? c0[e & 3] : c1[e & 3];
                        const float gv = cbv_ * __expf(fminf(acs_l - ACS[s * 8 + j], 0.f)) * (float)min(max(l_a - s + 1, 0), 1) + ddt * (float)(1 - min(abs(l_a - s), 1)); afr[e] = (short)f2bf(gv); }
#pragma unroll
                    for (int pb = 0; pb < 4; ++pb) { const LAS bf16* p0 = XI + (32 * ks2 + 4 * q + (li >> 2)) * XI_STRIDE + 16 * pb + 4 * (li & 3);
                        const bf16x8 bfr = tr_read2(p0, p0 + 16 * XI_STRIDE); acc[pb] = __builtin_amdgcn_mfma_f32_16x16x32_bf16(afr, bfr, acc[pb], 0, 0, 0); } } }
#pragma unroll
            for (int pb = 0; pb < 4; ++pb)
#pragma unroll
                for (int r = 0; r < 4; ++r) { const float y = acc[pb][r] * silu_f(bf2f(zr[pb * 4 + r]));
                    YS[(j * 16 + pb * 4 + r) * 512] = y; ssq[r] += y * y; }
            __syncthreads();
        }
#pragma unroll
        for (int r = 0; r < 4; ++r) { float s = ssq[r]; s += shfl_f(s, lane ^ 1); s += shfl_f(s, lane ^ 2); s += shfl_f(s, lane ^ 4); s += shfl_f(s, lane ^ 8); ssq[r] = __builtin_amdgcn_rsqf(s * (1.f / 384.f) + RMS_EPS); }
#pragma unroll 1
        for (int j = 0; j < 6; ++j)
#pragma unroll
            for (int pb = 0; pb < 4; ++pb)
#pragma unroll
                for (int r = 0; r < 4; ++r) { const int l = 16 * wave + 4 * q + r, ch = (g * 6 + j) * 64 + 16 * pb + li; CAT[(size_t)(m0 + l) * CAT_PITCH + CAT_SSM + ch] = f2bf(YS[(j * 16 + pb * 4 + r) * 512] * ssq[r] * nw[ch]); }
    }
}

static_assert(DM % 1024 == 0, "phase_resln: DM must be a multiple of 1024");
template <bool GATE> PHASE_FN phase_resln(unsigned char* wsarg, float* outarg, int L, int which, LAS unsigned char* lds, bool dry = false) {
    unsigned char* const WSQ = ld_ws(wsarg);
    const float* x32 = (L == 0 && which == 0) ? inp(lds, I_X) : nullptr;
    bf16* xb = (bf16*)(WSQ + WS_XB); const bf16* fb = (const bf16*)(WSQ + WS_XF); const bf16* emb = (const bf16*)(WSQ + WS_EMB);
    float* out32 = (L == DEPTH - 1 && which == 2 && !dry) ? ld_out(outarg) : nullptr; bf16* xo = dry ? (bf16*)(WSQ + WS_CAT) : xb;
    const float* gam = inp(lds, which == 0 ? I_L1G : (which == 1 ? I_L2G : I_L3G)) + (size_t)L * DM; const float* bet = inp(lds, which == 0 ? I_L1B : (which == 1 ? I_L2B : I_L3B)) + (size_t)L * DM;
    int BID = blockIdx.x, GSZ = ld_grid(); OPAQUE_S(BID); OPAQUE_S(GSZ);
    int tid_o = threadIdx.x; OPAQUE_V(tid_o);
    const int lane = tid_o & 63, wave = __builtin_amdgcn_readfirstlane(tid_o >> 6), pair = wave >> 1, half = wave & 1;
    const bool q8 = (((which == 0) && ((UP_INT8 >> L) & 1)) || ((which == 1) && GATE_INT8)) && !dry;
    LAS float* RS = (LAS float*)lds; LAS float* RQ = RS + 8;
    constexpr int NJ = DM / 1024;
    const int niter = (M + 4 * GSZ - 1) / (4 * GSZ);
    for (int itn = 0; itn < niter; ++itn) {
        const int m = (itn * GSZ + BID) * 4 + pair; const bool live = m < M;
        float v[NJ][8]; float s = 0.f;
        if (live) {
#pragma unroll
        for (int j = 0; j < NJ; ++j) { const size_t o = (size_t)m * DM + (size_t)((half * NJ + j) * 64 + lane) * 8;
            float xv[8];
            if (x32) { const f32x4 a = NT_LOAD((const f32x4*)(x32 + o)), b = NT_LOAD((const f32x4*)(x32 + o + 4)); xv[0] = a[0]; xv[1] = a[1]; xv[2] = a[2]; xv[3] = a[3]; xv[4] = b[0]; xv[5] = b[1]; xv[6] = b[2]; xv[7] = b[3]; }
            else { const u32x4 a = NT_LOAD((const u32x4*)(xb + o));
#pragma unroll
                for (int k = 0; k < 4; ++k) { xv[2 * k] = __uint_as_float(a[k] << 16); xv[2 * k + 1] = __uint_as_float(a[k] & 0xffff0000u); } }
            const u32x4 f = NT_LOAD((const u32x4*)(fb + o)); float fv[8];
#pragma unroll
            for (int k = 0; k < 4; ++k) { fv[2 * k] = __uint_as_float(f[k] << 16); fv[2 * k + 1] = __uint_as_float(f[k] & 0xffff0000u); }
            if (GATE) { const u32x4 e = NT_LOAD((const u32x4*)(emb + o));
#pragma unroll
                for (int k = 0; k < 4; ++k) { fv[2 * k] = __uint_as_float(e[k] << 16) * rcp_f(1.f + __expf(-fv[2 * k])); fv[2 * k + 1] = __uint_as_float(e[k] & 0xffff0000u) * rcp_f(1.f + __expf(-fv[2 * k + 1])); } }
#pragma unroll
            for (int k = 0; k < 8; ++k) { v[j][k] = DN_ALPHA * xv[k] + fv[k]; s += v[j][k]; } }
        }
        s = wave_sum(s, lane); if (lane == 0) RS[pair * 2 + half] = s;
        __syncthreads();
        const float mean = (RS[pair * 2] + RS[pair * 2 + 1]) * (1.f / DM); float s2 = 0.f;
        if (live) {
#pragma unroll
        for (int j = 0; j < NJ; ++j)
#pragma unroll
            for (int k = 0; k < 8; ++k) { v[j][k] -= mean; s2 += v[j][k] * v[j][k]; }
        }
        s2 = wave_sum(s2, lane); if (lane == 0) RQ[pair * 2 + half] = s2;
        __syncthreads();
        const float rstd = __builtin_amdgcn_rsqf((RQ[pair * 2] + RQ[pair * 2 + 1]) * (1.f / DM) + LN_EPS);
        float ymax = 0.f;
        if (live) {
#pragma unroll
        for (int j = 0; j < NJ; ++j) { const size_t c = (size_t)((half * NJ + j) * 64 + lane) * 8, o = (size_t)m * DM + c;
            const f32x4 g0 = *(const f32x4*)(gam + c), g1 = *(const f32x4*)(gam + c + 4), b0 = *(const f32x4*)(bet + c), b1 = *(const f32x4*)(bet + c + 4);
            float y[8];
#pragma unroll
            for (int k = 0; k < 4; ++k) { y[k] = v[j][k] * rstd * g0[k] + b0[k]; y[4 + k] = v[j][4 + k] * rstd * g1[k] + b1[k]; }
            if (out32) { *(f32x4*)(out32 + o) = (f32x4){y[0], y[1], y[2], y[3]}; *(f32x4*)(out32 + o + 4) = (f32x4){y[4], y[5], y[6], y[7]}; }
            else { u32x4 w; w.x = pk2(y[0], y[1]); w.y = pk2(y[2], y[3]); w.z = pk2(y[4], y[5]); w.w = pk2(y[6], y[7]); *(u32x4*)(xo + o) = w;
                   if ((GATE_FP8 && !GATE_INT8 && which == 1) || (QKV_FP8 && which == 2)) { u32x2 w8; w8.x = pk4_fp8(y[0], y[1], y[2], y[3]); w8.y = pk4_fp8(y[4], y[5], y[6], y[7]); *(u32x2*)(WSQ + WS_X8 + o) = w8; } }
            if (q8) {
#pragma unroll
                for (int k = 0; k < 8; ++k) { v[j][k] = y[k]; ymax = fmaxf(ymax, fabsf(y[k])); } } }
        }
        if (q8) {
            ymax = wave_max(ymax, lane); if (lane == 0) RS[16 + pair * 2 + half] = ymax;
            __syncthreads();
            const float rmx = fmaxf(fmaxf(RS[16 + pair * 2], RS[16 + pair * 2 + 1]), 1e-30f), iv = 127.f / rmx;
            if (live) {
#pragma unroll
                for (int j = 0; j < NJ; ++j) { const size_t o = (size_t)m * DM + (size_t)((half * NJ + j) * 64 + lane) * 8; u32x2 w8;
                    unsigned a = 0, b = 0;
#pragma unroll
                    for (int k = 0; k < 4; ++k) { a |= ((unsigned)(__float2int_rn(v[j][k] * iv) & 0xff)) << (8 * k); b |= ((unsigned)(__float2int_rn(v[j][4 + k] * iv) & 0xff)) << (8 * k); }
                    w8.x = a; w8.y = b; *(u32x2*)(WSQ + WS_X8 + o) = w8; }
                if (half == 0 && lane == 0) ((float*)(WSQ + WS_SA))[m] = rmx * (1.f / 127.f); }
        }
    }
    __syncthreads();
}

constexpr int PH_PER_LAYER = 13, N_PHASES = DEPTH * PH_PER_LAYER;
#ifndef REP_G3
#define REP_G3 1
#endif
#ifndef REP_G4
#define REP_G4 1
#endif
#ifndef REP_SCAN
#define REP_SCAN 1
#endif
#ifndef REP_MISC
#define REP_MISC 1
#endif
#ifndef REP_BAR
#define REP_BAR 1
#endif
#ifndef GEMM_ALIGN
#define GEMM_ALIGN true
#endif
#ifndef GEMM_SP2
#define GEMM_SP2 true
#endif
#ifndef REP_GEMM
#define REP_GEMM 1
#endif
#ifndef ATTN_NAIVE
#define ATTN_NAIVE 0
#endif
#ifndef REP_W
#define REP_W 1
#endif
#ifndef REP_LN
#define REP_LN 1
#endif
#ifndef REP_ATT
#define REP_ATT 1
#endif
#ifndef REP_SSD1
#define REP_SSD1 1
#endif
#ifndef REP_SSD3
#define REP_SSD3 1
#endif
#ifndef REP_SC
#define REP_SC 1
#endif
#ifndef PHASE_MASK
#define PHASE_MASK 0x1fff
#endif
#if ONE_LAUNCH && !defined(EMU)
#define IN(k) ((PHASE_MASK >> (((k) % PH_PER_LAYER))) & 1)
#define SEAM(k) do { if ((k) + 1 < N_PHASES) { XcdBarrier b_; b_.bar = (unsigned*)(ld_ws(P.ws) + WS_CTL) + 4096; b_.x = xb_xcc_id(); b_.st = (volatile LAS unsigned*)(lds + MISC_OFF) + 8; for (int rb_ = 0; rb_ < REP_BAR; ++rb_) xcd_barrier(b_); } } while (0)
#else
#define IN(k) (((PHASE_MASK >> (((k) % PH_PER_LAYER))) & 1) && P.ph_lo <= (k) && (k) < P.ph_hi)
#define SEAM(k) do { if (IN(k) && IN((k) + 1)) { XcdBarrier b_; b_.bar = (unsigned*)(ld_ws(P.ws) + WS_CTL) + 4096; b_.x = xb_xcc_id(); b_.st = (volatile LAS unsigned*)(lds + MISC_OFF) + 8; xcd_barrier(b_); } } while (0)
#endif
template <int L> DI void layer_program(const Params& P, LAS unsigned char* lds) {
    {
        constexpr int pb = L * PH_PER_LAYER;
#define WSP unsigned char* const ws = ld_ws(P.ws); (void)ws
#define GEMM_PHASE(EPI, A_, B_, N_, K_, ...) GEMM_PHASE_R(0, 0, EPI, A_, B_, N_, K_, __VA_ARGS__)
#define GEMM_PHASE_X(F8_, EPI, A_, B_, N_, K_, ...) GEMM_PHASE_R(F8_, 0, EPI, A_, B_, N_, K_, __VA_ARGS__)
#define GEMM_PHASE_R(F8_, ROT_, EPI, A_, B_, N_, K_, ...) do { pg8::Gemm g{(const bf16*)(A_), (const bf16*)(B_), M, (N_), (K_)}; int bid_ = blockIdx.x, gsz_ = ld_grid(); if (ROT_) bid_ = (bid_ + gsz_ / 2) % gsz_; OPAQUE_S(bid_); OPAQUE_S(gsz_); auto lds_ = lds; OPAQUE_S(lds_); pg8::StaticOrder S; S.init(M, (N_), gsz_, bid_); \
            EPI E{__VA_ARGS__}; for (int rep = 0; rep < REP_GEMM; ++rep) pg8::gemm_phase<EPI, pg8::StaticOrder, GEMM_ALIGN, GEMM_SP2, F8_>(lds_, g, S, E); } while (0)
        if (IN(pb + 0)) for (int rep = 0; rep < REP_W; ++rep) phase_weights(P.ws, L, lds);
        SEAM(pb + 0);
        if (IN(pb + 1)) { WSP;
            if (QKV_FP8) { GEMM_PHASE_X(1, pg8::EpiBf16<2>, ws + WS_X8, ws + WS_WIN, NQKV, DM / 2, (bf16*)(ws + WS_BIG), NU);
                           GEMM_PHASE_R(0, 1, pg8::EpiBf16<0>, ws + WS_XB, ws + WS_WIN + WINB_OFF, NREST, DM, (bf16*)(ws + WS_BIG) + NQKV, NU); }
            else GEMM_PHASE(pg8::EpiBf16<0>, ws + WS_XB, ws + WS_WIN, NU, DM, (bf16*)(ws + WS_BIG), NU); }
        SEAM(pb + 1);
        if (IN(pb + 2)) { phase_rope(P.ws, lds); for (int rm_ = 0; rm_ < REP_MISC; ++rm_) { phase_conv(P.ws, L, lds); WSP; GEMM_PHASE(pg8::EpiBf16<0>, (const bf16*)(ws + WS_PB) + (size_t)L * M * DPLE, ws + WS_WPE, DM, DPLE, (bf16*)(ws + WS_EMB), DM); } }
        SEAM(pb + 2);
        if (IN(pb + 3)) { for (int rep = 0; rep < REP_SSD1; ++rep) phase_ssd_states(P.ws, L, lds); for (int rep = 0; rep < REP_ATT; ++rep) { if (ATTN_NAIVE) phase_attn_naive(P.ws, lds); else phase_attn_mfma(P.ws, lds); } for (int rep = 0; rep < REP_SC; ++rep) phase_shortconv(P.ws, L, lds); }
        SEAM(pb + 3);
        if (IN(pb + 4)) { for (int rs_ = 0; rs_ < REP_SCAN; ++rs_) phase_ssd_scan(P.ws, rs_ + 1 < REP_SCAN); phase_attn_mix(P.ws); }
        SEAM(pb + 4);
        if (IN(pb + 5)) for (int rep = 0; rep < REP_SSD3; ++rep) phase_ssd_out(P.ws, L, lds);
        SEAM(pb + 5);
        if (IN(pb + 6)) { WSP; if (ATT_FP8) GEMM_PHASE_X(3, pg8::EpiBf16<0>, ws + WS_CAT, ws + WS_WOUT, DM, CAT_PITCH, (bf16*)(ws + WS_XF), DM);
            else GEMM_PHASE(pg8::EpiBf16<0>, ws + WS_CAT, ws + WS_WOUT, DM, DMIX, (bf16*)(ws + WS_XF), DM); }
        SEAM(pb + 6);
        if (IN(pb + 7)) for (int rep = 0; rep < REP_LN; ++rep) phase_resln<false>(P.ws, P.out, L, 0, lds, rep + 1 < REP_LN);
        SEAM(pb + 7);
        if (IN(pb + 8)) for (int r3_ = 0; r3_ < REP_G3; ++r3_) { WSP; if constexpr ((UP_INT8 >> L) & 1) GEMM_PHASE_X(2, pg8::EpiI8<1>, ws + WS_X8, ws + WS_WUP, DFF, DM / 2, (bf16*)(ws + WS_BIG), DFF, (const float*)(ws + WS_SA), (const float*)(ws + WS_SW));
            else GEMM_PHASE(pg8::EpiBf16<1>, ws + WS_XB, ws + WS_WUP, DFF, DM, (bf16*)(ws + WS_BIG), DFF); }
        SEAM(pb + 8);
        if (IN(pb + 9)) for (int r4_ = 0; r4_ < REP_G4; ++r4_) { WSP; GEMM_PHASE(pg8::EpiBf16<0>, ws + WS_BIG, ws + WS_WDN, DM, DFF, (bf16*)(ws + WS_XF), DM); }
        SEAM(pb + 9);
        if (IN(pb + 10)) for (int rep = 0; rep < REP_LN; ++rep) phase_resln<false>(P.ws, P.out, L, 1, lds, rep + 1 < REP_LN);
        SEAM(pb + 10);
        if (IN(pb + 11)) { WSP; if (GATE_INT8) GEMM_PHASE_X(2, pg8::EpiI8<0>, ws + WS_X8, ws + WS_WGT, DM, DM / 2, (bf16*)(ws + WS_XF), DM, (const float*)(ws + WS_SA), (const float*)(ws + WS_SWG));
            else if (GATE_FP8) GEMM_PHASE_X(true, pg8::EpiBf16<2>, ws + WS_X8, ws + WS_WGT, DM, DM / 2, (bf16*)(ws + WS_XF), DM);
            else GEMM_PHASE(pg8::EpiBf16<0>, ws + WS_XB, ws + WS_WGT, DM, DM, (bf16*)(ws + WS_XF), DM); }
        SEAM(pb + 11);
        if (IN(pb + 12)) for (int rep = 0; rep < REP_LN; ++rep) phase_resln<true>(P.ws, P.out, L, 2, lds, rep + 1 < REP_LN);
        SEAM(pb + 12);
#undef WSP
#undef GEMM_PHASE
#undef GEMM_PHASE_X
#undef GEMM_PHASE_R
    }
}
#undef IN
#undef SEAM

__global__ void __launch_bounds__(512, 2) hymba_fwd(Params P) {
#ifdef EMU
    unsigned char* lds = emu::lds_base();
#else
    extern __shared__ __attribute__((aligned(16))) unsigned char lds_raw[];
    LAS unsigned char* lds = (LAS unsigned char*)lds_raw;
#endif
    volatile LAS unsigned* MISC = (volatile LAS unsigned*)(lds + MISC_OFF);
    for (int u = threadIdx.x; u < 64; u += 512) MISC[u] = 0u;
    { LAS unsigned long long* pt = (LAS unsigned long long*)(lds + PTAB_OFF);
#pragma unroll
      for (int i = 0; i < 21; ++i) if (threadIdx.x == i) pt[i] = (unsigned long long)(size_t)P.in[i]; }
    __syncthreads();
    if ((P.ph_hi - P.ph_lo) > 1) (void)xcd_barrier_post((unsigned*)(P.ws + WS_CTL) + 4096, MISC + 8);
    layer_program<0>(P, lds);
    layer_program<1>(P, lds);
    static_assert(DEPTH == 2, "layer_program instantiations");

}

extern "C" void kernel_launch(void* const* d_in, const int* in_sizes, int n_in, void* d_out, int out_size, void* d_ws, size_t ws_size, hipStream_t stream) {
    static int grid = 0;
    if (grid == 0) {
        if (n_in != 21 || ws_size < WS_END) { fprintf(stderr, "kernel_launch: expected 21 inputs and >= %zu bytes of workspace; got %d inputs, %zu bytes\n", (size_t)WS_END, n_in, ws_size); grid = -1; return; }
        int dev = 0, cus = 0, per_cu = 0;
        if (hipGetDevice(&dev) != hipSuccess || hipDeviceGetAttribute(&cus, hipDeviceAttributeMultiprocessorCount, dev) != hipSuccess) { grid = -1; return; }
        if (hipFuncSetAttribute((const void*)hymba_fwd, hipFuncAttributeMaxDynamicSharedMemorySize, LDS_BYTES) != hipSuccess) { fprintf(stderr, "kernel_launch: hipFuncSetAttribute failed\n"); grid = -1; return; }
        if (hipOccupancyMaxActiveBlocksPerMultiprocessor(&per_cu, (const void*)hymba_fwd, 512, LDS_BYTES) != hipSuccess || per_cu < 1) fprintf(stderr, "kernel_launch: occupancy query reports %d\n", per_cu);
        (void)hipGetLastError();
        grid = cus;
    }
    if (grid < 0) return;
    (void)in_sizes; (void)out_size;
    hipMemsetAsync((char*)d_ws + WS_CTL, 0, CTL_BYTES, stream);
    Params p{};
    for (int i = 0; i < 21; ++i) p.in[i] = (const float*)d_in[i];
    p.out = (float*)d_out; p.ws = (unsigned char*)d_ws; p.grid = grid; p.pad = 0;
#if ONE_LAUNCH
    p.ph_lo = 0; p.ph_hi = N_PHASES;
    hipLaunchKernelGGL(hymba_fwd, dim3(grid), dim3(512), LDS_BYTES, stream, p);
#else
    for (int k = 0; k < N_PHASES; ++k) { p.ph_lo = k; p.ph_hi = k + 1; hipLaunchKernelGGL(hymba_fwd, dim3(grid), dim3(512), LDS_BYTES, stream, p); }
#endif
}
```

```cpp
#ifndef EMU
#include <hip/hip_runtime.h>
#endif
#include <cstdio>
#include <cstdint>
#include <type_traits>

#ifndef CFG_BATCH
#define CFG_BATCH 2
#endif
#ifndef CFG_SEQ
#define CFG_SEQ 8192
#endif
#ifndef CFG_DM
#define CFG_DM 4096
#endif
#ifndef CFG_DFF
#define CFG_DFF 16384
#endif
#ifndef ONE_LAUNCH
#define ONE_LAUNCH 1
#endif

#ifdef EMU
#define LAS
#define GAS
#define WAIT_VM0() ((void)0)
#define WAIT_LGKM0() ((void)0)
#define WAVE_SYNC() emu::wave_barrier()
#define CFENCE() ((void)0)
#else
#define LAS __attribute__((address_space(3)))
#define GAS __attribute__((address_space(1)))
#define WAIT_VM0() asm volatile("s_waitcnt vmcnt(0)" ::: "memory")
#define WAIT_LGKM0() asm volatile("s_waitcnt lgkmcnt(0)" ::: "memory")
#define WAVE_SYNC() do { asm volatile("s_waitcnt lgkmcnt(0)" ::: "memory"); __builtin_amdgcn_wave_barrier(); asm volatile("" ::: "memory"); } while (0)
#define CFENCE() asm volatile("" ::: "memory")
#endif
#define DI __device__ __forceinline__
#ifndef ATT_FP8
#define ATT_FP8 1
#endif
#ifndef QKV_FP8
#define QKV_FP8 1
#endif
#ifndef UP_INT8
#define UP_INT8 3
#endif
#ifndef GATE_INT8
#define GATE_INT8 1
#endif
#ifndef GATE_FP8
#define GATE_FP8 1
#endif
#ifndef USE_NT
#define USE_NT 1
#endif
#if USE_NT
#define NT_LOAD(p) __builtin_nontemporal_load(p)
#else
#define NT_LOAD(p) (*(p))
#endif
#ifdef EMU
#define F8_PAD() ((void)0)
#else
#define F8_PAD() asm volatile("s_nop 15\n\ts_nop 15" ::: "memory")
#endif
#define PHASE_FN __device__ __forceinline__ void
#ifdef EMU
#define OPAQUE_V(x) ((void)0)
#define OPAQUE_S(x) ((void)0)
#else
#define OPAQUE_V(x) asm volatile("" : "+v"(x))
#define OPAQUE_S(x) asm volatile("" : "+s"(x))
#endif

namespace pg8 {
#define PG8_LAS LAS
typedef unsigned short bf16_t;
typedef short bf16x8 __attribute__((ext_vector_type(8)));
typedef float f32x4 __attribute__((ext_vector_type(4)));
typedef unsigned u32x4 __attribute__((ext_vector_type(4)));
typedef int i32x4_t __attribute__((ext_vector_type(4)));
typedef int v8i_t __attribute__((ext_vector_type(8)));
constexpr int BM = 256, BK = 64, HALF = 128, HTB = HALF * BK * 2  , STAGE_BYTES = 8 * HTB, NXCD = 8, WGM = 8;

__host__ __device__ __forceinline__ int lds_byte(int r, int c) { const int st = (r >> 4) * 2 + (c >> 5), rr = r & 15, cc = c & 31, ob = rr * 64 + cc * 2; return st * 1024 + (ob ^ (((ob >> 9) & 1) << 5)); }
__host__ __device__ __forceinline__ void stage_rc(int b, int& R, int& C) { const int st = b / 1024, sb = b % 1024, swz = sb ^ (((sb >> 9) & 1) << 5); R = (st >> 1) * 16 + swz / 64; C = (st & 1) * 32 + (swz % 64) / 2; }
__host__ __device__ __forceinline__ int perm32(int rho) { const int n = rho >> 4, i = rho & 15; return 8 * (i >> 2) + 4 * n + (i & 3); }

struct Unit { int pm, pn; };
struct Gemm { const bf16_t* A; const bf16_t* Bt; int M, N, K; };

struct StaticOrder {
    int nM, nN, nwg, G, c;
    __host__ __device__ void init(int M, int N, int G_, int c_) { nM = M / BM; nN = N / BM; nwg = nM * nN; G = G_; c = c_; }
    __host__ __device__ bool next(int i, Unit& u) const {
        const long L = (long)i * G + c; if (L >= nwg) return false;
        int wgid = (int)L; { const int q = nwg / NXCD, r = nwg % NXCD, xcd = wgid % NXCD, off = wgid / NXCD; wgid = (xcd < r ? xcd * (q + 1) : r * (q + 1) + (xcd - r) * q) + off; }
        const int nig = WGM * nN, gid = wgid / nig, fm = gid * WGM, gsz = (nM - fm) < WGM ? (nM - fm) : WGM;
        u.pm = fm + ((wgid % nig) % gsz); u.pn = (wgid % nig) / gsz; return true;
    }
    __device__ __forceinline__ void a_ready(const Unit&) const {}
    __device__ __forceinline__ void done(const Unit&) const {}
};


#ifdef EMU
__device__ __forceinline__ unsigned cvt_pk_bf16(float lo, float hi) { unsigned a = __float_as_uint(lo), b = __float_as_uint(hi); a = (a + 0x7fffu + ((a >> 16) & 1u)) >> 16; b = (b + 0x7fffu + ((b >> 16) & 1u)) >> 16; return a | (b << 16); }
#else
__device__ __forceinline__ unsigned cvt_pk_bf16(float lo, float hi) { unsigned r; asm volatile("v_cvt_pk_bf16_f32 %0, %1, %2" : "=v"(r) : "v"(lo), "v"(hi)); return r; }
#endif
typedef unsigned u32x2 __attribute__((ext_vector_type(2)));
template <int ACT> struct EpiBf16 {
    static constexpr bool PERM = true, AFTER_DRAIN = false;
    bf16_t* O; int ldc;
    __device__ __forceinline__ void operator()(const f32x4 (&acc)[2][2][4][2], const Unit& u, int wr, int wc, int fr, int fq) const {
        const int row0 = u.pm * BM + wr * 64 + fr, col0 = u.pn * BM + wc * 32 + 8 * fq;
#pragma unroll
        for (int ai = 0; ai < 2; ++ai)
#pragma unroll
            for (int m = 0; m < 4; ++m) { bf16_t* rowp = O + (size_t)(row0 + ai * HALF + m * 16) * ldc + col0;
#pragma unroll
                for (int bj = 0; bj < 2; ++bj) { f32x4 v0 = acc[ai][bj][m][0], v1 = acc[ai][bj][m][1];
                    if (ACT == 1) {
#pragma unroll
                        for (int j = 0; j < 4; ++j) { const float a = v0[j] > 0.f ? v0[j] : 0.f, b = v1[j] > 0.f ? v1[j] : 0.f; v0[j] = a * a; v1[j] = b * b; } }
                    if (ACT == 2) { v0 = v0 * 0.015625f; v1 = v1 * 0.015625f; }
                    u32x4 w; w.x = cvt_pk_bf16(v0[0], v0[1]); w.y = cvt_pk_bf16(v0[2], v0[3]); w.z = cvt_pk_bf16(v1[0], v1[1]); w.w = cvt_pk_bf16(v1[2], v1[3]);
                    *(u32x4*)(rowp + bj * HALF) = w; } }
    }
};
template <bool I8> struct AccSel { typedef f32x4 type; };
template <> struct AccSel<true> { typedef i32x4_t type; };
template <int ACT  > struct EpiI8 {
    static constexpr bool PERM = true, AFTER_DRAIN = false;
    bf16_t* O; int ldc; const float* sa; const float* sw;
    __device__ __forceinline__ void operator()(const i32x4_t (&acc)[2][2][4][2], const Unit& u, int wr, int wc, int fr, int fq) const {
        const int row0 = u.pm * BM + wr * 64 + fr, col0 = u.pn * BM + wc * 32 + 8 * fq;
        f32x4 cs[2][2];
#pragma unroll
        for (int bj = 0; bj < 2; ++bj) { cs[bj][0] = *(const f32x4*)(sw + col0 + bj * HALF); cs[bj][1] = *(const f32x4*)(sw + col0 + bj * HALF + 4); }
#pragma unroll
        for (int ai = 0; ai < 2; ++ai)
#pragma unroll
            for (int m = 0; m < 4; ++m) { const int row = row0 + ai * HALF + m * 16; const float ra = sa[row]; bf16_t* rowp = O + (size_t)row * ldc + col0;
#pragma unroll
                for (int bj = 0; bj < 2; ++bj) { f32x4 v0, v1;
#pragma unroll
                    for (int j = 0; j < 4; ++j) { const float a = (float)acc[ai][bj][m][0][j] * ra * cs[bj][0][j], b = (float)acc[ai][bj][m][1][j] * ra * cs[bj][1][j];
                        if (ACT == 1) { const float ap = fmaxf(a, 0.f), bp = fmaxf(b, 0.f); v0[j] = ap * ap; v1[j] = bp * bp; } else { v0[j] = a; v1[j] = b; } }
                    u32x4 w; w.x = cvt_pk_bf16(v0[0], v0[1]); w.y = cvt_pk_bf16(v0[2], v0[3]); w.z = cvt_pk_bf16(v1[0], v1[1]); w.w = cvt_pk_bf16(v1[2], v1[3]);
                    *(u32x4*)(rowp + bj * HALF) = w; } }
    }
};
template <bool GATE> struct EpiRes {
    static constexpr bool PERM = false, AFTER_DRAIN = false;
    const float* base; float* out; int ldc; float alpha; const bf16_t* emb;
    __device__ __forceinline__ void operator()(const f32x4 (&acc)[2][2][4][2], const Unit& u, int wr, int wc, int fr, int fq) const {
        const int row0 = u.pm * BM + wr * 64 + fr, col0 = u.pn * BM + wc * 32 + 4 * fq;
#pragma unroll
        for (int ai = 0; ai < 2; ++ai)
#pragma unroll
            for (int m = 0; m < 4; ++m) { const size_t off = (size_t)(row0 + ai * HALF + m * 16) * ldc + col0;
#pragma unroll
                for (int bj = 0; bj < 2; ++bj)
#pragma unroll
                    for (int n = 0; n < 2; ++n) { const size_t o = off + bj * HALF + n * 16; const f32x4 bs = *(const f32x4*)(base + o); f32x4 v = acc[ai][bj][m][n];
                        if (GATE) { const u32x2 e = *(const u32x2*)(emb + o);
                            const float e0 = __uint_as_float(e.x << 16), e1 = __uint_as_float(e.x & 0xffff0000u), e2 = __uint_as_float(e.y << 16), e3 = __uint_as_float(e.y & 0xffff0000u);
                            v[0] = e0 / (1.f + __expf(-v[0])); v[1] = e1 / (1.f + __expf(-v[1])); v[2] = e2 / (1.f + __expf(-v[2])); v[3] = e3 / (1.f + __expf(-v[3])); }
                        *(f32x4*)(out + o) = bs * alpha + v; } }
    }
};

#ifdef EMU
__device__ __forceinline__ void mfma_f8_acc(f32x4& c, v8i_t a, v8i_t b, int) { c = __builtin_amdgcn_mfma_scale_f32_16x16x128_f8f6f4(a, b, c, 0, 0, 0, 0x7f7f7f7f, 0, 0x7f7f7f7f); }
#else
__device__ __forceinline__ void mfma_f8_acc(f32x4& c, v8i_t a, v8i_t b, int sc) { asm volatile("v_mfma_scale_f32_16x16x128_f8f6f4 %0, %1, %2, %0, %3, %3 op_sel_hi:[0,0,0]" : "+v"(c) : "v"(a), "v"(b), "v"(sc)); }
#endif
#ifdef EMU
__device__ __forceinline__ void mfma_f8_acc2(f32x4& c, v8i_t a, v8i_t b, int sa, int sb, int, int) { c = __builtin_amdgcn_mfma_scale_f32_16x16x128_f8f6f4(a, b, c, 0, 0, 0, sa, 0, sb); }
#else
__device__ __forceinline__ void mfma_f8_acc2(f32x4& c, v8i_t a, v8i_t b, int, int, int va, int vb) { asm volatile("v_mfma_scale_f32_16x16x128_f8f6f4 %0, %1, %2, %0, %3, %4 op_sel_hi:[0,0,0]" : "+v"(c) : "v"(a), "v"(b), "v"(va), "v"(vb)); }
#endif
template <class Epi, class Sched, bool ALIGN_EPI = false, bool SP2 = false, int QM = 0>
__device__ __forceinline__ void gemm_phase(PG8_LAS unsigned char* lds, const Gemm g, const Sched& S, const Epi& E) {
    int tid_o = threadIdx.x; OPAQUE_V(tid_o);
    constexpr bool MX = (QM == 3), F8 = (QM == 1) || MX, I8 = (QM == 2); typedef typename AccSel<I8>::type acc_v;
    constexpr int NT8 = 12;
    const int tid = tid_o, wid = __builtin_amdgcn_readfirstlane(tid >> 6), lane = tid & 63, wr = wid >> 2, wc = wid & 3, fr = lane & 15, fq = lane >> 4;
    const int K = g.K, nt = K / BK;
    unsigned voffA[2], voffB[2];
#pragma unroll
    for (int i = 0; i < 2; ++i) { int R, C; stage_rc(tid * 16 + i * 8192, R, C); const int Rb = Epi::PERM ? ((R & ~31) + perm32(R & 31)) : R;
        voffA[i] = (unsigned)(R * K + C) * 2u; voffB[i] = (unsigned)(Rb * K + C) * 2u; }
    const size_t kstep = (size_t)(BK * 2);
    const size_t hstep = (size_t)HALF * K * 2;
    const size_t tstep = 2 * hstep;
    const unsigned ldsw = (unsigned)wid * 1024u;
    const int aoff = lds_byte(wr * 64 + fr, fq * 8), boff = lds_byte(wc * 32 + fr, fq * 8);
#define PG8_SA(b, h) (((b) * 2 + (h)) * HTB)
#define PG8_SB(b, h) ((4 + (b) * 2 + (h)) * HTB)
#define PG8_STAGE(bufoff, gbase, voff) do { _Pragma("unroll") for (int _i = 0; _i < 2; ++_i) \
        __builtin_amdgcn_global_load_lds((const unsigned*)((const char*)(gbase) + (voff)[_i]), (PG8_LAS unsigned*)(lds + (bufoff) + ldsw + _i * 8192), 16, 0, 0); } while (0)
#define PG8_LDA(dst, b, h) do { if constexpr (F8) { _Pragma("unroll") for (int m = 0; m < 4; ++m) dst##8[m] = __builtin_shufflevector(*(const PG8_LAS i32x4_t*)(lds + PG8_SA(b, h) + aoff + m * 2048), *(const PG8_LAS i32x4_t*)(lds + PG8_SA(b, h) + aoff + m * 2048 + 1024), 0, 1, 2, 3, 4, 5, 6, 7); } \
        else { _Pragma("unroll") for (int m = 0; m < 4; ++m) _Pragma("unroll") for (int k = 0; k < 2; ++k) dst[m][k] = *(const PG8_LAS bf16x8*)(lds + PG8_SA(b, h) + aoff + m * 2048 + k * 1024); } } while (0)
#define PG8_LDB(dst, b, h) do { if constexpr (F8) { _Pragma("unroll") for (int n = 0; n < 2; ++n) dst##8[n] = __builtin_shufflevector(*(const PG8_LAS i32x4_t*)(lds + PG8_SB(b, h) + boff + n * 2048), *(const PG8_LAS i32x4_t*)(lds + PG8_SB(b, h) + boff + n * 2048 + 1024), 0, 1, 2, 3, 4, 5, 6, 7); } \
        else { _Pragma("unroll") for (int n = 0; n < 2; ++n) _Pragma("unroll") for (int k = 0; k < 2; ++k) dst[n][k] = *(const PG8_LAS bf16x8*)(lds + PG8_SB(b, h) + boff + n * 2048 + k * 1024); } } while (0)
#ifndef GEMM_PRIO
#define GEMM_PRIO 1
#endif
#define PG8_MMA(ai, bj, At, Bt) do { if (GEMM_PRIO) __builtin_amdgcn_s_setprio(GEMM_PRIO); \
        if constexpr (MX) { if constexpr (mx8) { _Pragma("unroll") for (int m = 0; m < 4; ++m) _Pragma("unroll") for (int n = 0; n < 2; ++n) mfma_f8_acc2(acc[ai][bj][m][n], Bt##8[n], At##8[m], 0x79797979, 0x7b7b7b7b, mx_sw, mx_sa); } \
            else { _Pragma("unroll") for (int m = 0; m < 4; ++m) _Pragma("unroll") for (int n = 0; n < 2; ++n) { \
                acc[ai][bj][m][n] = __builtin_amdgcn_mfma_f32_16x16x32_bf16(__builtin_bit_cast(bf16x8, __builtin_shufflevector(Bt##8[n], Bt##8[n], 0, 1, 2, 3)), __builtin_bit_cast(bf16x8, __builtin_shufflevector(At##8[m], At##8[m], 0, 1, 2, 3)), acc[ai][bj][m][n], 0, 0, 0); \
                acc[ai][bj][m][n] = __builtin_amdgcn_mfma_f32_16x16x32_bf16(__builtin_bit_cast(bf16x8, __builtin_shufflevector(Bt##8[n], Bt##8[n], 4, 5, 6, 7)), __builtin_bit_cast(bf16x8, __builtin_shufflevector(At##8[m], At##8[m], 4, 5, 6, 7)), acc[ai][bj][m][n], 0, 0, 0); } } } \
        else if constexpr (F8) { _Pragma("unroll") for (int m = 0; m < 4; ++m) _Pragma("unroll") for (int n = 0; n < 2; ++n) \
            mfma_f8_acc(acc[ai][bj][m][n], Bt##8[n], At##8[m], f8_scale); } \
        else if constexpr (I8) { _Pragma("unroll") for (int m = 0; m < 4; ++m) _Pragma("unroll") for (int n = 0; n < 2; ++n) _Pragma("unroll") for (int k = 0; k < 2; ++k) \
            acc[ai][bj][m][n] = __builtin_amdgcn_mfma_i32_16x16x64_i8(__builtin_bit_cast(i32x4_t, Bt[n][k]), __builtin_bit_cast(i32x4_t, At[m][k]), acc[ai][bj][m][n], 0, 0, 0); } \
        else { _Pragma("unroll") for (int m = 0; m < 4; ++m) _Pragma("unroll") for (int n = 0; n < 2; ++n) _Pragma("unroll") for (int k = 0; k < 2; ++k) \
            acc[ai][bj][m][n] = __builtin_amdgcn_mfma_f32_16x16x32_bf16(Bt[n][k], At[m][k], acc[ai][bj][m][n], 0, 0, 0); } \
        if (GEMM_PRIO) __builtin_amdgcn_s_setprio(0); } while (0)
#ifdef EMU
#define PG8_WAIT_V(n) ((void)0)
#define PG8_WAIT_L(n) ((void)0)
#else
#define PG8_WAIT_V(n) asm volatile("s_waitcnt vmcnt(" #n ")" ::: "memory")
#define PG8_WAIT_L(n) asm volatile("s_waitcnt lgkmcnt(" #n ")" ::: "memory")
#endif
#define PG8_BAR __builtin_amdgcn_s_barrier()
#define PG8_SCHED __builtin_amdgcn_sched_barrier(0)
    Unit cur, nxt; int ui = 0;
    if (!S.next(0, cur)) return;
    acc_v acc[2][2][4][2];
#pragma unroll
    for (int a = 0; a < 2; ++a)
#pragma unroll
        for (int b = 0; b < 2; ++b)
#pragma unroll
            for (int m = 0; m < 4; ++m)
#pragma unroll
                for (int n = 0; n < 2; ++n) acc[a][b][m][n] = (acc_v){0, 0, 0, 0};
    int f8_scale = 0x7f7f7f7f; OPAQUE_V(f8_scale);
    int mx_sw = 0x79797979, mx_sa = 0x7b7b7b7b; OPAQUE_V(mx_sw); OPAQUE_V(mx_sa);
    bf16x8 At[4][2], B0[2][2], B1[2][2]; v8i_t At8[4], B08[2], B18[2];
    const char* cA = (const char*)g.A + (size_t)cur.pm * tstep; const char* cB = (const char*)g.Bt + (size_t)cur.pn * tstep;
    S.a_ready(cur);
    if constexpr (SP2) {
        PG8_STAGE(PG8_SB(0, 0), cB, voffB); PG8_STAGE(PG8_SB(0, 1), cB + hstep, voffB); PG8_STAGE(PG8_SA(0, 0), cA, voffA); PG8_STAGE(PG8_SA(0, 1), cA + hstep, voffA);
        if (wr == 1) PG8_BAR;
        PG8_WAIT_V(2); PG8_BAR;
        PG8_STAGE(PG8_SB(1, 0), cB + kstep, voffB); PG8_STAGE(PG8_SA(1, 0), cA + kstep, voffA); PG8_STAGE(PG8_SB(1, 1), cB + hstep + kstep, voffB);
        PG8_WAIT_V(6); PG8_BAR;
    } else {
        PG8_STAGE(PG8_SB(0, 0), cB, voffB); PG8_STAGE(PG8_SA(0, 0), cA, voffA); PG8_STAGE(PG8_SB(0, 1), cB + hstep, voffB); PG8_STAGE(PG8_SA(0, 1), cA + hstep, voffA);
        if (wr == 1) PG8_BAR;
        PG8_WAIT_V(4); PG8_BAR;
        PG8_STAGE(PG8_SB(1, 0), cB + kstep, voffB); PG8_STAGE(PG8_SA(1, 0), cA + kstep, voffA); PG8_STAGE(PG8_SB(1, 1), cB + hstep + kstep, voffB);
        PG8_WAIT_V(6); PG8_BAR;
    }
    for (;;) {
        const bool has_next = S.next(ui + 1, nxt);
        const char* nA = has_next ? (const char*)g.A + (size_t)nxt.pm * tstep : cA; const char* nB = has_next ? (const char*)g.Bt + (size_t)nxt.pn * tstep : cB;
        auto kiter = [&](auto mxtag, const int t) __attribute__((always_inline)) {
            constexpr bool mx8 = MX && decltype(mxtag)::value; (void)mx8;
            const bool last = (t == nt - 2);
            const char* a1 = cA + (size_t)(t + 1) * kstep;
            const char* a2 = last ? nA : cA + (size_t)(t + 2) * kstep; const char* b2 = last ? nB : cB + (size_t)(t + 2) * kstep;
            const char* a3 = a2 + kstep; const char* b3 = b2 + kstep;
            if (last && has_next) S.a_ready(nxt);
            if constexpr (SP2) {
            PG8_LDB(B0, 0, 0); PG8_LDB(B1, 0, 1); PG8_SCHED; PG8_LDA(At, 0, 0); PG8_STAGE(PG8_SA(1, 1), a1 + hstep, voffA);
            PG8_WAIT_V(8); PG8_WAIT_L(0); PG8_BAR; PG8_MMA(0, 0, At, B0); PG8_MMA(0, 1, At, B1); PG8_BAR; PG8_SCHED;
            PG8_LDA(At, 0, 1); PG8_STAGE(PG8_SB(0, 0), b2, voffB); PG8_STAGE(PG8_SB(0, 1), b2 + hstep, voffB); PG8_STAGE(PG8_SA(0, 0), a2, voffA);
            PG8_WAIT_V(8); PG8_WAIT_L(0); PG8_BAR; PG8_MMA(1, 0, At, B0); PG8_MMA(1, 1, At, B1); PG8_BAR; PG8_SCHED;
            PG8_LDB(B0, 1, 0); PG8_LDB(B1, 1, 1); PG8_SCHED; PG8_LDA(At, 1, 0); PG8_STAGE(PG8_SA(0, 1), a2 + hstep, voffA);
            PG8_WAIT_V(8); PG8_WAIT_L(0); PG8_BAR; PG8_MMA(0, 0, At, B0); PG8_MMA(0, 1, At, B1); PG8_BAR; PG8_SCHED;
            PG8_LDA(At, 1, 1); PG8_STAGE(PG8_SB(1, 0), b3, voffB); PG8_STAGE(PG8_SB(1, 1), b3 + hstep, voffB); PG8_STAGE(PG8_SA(1, 0), a3, voffA);
            PG8_WAIT_V(8); PG8_WAIT_L(0); PG8_BAR; PG8_MMA(1, 0, At, B0); PG8_MMA(1, 1, At, B1); PG8_BAR; PG8_SCHED;
            } else {
            PG8_LDB(B0, 0, 0); PG8_SCHED; PG8_LDA(At, 0, 0); PG8_STAGE(PG8_SA(1, 1), a1 + hstep, voffA);
            PG8_WAIT_L(8); PG8_BAR; PG8_WAIT_L(0); PG8_MMA(0, 0, At, B0); PG8_BAR; PG8_SCHED;
            PG8_LDB(B1, 0, 1); PG8_STAGE(PG8_SB(0, 0), b2, voffB);
            PG8_BAR; PG8_WAIT_L(0); PG8_MMA(0, 1, At, B1); PG8_BAR;
            PG8_LDA(At, 0, 1); PG8_STAGE(PG8_SA(0, 0), a2, voffA);
            PG8_BAR; PG8_WAIT_L(0); PG8_MMA(1, 0, At, B0); PG8_BAR; PG8_SCHED;
            PG8_STAGE(PG8_SB(0, 1), b2 + hstep, voffB);
            PG8_WAIT_V(6); PG8_BAR; PG8_MMA(1, 1, At, B1); PG8_BAR;
            PG8_LDB(B0, 1, 0); PG8_SCHED; PG8_LDA(At, 1, 0); PG8_STAGE(PG8_SA(0, 1), a2 + hstep, voffA);
            PG8_WAIT_L(8); PG8_BAR; PG8_WAIT_L(0); PG8_MMA(0, 0, At, B0); PG8_BAR; PG8_SCHED;
            PG8_LDB(B1, 1, 1); PG8_STAGE(PG8_SB(1, 0), b3, voffB);
            PG8_BAR; PG8_WAIT_L(0); PG8_MMA(0, 1, At, B1); PG8_BAR;
            PG8_LDA(At, 1, 1); PG8_STAGE(PG8_SA(1, 0), a3, voffA);
            PG8_BAR; PG8_WAIT_L(0); PG8_MMA(1, 0, At, B0); PG8_BAR; PG8_SCHED;
            PG8_STAGE(PG8_SB(1, 1), b3 + hstep, voffB);
            PG8_WAIT_V(6); PG8_BAR; PG8_MMA(1, 1, At, B1); PG8_BAR;
            }
        };
        if constexpr (MX) { for (int t = 0; t < NT8; t += 2) kiter(std::true_type{}, t); for (int t = NT8; t < nt; t += 2) kiter(std::false_type{}, t); }
        else { for (int t = 0; t < nt; t += 2) kiter(std::false_type{}, t); }
        if constexpr (ALIGN_EPI) { if (wr == 0) PG8_BAR; }
        if constexpr (F8) { F8_PAD(); }
        if constexpr (!Epi::AFTER_DRAIN) { E(acc, cur, wr, wc, fr, fq); S.done(cur); }
        if (!has_next) break;
#pragma unroll
        for (int a = 0; a < 2; ++a)
#pragma unroll
            for (int b = 0; b < 2; ++b)
#pragma unroll
                for (int m = 0; m < 4; ++m)
#pragma unroll
                    for (int n = 0; n < 2; ++n) acc[a][b][m][n] = (acc_v){0, 0, 0, 0};
        cur = nxt; cA = nA; cB = nB; ++ui;
        if constexpr (ALIGN_EPI) { if (wr == 1) PG8_BAR; }
    }
    PG8_WAIT_V(0);
    if constexpr (!ALIGN_EPI) { if (wr == 0) PG8_BAR; }
    PG8_BAR;
    if constexpr (Epi::AFTER_DRAIN) { E.fused(acc, cur, wr, wc, fr, fq, lds, wid, lane); S.done(cur); }
#undef PG8_SA
#undef PG8_SB
#undef PG8_STAGE
#undef PG8_LDA
#undef PG8_LDB
#undef PG8_MMA
#undef PG8_WAIT_V
#undef PG8_WAIT_L
#undef PG8_BAR
#undef PG8_SCHED
}
}


constexpr int BATCH = CFG_BATCH, SEQ = CFG_SEQ, DM = CFG_DM, DFF = CFG_DFF, DEPTH = 2;
constexpr int M = BATCH * SEQ, NCH = SEQ / 128;
constexpr int DMIX = 4096, DPLE = 256, D_IN = 11800;
constexpr int NU = 12032;
constexpr int UQ = 0, UK = 1536, UV = 3072, UZ = 4608, UX = 6144, UB = 7680, UC = 8192, USB = 8704, USC = 9728, USH = 10752, UDT = 11776;
constexpr float LN_EPS = 1e-5f, RMS_EPS = 1e-5f, DN_ALPHA = 1.41421356237f, ATT_SCALE = 0.08838834764831845f;
static_assert(SEQ % 2048 == 0 && M % 256 == 0 && DM % 256 == 0 && DFF % 256 == 0 && DM <= DMIX, "shape");
constexpr int NQKV = 4608, NREST = NU - NQKV;
constexpr size_t WINB_OFF = (size_t)NQKV * DM;
DI int remap_u(int n) { return n < 8704 ? n : (n < 8728 ? UDT + (n - 8704) : n - 24); }

constexpr int CAT_PITCH = ATT_FP8 ? 3328 : 4096;
constexpr int CAT_SSM = ATT_FP8 ? 768 : 1536, CAT_SC = CAT_SSM + 1536;
constexpr int ATT_PITCH = ATT_FP8 ? 1536 : CAT_PITCH;
typedef pg8::bf16_t bf16;
typedef pg8::f32x4 f32x4;
typedef pg8::u32x4 u32x4;
typedef pg8::bf16x8 bf16x8;
typedef pg8::u32x2 u32x2;
typedef short s16x4 __attribute__((ext_vector_type(4)));

constexpr size_t al256(size_t x) { return (x + 255) & ~(size_t)255; }
constexpr size_t WS_CTL = 0, CTL_BYTES = 1u << 20;
constexpr size_t WS_WIN = WS_CTL + CTL_BYTES;
constexpr size_t WS_WOUT = WS_WIN + al256((size_t)NU * DM * 2);
constexpr size_t WS_WUP = WS_WOUT + al256((size_t)DM * DMIX * 2);
constexpr size_t WS_WDN = WS_WUP + al256((size_t)DFF * DM * 2);
constexpr size_t WS_WGT = WS_WDN + al256((size_t)DM * DFF * 2);
constexpr size_t WS_WPE = WS_WGT + al256((size_t)DM * DM * 2);
constexpr size_t WS_XB = WS_WPE + al256((size_t)DM * DPLE * 2);
constexpr size_t WS_XF = WS_XB + al256((size_t)M * DM * 2);
constexpr size_t WS_CAT = WS_XF + al256((size_t)M * DM * 2);
constexpr size_t WS_PB = WS_CAT + al256((size_t)M * DMIX * 2);
constexpr size_t WS_LSE = WS_PB + al256((size_t)DEPTH * M * DPLE * 2);
constexpr size_t WS_ROPE = WS_LSE + al256((size_t)M * 12 * 4);
constexpr size_t WS_CD = WS_ROPE + al256((size_t)SEQ * 32 * 4);
constexpr size_t WS_EMB = WS_CD + al256((size_t)BATCH * NCH * 24 * 4);
constexpr size_t WS_YS = WS_EMB + al256((size_t)M * DM * 2);
constexpr size_t WS_XC = WS_YS + al256((size_t)256 * 6 * 16 * 512 * 4);
constexpr size_t WS_PVB = WS_XC + al256((size_t)M * 2560 * 2);
constexpr size_t WS_X8 = WS_PVB + al256((size_t)BATCH * NCH * 24 * 8192 * 2);
constexpr size_t WS_SA = WS_X8 + al256((size_t)M * DM);
constexpr size_t WS_SW = WS_SA + al256((size_t)M * 4);
constexpr size_t WS_SWG = WS_SW + al256((size_t)DFF * 4);
constexpr size_t WS_ATT = WS_SWG + al256((size_t)DM * 4);
constexpr size_t WS_BIG = WS_ATT + al256((size_t)M * 1536 * 2);
constexpr size_t BIG_U_BYTES = al256((size_t)M * NU * 2), BIG_ST_BYTES = al256((size_t)BATCH * NCH * 24 * 64 * 128 * 4), BIG_H_BYTES = al256((size_t)M * DFF * 2);
constexpr size_t BIG_BYTES = (BIG_U_BYTES + BIG_ST_BYTES) > BIG_H_BYTES ? (BIG_U_BYTES + BIG_ST_BYTES) : BIG_H_BYTES;
constexpr size_t WS_END = WS_BIG + BIG_BYTES;

constexpr int RING_BYTES = 139264;
constexpr int MISC_OFF = RING_BYTES;
constexpr int LDS_BYTES = 147456;

DI float bf2f(unsigned short b) { return __uint_as_float(((unsigned)b) << 16); }
DI unsigned short f2bf(float f) { unsigned u = __float_as_uint(f); return (unsigned short)((u + 0x7fffu + ((u >> 16) & 1u)) >> 16); }
DI unsigned pk2(float lo, float hi) { return (unsigned)f2bf(lo) | ((unsigned)f2bf(hi) << 16); }
DI float rcp_f(float x) { return __builtin_amdgcn_rcpf(x); }
DI float silu_f(float x) { return x * rcp_f(1.f + __expf(-x)); }
DI float softplus_f(float x) { return (x > 0.f ? x : 0.f) + log1pf(__expf(-fabsf(x))); }
#ifdef EMU
DI bf16x8 tr_read2(const bf16* p_lo, const bf16* p_hi) { const emu_s16x4 a = emu_tr_read_b64(p_lo), b = emu_tr_read_b64(p_hi); return __builtin_shufflevector(a, b, 0, 1, 2, 3, 4, 5, 6, 7); }
#else
DI bf16x8 tr_read2(const LAS bf16* p_lo, const LAS bf16* p_hi) { s16x4 a, b;
    asm volatile("ds_read_b64_tr_b16 %0, %2\n\tds_read_b64_tr_b16 %1, %3\n\ts_waitcnt lgkmcnt(0)" : "=&v"(a), "=&v"(b) : "v"((unsigned)(size_t)p_lo), "v"((unsigned)(size_t)p_hi) : "memory");
    return __builtin_shufflevector(a, b, 0, 1, 2, 3, 4, 5, 6, 7); }
#endif
#ifdef EMU
DI float shfl_f(float v, int src) { return emu::shfl_idx(v, src); }
#else
DI float shfl_f(float v, int src) { return __int_as_float(__builtin_amdgcn_ds_bpermute(src << 2, __float_as_int(v))); }
#endif
#ifdef EMU
DI int bcast_lane0(int v) { return emu::shfl_idx(v, 0); }
#else
DI int bcast_lane0(int v) { return __builtin_amdgcn_readfirstlane(v); }
#endif
DI float wave_sum(float v, int lane) {
#pragma unroll
    for (int o = 1; o < 64; o <<= 1) v += shfl_f(v, lane ^ o);
    return v; }
DI float wave_max(float v, int lane) {
#pragma unroll
    for (int o = 1; o < 64; o <<= 1) v = fmaxf(v, shfl_f(v, lane ^ o));
    return v; }

#ifdef EMU
DI unsigned char* ld_ws(unsigned char* p) { return p; }
DI float* ld_out(float* p) { return p; }
DI int ld_grid() { return (int)gridDim.x; }
#else
DI int ld_grid() { int v; asm volatile("s_load_dword %0, %1, 0xc0\n\ts_waitcnt lgkmcnt(0)" : "=s"(v) : "s"(__builtin_amdgcn_kernarg_segment_ptr())); return v; }
DI unsigned long long karg_u64_168() { unsigned long long v; asm volatile("s_load_dwordx2 %0, %1, 0xa8\n\ts_waitcnt lgkmcnt(0)" : "=s"(v) : "s"(__builtin_amdgcn_kernarg_segment_ptr())); return v; }
DI unsigned long long karg_u64_176() { unsigned long long v; asm volatile("s_load_dwordx2 %0, %1, 0xb0\n\ts_waitcnt lgkmcnt(0)" : "=s"(v) : "s"(__builtin_amdgcn_kernarg_segment_ptr())); return v; }
DI unsigned char* ld_ws(unsigned char*) { return (unsigned char*)(GAS unsigned char*)karg_u64_176(); }
DI float* ld_out(float*) { return (float*)(GAS float*)karg_u64_168(); }
#endif
#define XB_TMO      128
#define XB_XCNT(j)  (256  + 64 * (j))
#define XB_XSUB(j)  (1280 + 64 * (j))
#define XB_XGEN(j)  (2304 + 64 * (j))
#define XB_TOP      3328
#define XB_TOPGEN   3392
#define XCD_BAR_WORDS 3456
#define XB_SPIN_CAP (1u << 18)

__device__ __forceinline__ unsigned xb_ld(unsigned* p)              { return __hip_atomic_load(p, __ATOMIC_RELAXED, __HIP_MEMORY_SCOPE_AGENT); }
__device__ __forceinline__ unsigned xb_add(unsigned* p, unsigned v) { return __hip_atomic_fetch_add(p, v, __ATOMIC_RELAXED, __HIP_MEMORY_SCOPE_AGENT); }
__device__ __forceinline__ unsigned xb_xcc_id() { return (unsigned)__builtin_amdgcn_s_getreg((3 << 11) | 20) & 0xFu; }
#define XB_SPIN(cond, bar) do { unsigned _sp = 0; while (cond) { __builtin_amdgcn_s_sleep(1); \
    if ((++_sp & 255u) == 0u) { if (xb_ld(&(bar)[XB_TMO])) break; if (_sp > XB_SPIN_CAP) { atomicAdd(&(bar)[XB_TMO], 1u); break; } } } } while (0)

struct XcdBarrier {
    unsigned* bar; unsigned x;
    volatile LAS unsigned* st;
};

__device__ __forceinline__ XcdBarrier xcd_barrier_post(unsigned* bar, volatile LAS unsigned* st) {
    XcdBarrier b; b.bar = bar; b.x = xb_xcc_id(); b.st = st;
    if (threadIdx.x == 0) (void)xb_add(&bar[XB_XCNT(b.x)], 1u);
    return b;
}
__device__ __forceinline__ void xcd_barrier_complete(unsigned* bar, unsigned x, unsigned& nloc, unsigned& nx) {
    const unsigned G = (unsigned)ld_grid();
    unsigned sum, cnt, mine, sp = 0u;
    for (;;) {
        sum = 0u; cnt = 0u; mine = 0u;
#pragma unroll
        for (unsigned j = 0; j < 16; ++j) { const unsigned c = xb_ld(&bar[XB_XCNT(j)]); sum += c; cnt += (c > 0u) ? 1u : 0u; mine = (j == x) ? c : mine; }
        if (sum == G) break;
        __builtin_amdgcn_s_sleep(1);
        if ((++sp & 255u) == 0u) { if (xb_ld(&bar[XB_TMO])) break; if (sp > XB_SPIN_CAP) { atomicAdd(&bar[XB_TMO], 1u); break; } }
    }
    nloc = mine > 0u ? mine : 1u; nx = cnt > 0u ? cnt : 1u;
}

__device__ __forceinline__ void xcd_barrier(const XcdBarrier& b) {
    WAIT_VM0();
    __syncthreads();
    if (threadIdx.x == 0) {
        unsigned* bar = b.bar;
        __builtin_amdgcn_s_waitcnt(0);
        unsigned nloc = b.st[0], nx = b.st[1];
        if (nloc == 0u) { xcd_barrier_complete(bar, b.x, nloc, nx); b.st[0] = nloc; b.st[1] = nx; }
        const unsigned old = xb_add(&bar[XB_XSUB(b.x)], 1u);
        const unsigned gen = old / nloc;
        if (old + 1u == (gen + 1u) * nloc) {
            __builtin_amdgcn_fence(__ATOMIC_RELEASE, "agent");
            WAIT_VM0();
            const unsigned og = xb_add(&bar[XB_TOP], 1u);
            const unsigned tg = og / nx;
            if (og + 1u == (tg + 1u) * nx) xb_add(&bar[XB_TOPGEN], 1u);
            else XB_SPIN(xb_ld(&bar[XB_TOPGEN]) == tg, bar);
            __builtin_amdgcn_fence(__ATOMIC_ACQUIRE, "agent");
            xb_add(&bar[XB_XGEN(b.x)], 1u);
            WAIT_VM0();
        } else {
            XB_SPIN(xb_ld(&bar[XB_XGEN(b.x)]) == gen, bar);
            __builtin_amdgcn_fence(__ATOMIC_ACQUIRE, "agent");
            WAIT_VM0();
        }
    }
    __syncthreads();
}

constexpr int PTAB_OFF = MISC_OFF + 256;
DI const float* inp(LAS unsigned char* lds, int i) { const LAS unsigned* t = (const LAS unsigned*)(lds + PTAB_OFF) + 2 * i;
    const unsigned lo = __builtin_amdgcn_readfirstlane(t[0]), hi = __builtin_amdgcn_readfirstlane(t[1]); return (const float*)(const GAS float*)(((unsigned long long)hi << 32) | (unsigned long long)lo); }
DI unsigned char* opq(unsigned char* p) { unsigned lo = __builtin_amdgcn_readfirstlane((unsigned)(size_t)p), hi = __builtin_amdgcn_readfirstlane((unsigned)((size_t)p >> 32)); OPAQUE_S(lo); OPAQUE_S(hi); return (unsigned char*)(GAS unsigned char*)(((size_t)hi << 32) | (size_t)lo); }
struct Params { const float* in[21]; float* out; unsigned char* ws; int ph_lo, ph_hi; int grid, pad; };
enum { I_X = 0, I_P, I_WIN, I_CW, I_CB, I_DTB, I_ALOG, I_SD, I_NW, I_SCW, I_WOUT, I_L1G, I_L1B, I_WUP, I_WDN, I_L2G, I_L2B, I_WPE, I_WGT, I_L3G, I_L3B };

template <bool REMAP> DI void transpose_item(const float* W, int K, int N, bf16* WT, LAS float* scr, int item, int lane, int row_off = 0, int dpitch = 0, int koff = 0) {
    const int nblk = (N + 63) / 64, kb = item / nblk, nb = item % nblk, k0 = 64 * kb, n0 = 64 * nb;
    const int r4 = lane >> 4, c4 = lane & 15, nl = n0 + 4 * c4;
    f32x4 v[16];
#pragma unroll
    for (int i = 0; i < 16; ++i) v[i] = nl < N ? NT_LOAD((const f32x4*)(W + (size_t)(k0 + 4 * i + r4) * N + nl)) : (f32x4){0.f, 0.f, 0.f, 0.f};
#pragma unroll
    for (int i = 0; i < 16; ++i) { LAS float* d = scr + (4 * i + r4) * 65 + 4 * c4; d[0] = v[i][0]; d[1] = v[i][1]; d[2] = v[i][2]; d[3] = v[i][3]; }
    WAVE_SYNC();
#pragma unroll
    for (int j = 0; j < 8; ++j) { const int chunk = lane + 64 * j, nn = chunk >> 3, kc = chunk & 7, n = n0 + nn; const LAS float* s = scr + (8 * kc) * 65 + nn;
        u32x4 o; o.x = pk2(s[0 * 65], s[1 * 65]); o.y = pk2(s[2 * 65], s[3 * 65]); o.z = pk2(s[4 * 65], s[5 * 65]); o.w = pk2(s[6 * 65], s[7 * 65]);
        if (n < N) { const int row = (REMAP ? remap_u(n) : n) - row_off; *(u32x4*)(WT + (size_t)row * (dpitch ? dpitch : K) + k0 + koff + 8 * kc) = o; } }
    WAVE_SYNC();
}
DI unsigned pk4_fp8(float a, float b, float c, float d) { int w = 0; w = __builtin_amdgcn_cvt_pk_fp8_f32(a, b, w, false); w = __builtin_amdgcn_cvt_pk_fp8_f32(c, d, w, true); return (unsigned)w; }
DI void transpose_item_fp8(const float* W, int K, int N, unsigned char* WT8, LAS float* scr, int item, int lane, int dpitch = 0) {
    const int nblk = (N + 63) / 64, kb = item / nblk, nb = item % nblk, k0 = 64 * kb, n0 = 64 * nb;
    const int r4 = lane >> 4, c4 = lane & 15, nl = n0 + 4 * c4;
    f32x4 v[16];
#pragma unroll
    for (int i = 0; i < 16; ++i) v[i] = nl < N ? NT_LOAD((const f32x4*)(W + (size_t)(k0 + 4 * i + r4) * N + nl)) : (f32x4){0.f, 0.f, 0.f, 0.f};
#pragma unroll
    for (int i = 0; i < 16; ++i) { LAS float* d = scr + (4 * i + r4) * 65 + 4 * c4; d[0] = v[i][0]; d[1] = v[i][1]; d[2] = v[i][2]; d[3] = v[i][3]; }
    WAVE_SYNC();
#pragma unroll
    for (int j = 0; j < 4; ++j) { const int chunk = lane + 64 * j, nn = chunk >> 2, kc = chunk & 3, n = n0 + nn; const LAS float* s = scr + (16 * kc) * 65 + nn;
        u32x4 o;
#pragma unroll
        for (int e = 0; e < 4; ++e) o[e] = pk4_fp8(s[(4 * e) * 65] * 64.f, s[(4 * e + 1) * 65] * 64.f, s[(4 * e + 2) * 65] * 64.f, s[(4 * e + 3) * 65] * 64.f);
        if (n < N) *(u32x4*)(WT8 + (size_t)n * (dpitch ? dpitch : K) + k0 + 16 * kc) = o; }
    WAVE_SYNC();
}
DI void upq_strips(const float* W, int K, int N, signed char* WT8, float* sw_out, LAS unsigned char* lds, int BID, int GSZ, int wave, int lane) {
    LAS float* scr = (LAS float*)(lds + wave * 16640); LAS float* cmx = (LAS float*)(lds + 8 * 16640); LAS float* inv = cmx + 8 * 64;
    const int r4 = lane >> 4, c4 = lane & 15, ntile = K / 64;
    for (int s = BID; s < N / 64; s += GSZ) { const int n0 = 64 * s;
        f32x4 mx = {0.f, 0.f, 0.f, 0.f};
        for (int kb = wave; kb < ntile; kb += 16) {
            f32x4 v[2][16]; const bool two = kb + 8 < ntile;
#pragma unroll
            for (int i = 0; i < 16; ++i) { v[0][i] = *(const f32x4*)(W + (size_t)(64 * kb + 4 * i + r4) * N + n0 + 4 * c4); v[1][i] = two ? *(const f32x4*)(W + (size_t)(64 * (kb + 8) + 4 * i + r4) * N + n0 + 4 * c4) : (f32x4){0.f, 0.f, 0.f, 0.f}; }
#pragma unroll
            for (int i = 0; i < 16; ++i)
#pragma unroll
                for (int e = 0; e < 4; ++e) mx[e] = fmaxf(mx[e], fmaxf(fabsf(v[0][i][e]), fabsf(v[1][i][e]))); }
#pragma unroll
        for (int e = 0; e < 4; ++e) { mx[e] = fmaxf(mx[e], shfl_f(mx[e], lane ^ 16)); mx[e] = fmaxf(mx[e], shfl_f(mx[e], lane ^ 32)); }
        if (r4 == 0) { cmx[wave * 64 + 4 * c4] = mx[0]; cmx[wave * 64 + 4 * c4 + 1] = mx[1]; cmx[wave * 64 + 4 * c4 + 2] = mx[2]; cmx[wave * 64 + 4 * c4 + 3] = mx[3]; }
        __syncthreads();
        if (wave == 0) { float m = 0.f;
#pragma unroll
            for (int w = 0; w < 8; ++w) m = fmaxf(m, cmx[w * 64 + lane]);
            m = fmaxf(m, 1e-30f); inv[lane] = 127.f / m; sw_out[n0 + lane] = m * (1.f / 127.f); }
        __syncthreads();
        f32x4 v[16];
#pragma unroll
        for (int i = 0; i < 16; ++i) v[i] = *(const f32x4*)(W + (size_t)(64 * wave + 4 * i + r4) * N + n0 + 4 * c4);
        for (int kb = wave; kb < ntile; kb += 8) { const int k0 = 64 * kb;
#pragma unroll
            for (int i = 0; i < 16; ++i) { LAS float* d = scr + (4 * i + r4) * 65 + 4 * c4; d[0] = v[i][0]; d[1] = v[i][1]; d[2] = v[i][2]; d[3] = v[i][3]; }
            if (kb + 8 < ntile) {
#pragma unroll
                for (int i = 0; i < 16; ++i) v[i] = *(const f32x4*)(W + (size_t)(k0 + 512 + 4 * i + r4) * N + n0 + 4 * c4); }
            WAVE_SYNC();
#pragma unroll
            for (int j = 0; j < 4; ++j) { const int chunk = lane + 64 * j, nn = chunk >> 2, kc = chunk & 3; const LAS float* sp = scr + (16 * kc) * 65 + nn; const float iv = inv[nn];
                u32x4 o;
#pragma unroll
                for (int e = 0; e < 4; ++e) { unsigned w = 0;
#pragma unroll
                    for (int b = 0; b < 4; ++b) w |= ((unsigned)(__float2int_rn(sp[(4 * e + b) * 65] * iv) & 0xff)) << (8 * b);
                    o[e] = w; }
                *(u32x4*)(WT8 + (size_t)(n0 + nn) * K + k0 + 16 * kc) = o; }
            WAVE_SYNC(); }
        __syncthreads();
    }
}
PHASE_FN phase_weights(unsigned char* wsarg, int L, LAS unsigned char* lds, int qsel = 0) {
    int BID = blockIdx.x, GSZ = ld_grid(); OPAQUE_S(BID); OPAQUE_S(GSZ); OPAQUE_S(lds);
    unsigned char* const WSQ = ld_ws(wsarg);
    int tid_o = threadIdx.x; OPAQUE_V(tid_o);
    const int tid = tid_o, lane = tid & 63, wave = __builtin_amdgcn_readfirstlane(tid >> 6);
    LAS float* scr = (LAS float*)(lds + wave * 16640);
    const int gw = BID * 8 + wave, NGW = GSZ * 8;
    unsigned char* ws = WSQ;
    const float* win = inp(lds, I_WIN) + (size_t)L * DM * D_IN; const float* wout = inp(lds, I_WOUT) + (size_t)L * DMIX * DM; const float* wup = inp(lds, I_WUP) + (size_t)L * DM * DFF;
    const float* wdn = inp(lds, I_WDN) + (size_t)L * DFF * DM; const float* wgt = inp(lds, I_WGT) + (size_t)L * DM * DM; const float* wpe = inp(lds, I_WPE) + (size_t)L * DPLE * DM;
    constexpr int I_1 = (DM / 64) * ((D_IN + 63) / 64), I_2 = (DMIX / 64) * (DM / 64), I_3 = (DM / 64) * (DFF / 64), I_4 = (DFF / 64) * (DM / 64), I_5 = (DM / 64) * (DM / 64), I_6 = (DPLE / 64) * (DM / 64);
    static_assert(8 * 16640 + 8 * 64 * 4 + 256 <= RING_BYTES && D_IN % 4 == 0 && DM % 64 == 0 && DFF % 64 == 0, "weights phase tiles");
    constexpr int NIT = I_1 + I_2 + I_3 + I_4 + I_5 + I_6;
    if ((UP_INT8 >> L) & 1) upq_strips(wup, DM, DFF, (signed char*)(ws + WS_WUP), (float*)(ws + WS_SW), lds, BID, GSZ, wave, lane);
    if (GATE_INT8) upq_strips(wgt, DM, DM, (signed char*)(ws + WS_WGT), (float*)(ws + WS_SWG), lds, (BID + GSZ / 2) % GSZ, GSZ, wave, lane);
    unsigned* qctr = (unsigned*)(ws + WS_CTL) + 12288 + 64 * (2 * L + (int)(qsel & 1)); (void)gw; (void)NGW;
    for (;;) { unsigned c0 = 0; if (lane == 0) c0 = __hip_atomic_fetch_add(qctr, 16u, __ATOMIC_RELAXED, __HIP_MEMORY_SCOPE_AGENT);
      c0 = (unsigned)bcast_lane0((int)c0); if (c0 >= (unsigned)NIT) break;
      for (int it = (int)c0; it < (int)c0 + 16 && it < NIT; ++it) {
        int r = it;
        if (r < I_1) { if (QKV_FP8) { if (r % ((D_IN + 63) / 64) < NQKV / 64) transpose_item_fp8(win, DM, D_IN, ws + WS_WIN, scr, r, lane); else transpose_item<true>(win, DM, D_IN, (bf16*)(ws + WS_WIN + WINB_OFF), scr, r, lane, NQKV); }
                       else transpose_item<true>(win, DM, D_IN, (bf16*)(ws + WS_WIN), scr, r, lane); continue; } r -= I_1;
        if (r < I_2) { if (ATT_FP8) { if (r / (DM / 64) < 1536 / 64) transpose_item_fp8(wout, DMIX, DM, ws + WS_WOUT, scr, r, lane, CAT_PITCH * 2); else transpose_item<false>(wout, DMIX, DM, (bf16*)(ws + WS_WOUT), scr, r, lane, 0, CAT_PITCH, -768); }
                       else transpose_item<false>(wout, DMIX, DM, (bf16*)(ws + WS_WOUT), scr, r, lane); continue; } r -= I_2;
        if (r < I_3) { if (!((UP_INT8 >> L) & 1)) transpose_item<false>(wup, DM, DFF, (bf16*)(ws + WS_WUP), scr, r, lane); continue; } r -= I_3;
        if (r < I_4) { transpose_item<false>(wdn, DFF, DM, (bf16*)(ws + WS_WDN), scr, r, lane); continue; } r -= I_4;
        if (r < I_5) { if (GATE_INT8) {} else if (GATE_FP8) transpose_item_fp8(wgt, DM, DM, ws + WS_WGT, scr, r, lane); else transpose_item<false>(wgt, DM, DM, (bf16*)(ws + WS_WGT), scr, r, lane); continue; } r -= I_5;
        transpose_item<false>(wpe, DPLE, DM, (bf16*)(ws + WS_WPE), scr, r, lane);
      } }
    const size_t gt = (size_t)BID * 512 + tid, GT = (size_t)GSZ * 512;
    if (L == 0) {
        { u32x4* z = QKV_FP8 ? (u32x4*)((bf16*)(ws + WS_WIN + WINB_OFF) + (size_t)(D_IN - NQKV) * DM) : (u32x4*)((bf16*)(ws + WS_WIN) + (size_t)D_IN * DM); const size_t n16 = (size_t)(NU - D_IN) * DM / 8; for (size_t i = gt; i < n16; i += GT) z[i] = (u32x4){0u, 0u, 0u, 0u}; }
        { const f32x4* x4 = (const f32x4*)inp(lds, I_X); u32x2* o = (u32x2*)(ws + WS_XB); unsigned* o8 = (unsigned*)(ws + WS_X8); for (size_t i = gt; i < (size_t)M * DM / 4; i += GT) { const f32x4 v = x4[i]; u32x2 w; w.x = pk2(v[0], v[1]); w.y = pk2(v[2], v[3]); o[i] = w; if (QKV_FP8) o8[i] = pk4_fp8(v[0], v[1], v[2], v[3]); } }
        { const f32x4* p4 = (const f32x4*)inp(lds, I_P); u32x2* o = (u32x2*)(ws + WS_PB); for (size_t i = gt; i < (size_t)DEPTH * M * DPLE / 4; i += GT) { const f32x4 v = p4[i]; u32x2 w; w.x = pk2(v[0], v[1]); w.y = pk2(v[2], v[3]); o[i] = w; } }
        { float* rt = (float*)(ws + WS_ROPE); for (size_t i = gt; i < (size_t)SEQ * 16; i += GT) { const int pos = (int)(i >> 4), k = (int)(i & 15);
            const float inv = exp2f(-(float)k * (18.931568569324174f / 16.0f)); const float ang = (float)pos * inv; rt[pos * 32 + k] = cosf(ang); rt[pos * 32 + 16 + k] = sinf(ang); } }
    }
}

PHASE_FN phase_rope(unsigned char* wsarg, LAS unsigned char* lds) {
    int BID = blockIdx.x, GSZ = ld_grid(); OPAQUE_S(BID); OPAQUE_S(GSZ); OPAQUE_S(lds);
    unsigned char* const WSQ = ld_ws(wsarg);
    bf16* U = (bf16*)(WSQ + WS_BIG); const float* rt = (const float*)(WSQ + WS_ROPE);
    int tid_o = threadIdx.x; OPAQUE_V(tid_o);
    const size_t gt = (size_t)BID * 512 + tid_o, GT = (size_t)GSZ * 512;
    for (size_t i = gt; i < (size_t)M * 24; i += GT) {
        const int m = (int)(i / 24), hh = (int)(i % 24), pos = m % SEQ;
        bf16* p = U + (size_t)m * NU + (hh < 12 ? UQ + hh * 128 : UK + (hh - 12) * 128);
        const float* cs = rt + pos * 32;
#pragma unroll
        for (int h2 = 0; h2 < 2; ++h2) { u32x4 a = *(u32x4*)(p + 8 * h2), bq = *(u32x4*)(p + 16 + 8 * h2);
#pragma unroll
            for (int w = 0; w < 4; ++w) { const int k = h2 * 8 + w * 2; const unsigned xa = a[w], xb = bq[w];
                const float x1l = __uint_as_float(xa << 16), x1h = __uint_as_float(xa & 0xffff0000u), x2l = __uint_as_float(xb << 16), x2h = __uint_as_float(xb & 0xffff0000u);
                const float c0 = cs[k], c1 = cs[k + 1], s0 = cs[16 + k], s1 = cs[16 + k + 1];
                a[w] = pk2(x1l * c0 - x2l * s0, x1h * c1 - x2h * s1); bq[w] = pk2(x2l * c0 + x1l * s0, x2h * c1 + x1h * s1); }
            *(u32x4*)(p + 8 * h2) = a; *(u32x4*)(p + 16 + 8 * h2) = bq; }
    }
}

PHASE_FN phase_attn_naive(unsigned char* wsarg, LAS unsigned char* lds) {
    int BID = blockIdx.x, GSZ = ld_grid(); OPAQUE_S(BID); OPAQUE_S(GSZ); OPAQUE_S(lds);
    unsigned char* const WSQ = ld_ws(wsarg);
    int tid_o = threadIdx.x; OPAQUE_V(tid_o);
    const int tid = tid_o, lane = tid & 63, wave = __builtin_amdgcn_readfirstlane(tid >> 6);
    LAS float* qs = (LAS float*)(lds + wave * 2048); LAS float* ps = qs + 128;
    const bf16* U = (const bf16*)(WSQ + WS_BIG); bf16* AO = (bf16*)(WSQ + (ATT_FP8 ? WS_ATT : WS_CAT)); float* LSE = (float*)(WSQ + WS_LSE);
    const int gw = BID * 8 + wave, NGW = GSZ * 8;
    for (int it = gw; it < M * 12; it += NGW) {
        const int head = it % 12, m = it / 12, t = m % SEQ, g = head >> 2, d = g == 0 ? 1 : (g == 1 ? 4 : 16);
        { const unsigned qq = *(const unsigned*)(U + (size_t)m * NU + UQ + head * 128 + 2 * lane); qs[2 * lane] = __uint_as_float(qq << 16) * ATT_SCALE; qs[2 * lane + 1] = __uint_as_float(qq & 0xffff0000u) * ATT_SCALE; }
        WAVE_SYNC();
        float sc[3];
#pragma unroll
        for (int r = 0; r < 3; ++r) { const int j = lane + 64 * r; const bool ok = (j <= 128) && (t - j * d >= 0); float s = -INFINITY;
            if (ok) { const bf16* kr = U + (size_t)(m - j * d) * NU + UK + head * 128; s = 0.f;
                for (int c = 0; c < 16; ++c) { const u32x4 kv = *(const u32x4*)(kr + 8 * c);
#pragma unroll
                    for (int w = 0; w < 4; ++w) s += qs[8 * c + 2 * w] * __uint_as_float(kv[w] << 16) + qs[8 * c + 2 * w + 1] * __uint_as_float(kv[w] & 0xffff0000u); } }
            sc[r] = s; }
        const float mx = wave_max(fmaxf(fmaxf(sc[0], sc[1]), sc[2]), lane);
        float psum = 0.f;
#pragma unroll
        for (int r = 0; r < 3; ++r) { const int j = lane + 64 * r; const float p = (sc[r] == -INFINITY) ? 0.f : __expf(sc[r] - mx); psum += p; if (j <= 128) ps[j] = p; }
        const float den = wave_sum(psum, lane);
        WAVE_SYNC();
        float a0 = 0.f, a1 = 0.f;
        for (int j = 0; j <= 128; ++j) { if (t - j * d < 0) break; const float pj = ps[j]; const unsigned vv = *(const unsigned*)(U + (size_t)(m - j * d) * NU + UV + head * 128 + 2 * lane);
            a0 += pj * __uint_as_float(vv << 16); a1 += pj * __uint_as_float(vv & 0xffff0000u); }
        const float inv = 1.f / den;
        *(unsigned*)(AO + (size_t)m * ATT_PITCH + head * 128 + 2 * lane) = pk2(a0 * inv, a1 * inv);
        if (lane == 0) LSE[(size_t)m * 12 + head] = mx + __logf(den);
        WAVE_SYNC();
    }
}

constexpr int AK_STRIDE = 136, AV_STRIDE = 264;
constexpr int AL_K = 0, AL_V = 256 * AK_STRIDE * 2, AL_END = AL_V + 128 * AV_STRIDE * 2;
PHASE_FN phase_attn_mfma(unsigned char* wsarg, LAS unsigned char* lds) {
    int BID = blockIdx.x, GSZ = ld_grid(); OPAQUE_S(BID); OPAQUE_S(GSZ); OPAQUE_S(lds);
    unsigned char* const WSQ = ld_ws(wsarg);
    int tid_o = threadIdx.x; OPAQUE_V(tid_o);
    const int tid = tid_o, lane = tid & 63, wave = tid >> 6, li = lane & 15, q = lane >> 4;
    const bf16* U = (const bf16*)(WSQ + WS_BIG); bf16* AO = (bf16*)(WSQ + (ATT_FP8 ? WS_ATT : WS_CAT)); float* LSE = (float*)(WSQ + WS_LSE);
    LAS bf16* KS = (LAS bf16*)(lds + AL_K); LAS bf16* VT = (LAS bf16*)(lds + AL_V);
    constexpr int UPH = SEQ / 128, NUNITS = BATCH * 12 * UPH;
    const int per = (NUNITS + (int)GSZ - 1) / (int)GSZ;
    const int u_lo = (int)BID * per, u_hi = (u_lo + per < NUNITS) ? u_lo + per : NUNITS;
    for (int uid = u_lo; uid < u_hi; ++uid) {
        const int idx = uid % UPH, bh = uid / UPH, head = bh % 12, b = bh / 12, g = head >> 2, dsh = 2 * g, d = 1 << dsh;
        const int nblk = UPH >> dsh, r = idx / nblk, n = idx % nblk, u0 = 128 * n;
        const size_t rowbase = (size_t)b * SEQ + r;
#pragma unroll
        for (int i = 0; i < 4; ++i) { const int pidx = tid + 512 * i, rp = pidx >> 4, ch = pidx & 15, k0 = 2 * rp;
            u32x4 ka = {0u, 0u, 0u, 0u}, kb = ka, va = ka, vb = ka;
            if (n > 0 || k0 >= 128) { const bf16* r0 = U + (rowbase + (size_t)(u0 - 128 + k0) * d) * NU + head * 128 + 8 * ch; const bf16* r1 = r0 + (size_t)d * NU;
                ka = *(const u32x4*)(r0 + UK); kb = *(const u32x4*)(r1 + UK); va = *(const u32x4*)(r0 + UV); vb = *(const u32x4*)(r1 + UV); }
            *(LAS u32x4*)(KS + k0 * AK_STRIDE + 8 * ch) = ka; *(LAS u32x4*)(KS + (k0 + 1) * AK_STRIDE + 8 * ch) = kb;
#pragma unroll
            for (int w = 0; w < 4; ++w) {
                *(LAS unsigned*)(VT + (8 * ch + 2 * w) * AV_STRIDE + k0) = (va[w] & 0xffffu) | (vb[w] << 16);
                *(LAS unsigned*)(VT + (8 * ch + 2 * w + 1) * AV_STRIDE + k0) = (va[w] >> 16) | (vb[w] & 0xffff0000u); } }
        int qi_o = 16 * wave + li; OPAQUE_V(qi_o);
        const int qi = qi_o; const size_t qrow = rowbase + (size_t)(u0 + qi) * d;
        bf16x8 qf[4];
#pragma unroll
        for (int ks = 0; ks < 4; ++ks) qf[ks] = *(const bf16x8*)(U + qrow * NU + UQ + head * 128 + 32 * ks + 8 * q);
        __syncthreads();
        f32x4 st[10]; float mx = -INFINITY; const int lb = (n > 0) ? qi : max(qi, 128);
#pragma unroll
        for (int t = 0; t < 9; ++t) { const int kt = wave + t; f32x4 a = {0.f, 0.f, 0.f, 0.f};
#pragma unroll
            for (int ks = 0; ks < 4; ++ks) { const bf16x8 kf = *(const LAS bf16x8*)(KS + (16 * kt + li) * AK_STRIDE + 32 * ks + 8 * q); a = __builtin_amdgcn_mfma_f32_16x16x32_bf16(kf, qf[ks], a, 0, 0, 0); }
#pragma unroll
            for (int e = 0; e < 4; ++e) { const int ki = 16 * kt + 4 * q + e;
                const int m01 = min(max(ki - lb + 1, 0), 1) * min(max(qi + 129 - ki, 0), 1); a[e] = fmaf(a[e], ATT_SCALE, (float)(m01 - 1) * 1e30f); mx = fmaxf(mx, a[e]); }
            st[t] = a; }
        st[9] = (f32x4){0.f, 0.f, 0.f, 0.f};
        mx = fmaxf(mx, shfl_f(mx, lane ^ 16)); mx = fmaxf(mx, shfl_f(mx, lane ^ 32));
        float den = 0.f;
#pragma unroll
        for (int t = 0; t < 9; ++t)
#pragma unroll
            for (int e = 0; e < 4; ++e) { const float p = __expf(st[t][e] - mx); st[t][e] = p; den += p; }
        den += shfl_f(den, lane ^ 16); den += shfl_f(den, lane ^ 32);
        f32x4 oacc[8];
#pragma unroll
        for (int dt = 0; dt < 8; ++dt) oacc[dt] = (f32x4){0.f, 0.f, 0.f, 0.f};
#pragma unroll
        for (int a = 0; a < 5; ++a) { u32x4 pw; pw.x = pg8::cvt_pk_bf16(st[2 * a][0], st[2 * a][1]); pw.y = pg8::cvt_pk_bf16(st[2 * a][2], st[2 * a][3]); pw.z = pg8::cvt_pk_bf16(st[2 * a + 1][0], st[2 * a + 1][1]); pw.w = pg8::cvt_pk_bf16(st[2 * a + 1][2], st[2 * a + 1][3]);
            const bf16x8 pf = __builtin_bit_cast(bf16x8, pw);
            const int ke = 16 * (wave + 2 * a) + 4 * q, ko = (a < 4) ? ke + 16 : ke;
#pragma unroll
            for (int dt = 0; dt < 8; ++dt) { const s16x4 lo = *(const LAS s16x4*)(VT + (16 * dt + li) * AV_STRIDE + ke), hi = *(const LAS s16x4*)(VT + (16 * dt + li) * AV_STRIDE + ko);
                const bf16x8 vf = __builtin_shufflevector(lo, hi, 0, 1, 2, 3, 4, 5, 6, 7); oacc[dt] = __builtin_amdgcn_mfma_f32_16x16x32_bf16(vf, pf, oacc[dt], 0, 0, 0); } }
        const float inv = rcp_f(den);
        bf16* orow = AO + qrow * ATT_PITCH + head * 128 + 4 * q;
#pragma unroll
        for (int dt = 0; dt < 8; ++dt) { u32x2 w; w.x = pg8::cvt_pk_bf16(oacc[dt][0] * inv, oacc[dt][1] * inv); w.y = pg8::cvt_pk_bf16(oacc[dt][2] * inv, oacc[dt][3] * inv); *(u32x2*)(orow + 16 * dt) = w; }
        if (q == 0) LSE[qrow * 12 + head] = mx + __logf(den);
        __syncthreads();
    }
}
PHASE_FN phase_attn_mix(unsigned char* wsarg) {
    int BID = blockIdx.x, GSZ = ld_grid(); OPAQUE_S(BID); OPAQUE_S(GSZ);
    unsigned char* const WSQ = ld_ws(wsarg);
    bf16* CAT = (bf16*)(WSQ + WS_CAT); const float* LSE = (const float*)(WSQ + WS_LSE);
    int tid_o = threadIdx.x; OPAQUE_V(tid_o);
    const size_t gt = (size_t)BID * 512 + tid_o, GT = (size_t)GSZ * 512;
    for (size_t i = gt; i < (size_t)M * 64; i += GT) {
        const int m = (int)(i >> 6), h = (int)((i >> 4) & 3), ch = (int)(i & 15);
        const float l0 = LSE[(size_t)m * 12 + h], l1 = LSE[(size_t)m * 12 + 4 + h], l2 = LSE[(size_t)m * 12 + 8 + h];
        const float mx = fmaxf(l0, fmaxf(l1, l2)); const float e0 = __expf(l0 - mx), e1 = __expf(l1 - mx), e2 = __expf(l2 - mx); const float inv = rcp_f(e0 + e1 + e2);
#pragma unroll
        for (int g = 0; g < 3; ++g) { const float wg_ = (g == 0 ? e0 : (g == 1 ? e1 : e2)) * inv;
            if (ATT_FP8) { const u32x4 v = *(const u32x4*)((const bf16*)(WSQ + WS_ATT) + (size_t)m * 1536 + (g * 4 + h) * 128 + ch * 8); const float w16 = wg_ * 16.f; u32x2 o8;
                o8.x = pk4_fp8(__uint_as_float(v[0] << 16) * w16, __uint_as_float(v[0] & 0xffff0000u) * w16, __uint_as_float(v[1] << 16) * w16, __uint_as_float(v[1] & 0xffff0000u) * w16);
                o8.y = pk4_fp8(__uint_as_float(v[2] << 16) * w16, __uint_as_float(v[2] & 0xffff0000u) * w16, __uint_as_float(v[3] << 16) * w16, __uint_as_float(v[3] & 0xffff0000u) * w16);
                *(u32x2*)((unsigned char*)CAT + (size_t)m * (CAT_PITCH * 2) + (g * 4 + h) * 128 + ch * 8) = o8; }
            else { u32x4* p = (u32x4*)(CAT + (size_t)m * CAT_PITCH + (g * 4 + h) * 128 + ch * 8); u32x4 v = *p;
#pragma unroll
                for (int k = 0; k < 4; ++k) v[k] = pk2(__uint_as_float(v[k] << 16) * wg_, __uint_as_float(v[k] & 0xffff0000u) * wg_);
                *p = v; } }
    }
}

PHASE_FN phase_shortconv(unsigned char* wsarg, int L, LAS unsigned char* lds) {
    int BID = blockIdx.x, GSZ = ld_grid(); OPAQUE_S(BID); OPAQUE_S(GSZ); OPAQUE_S(lds);
    unsigned char* const WSQ = ld_ws(wsarg);
    const bf16* U = (const bf16*)(WSQ + WS_BIG); bf16* CAT = (bf16*)(WSQ + WS_CAT); const float* w = inp(lds, I_SCW) + (size_t)L * 3 * 1024;
    int tid_o = threadIdx.x; OPAQUE_V(tid_o);
    const size_t gt = (size_t)BID * 512 + tid_o, GT = (size_t)GSZ * 512;
    for (size_t i = gt; i < (size_t)M * 128; i += GT) {
        const int m = (int)(i >> 7), c0 = (int)(i & 127) * 8, t = m % SEQ;
        float acc[8];
#pragma unroll
        for (int e = 0; e < 8; ++e) acc[e] = 0.f;
#pragma unroll
        for (int k = 0; k < 3; ++k) { if (t - 2 + k < 0) continue; const bf16* r = U + (size_t)(m - 2 + k) * NU;
            const u32x4 cw = *(const u32x4*)(r + USC + c0), hw = *(const u32x4*)(r + USH + c0);
#pragma unroll
            for (int q = 0; q < 4; ++q) { acc[2 * q] += w[k * 1024 + c0 + 2 * q] * (__uint_as_float(cw[q] << 16) * __uint_as_float(hw[q] << 16));
                acc[2 * q + 1] += w[k * 1024 + c0 + 2 * q + 1] * (__uint_as_float(cw[q] & 0xffff0000u) * __uint_as_float(hw[q] & 0xffff0000u)); } }
        const u32x4 bw = *(const u32x4*)(U + (size_t)m * NU + USB + c0); u32x4 ow;
#pragma unroll
        for (int q = 0; q < 4; ++q) ow[q] = pk2(acc[2 * q] * __uint_as_float(bw[q] << 16), acc[2 * q + 1] * __uint_as_float(bw[q] & 0xffff0000u));
        *(u32x4*)(CAT + (size_t)m * CAT_PITCH + CAT_SC + c0) = ow;
    }
}

PHASE_FN phase_conv(unsigned char* wsarg, int L, LAS unsigned char* lds) {
    unsigned char* const WSQ = ld_ws(wsarg);
    int BID = blockIdx.x, GSZ = ld_grid(); OPAQUE_S(BID); OPAQUE_S(GSZ);
    int tid_o = threadIdx.x; OPAQUE_V(tid_o);
    const bf16* U = (const bf16*)(WSQ + WS_BIG); bf16* XC = (bf16*)(WSQ + WS_XC);
    const float* cw = inp(lds, I_CW) + (size_t)L * 4 * 2560; const float* cbv = inp(lds, I_CB) + (size_t)L * 2560;
    const size_t gt = (size_t)BID * 512 + tid_o, GT = (size_t)GSZ * 512;
    for (size_t i = gt; i < (size_t)(M / 16) * 320; i += GT) {
        const int rb = (int)(i / 320), c0 = (int)(i % 320) * 8, m0 = rb * 16, t0 = m0 % SEQ;
        float w[4][8], bs[8];
#pragma unroll
        for (int k = 0; k < 4; ++k) { const f32x4 a0 = *(const f32x4*)(cw + k * 2560 + c0), a1 = *(const f32x4*)(cw + k * 2560 + c0 + 4);
#pragma unroll
            for (int e = 0; e < 4; ++e) { w[k][e] = a0[e]; w[k][4 + e] = a1[e]; } }
        { const f32x4 a0 = *(const f32x4*)(cbv + c0), a1 = *(const f32x4*)(cbv + c0 + 4);
#pragma unroll
          for (int e = 0; e < 4; ++e) { bs[e] = a0[e]; bs[4 + e] = a1[e]; } }
        u32x4 raw[19];
#pragma unroll
        for (int r = 0; r < 19; ++r) raw[r] = (r >= 3 || t0 > 0) ? *(const u32x4*)(U + (size_t)(m0 + r - 3) * NU + UX + c0) : (u32x4){0u, 0u, 0u, 0u};
#pragma unroll
        for (int r = 0; r < 16; ++r) { u32x4 o;
#pragma unroll
            for (int e2 = 0; e2 < 4; ++e2) { float lo = bs[2 * e2], hi = bs[2 * e2 + 1];
#pragma unroll
                for (int k = 0; k < 4; ++k) { const unsigned x = raw[r + k][e2]; lo += w[k][2 * e2] * __uint_as_float(x << 16); hi += w[k][2 * e2 + 1] * __uint_as_float(x & 0xffff0000u); }
                o[e2] = pk2(silu_f(lo), silu_f(hi)); }
            *(u32x4*)(XC + (size_t)(m0 + r) * 2560 + c0) = o; }
    }
}
constexpr int BI_STRIDE = 136, XI_STRIDE = 72;
constexpr int SL_DT = 0, SL_ACS = 4096, SL_BI = 8192, SL_CI = SL_BI + 128 * BI_STRIDE * 2, SL_XI = SL_CI + 128 * BI_STRIDE * 2, SL_PV = SL_XI + 128 * XI_STRIDE * 2, SL_END = SL_PV + 64 * 136 * 2;
constexpr int SL_XI2 = SL_CI;
static_assert(SL_END <= RING_BYTES, "SSD LDS");
DI void ssd_dt_scan(int L, const bf16* U, int m0, int g, LAS unsigned char* lds, int wave, int lane) {
    LAS float* DT = (LAS float*)(lds + SL_DT); LAS float* ACS = (LAS float*)(lds + SL_ACS);
    if (wave < 6) { const int h = g * 6 + wave; const float bias = inp(lds, I_DTB)[L * 24 + h], a = -__expf(inp(lds, I_ALOG)[L * 24 + h]);
        const float d0 = softplus_f(bf2f(U[(size_t)(m0 + lane) * NU + UDT + h]) + bias), d1 = softplus_f(bf2f(U[(size_t)(m0 + 64 + lane) * NU + UDT + h]) + bias);
        float c0 = d0 * a, c1 = d1 * a;
#pragma unroll
        for (int o = 1; o < 64; o <<= 1) { const int src = lane >= o ? lane - o : lane; const float u0 = shfl_f(c0, src), u1 = shfl_f(c1, src); if (lane >= o) { c0 += u0; c1 += u1; } }
        c1 += shfl_f(c0, 63);
        DT[lane * 8 + wave] = d0; DT[(64 + lane) * 8 + wave] = d1; ACS[lane * 8 + wave] = c0; ACS[(64 + lane) * 8 + wave] = c1; }
}
PHASE_FN phase_ssd_states(unsigned char* wsarg, int L, LAS unsigned char* lds) {
    unsigned char* const WSQ = ld_ws(wsarg);
    int BID = blockIdx.x, GSZ = ld_grid(); OPAQUE_S(BID); OPAQUE_S(GSZ); OPAQUE_S(lds);
    int tid_o = threadIdx.x; OPAQUE_V(tid_o);
    const int tid = tid_o, lane = tid & 63, wave = tid >> 6, li = lane & 15, q = lane >> 4;
    const bf16* U = (const bf16*)(WSQ + WS_BIG); const bf16* XC = (const bf16*)(WSQ + WS_XC); float* ST = (float*)(WSQ + WS_BIG + BIG_U_BYTES); float* CD = (float*)(WSQ + WS_CD);
    LAS float* DT = (LAS float*)(lds + SL_DT); LAS float* ACS = (LAS float*)(lds + SL_ACS); LAS bf16* BI = (LAS bf16*)(lds + SL_BI);
    for (int it = BID; it < BATCH * NCH * 4; it += GSZ) {
        const int g = it & 3, c = (it >> 2) % NCH, b = (it >> 2) / NCH, m0 = b * SEQ + c * 128;
        ssd_dt_scan(L, U, m0, g, lds, wave, lane);
#pragma unroll
        for (int i = 0; i < 4; ++i) { const int ci = tid + 512 * i, row = ci >> 4, ch = ci & 15; *(LAS u32x4*)(BI + row * BI_STRIDE + 8 * ch) = *(const u32x4*)(XC + (size_t)(m0 + row) * 2560 + 1536 + g * 128 + 8 * ch); }
        __syncthreads();
        bf16x8 bfr[4];
#pragma unroll
        for (int ks = 0; ks < 4; ++ks) { const LAS bf16* p0 = BI + (32 * ks + 8 * q + (li >> 2)) * BI_STRIDE + 16 * wave + 4 * (li & 3); bfr[ks] = tr_read2(p0, p0 + 4 * BI_STRIDE); }
        u32x4 xr[2];
#pragma unroll
        for (int i = 0; i < 2; ++i) { const int ci = tid + 512 * i; xr[i] = *(const u32x4*)(XC + (size_t)(m0 + (ci >> 3)) * 2560 + (g * 6) * 64 + 8 * (ci & 7)); }
#pragma unroll 1
        for (int j = 0; j < 6; ++j) { const int h = g * 6 + j; LAS bf16* XI = (LAS bf16*)(lds + ((j & 1) ? SL_XI2 : SL_XI));
            { const float alast = ACS[127 * 8 + j];
#pragma unroll
              for (int i = 0; i < 2; ++i) { const int ci = tid + 512 * i, row = ci >> 3, ch = ci & 7;
                  const float wgt = DT[row * 8 + j] * __expf(alast - ACS[row * 8 + j]); u32x4 o;
#pragma unroll
                  for (int e = 0; e < 4; ++e) o[e] = pk2(__uint_as_float(xr[i][e] << 16) * wgt, __uint_as_float(xr[i][e] & 0xffff0000u) * wgt);
                  *(LAS u32x4*)(XI + row * XI_STRIDE + 8 * ch) = o; } }
            __syncthreads();
            if (j < 5) {
#pragma unroll
                for (int i = 0; i < 2; ++i) { const int ci = tid + 512 * i; xr[i] = *(const u32x4*)(XC + (size_t)(m0 + (ci >> 3)) * 2560 + (h + 1) * 64 + 8 * (ci & 7)); } }
            f32x4 acc[4];
#pragma unroll
            for (int pb = 0; pb < 4; ++pb) acc[pb] = (f32x4){0.f, 0.f, 0.f, 0.f};
#pragma unroll
            for (int ks = 0; ks < 4; ++ks)
#pragma unroll
                for (int pb = 0; pb < 4; ++pb) { const LAS bf16* p0 = XI + (32 * ks + 8 * q + (li >> 2)) * XI_STRIDE + 16 * pb + 4 * (li & 3); const bf16x8 afr = tr_read2(p0, p0 + 4 * XI_STRIDE);
                    acc[pb] = __builtin_amdgcn_mfma_f32_16x16x32_bf16(afr, bfr[ks], acc[pb], 0, 0, 0); }
            float* st = ST + ((size_t)((b * NCH + c) * 24 + h) * 64) * 128;
#pragma unroll
            for (int pb = 0; pb < 4; ++pb)
#pragma unroll
                for (int r = 0; r < 4; ++r) st[(size_t)(16 * pb + 4 * q + r) * 128 + 16 * wave + li] = acc[pb][r];
            if (tid == 0) CD[(b * NCH + c) * 24 + h] = __expf(ACS[127 * 8 + j]);
        }
        __syncthreads();
    }
}
PHASE_FN phase_ssd_scan(unsigned char* wsarg, bool dry = false) {
    unsigned char* const WSQ = ld_ws(wsarg);
    int BID = blockIdx.x, GSZ = ld_grid(); OPAQUE_S(BID); OPAQUE_S(GSZ);
    const float* ST = (const float*)(WSQ + WS_BIG + BIG_U_BYTES); const float* CD = (const float*)(WSQ + WS_CD); bf16* SO = dry ? (bf16*)(WSQ + WS_XF) : (bf16*)(WSQ + WS_PVB);
    int tid_o = threadIdx.x; OPAQUE_V(tid_o);
    const size_t gt = (size_t)BID * 512 + tid_o, GT = (size_t)GSZ * 512;
    static_assert(NCH % 8 == 0, "scan batch");
    for (size_t e = gt; e < (size_t)BATCH * 24 * 2048; e += GT) {
        const int b = (int)(e / (24 * 2048)), rem4 = (int)(e % (24 * 2048)), h = rem4 >> 11;
        f32x4 hs = {0.f, 0.f, 0.f, 0.f};
#pragma unroll 1
        for (int c0 = 0; c0 < NCH; c0 += 8) { f32x4 v[8]; float cd[8];
#pragma unroll
            for (int k = 0; k < 8; ++k) { v[k] = *(const f32x4*)(ST + ((size_t)(b * NCH + c0 + k) * 24 * 2048 + rem4) * 4); cd[k] = CD[(b * NCH + c0 + k) * 24 + h]; }
#pragma unroll
            for (int k = 0; k < 8; ++k) { u32x2 w; w.x = pk2(hs[0], hs[1]); w.y = pk2(hs[2], hs[3]); *(u32x2*)(SO + ((size_t)(b * NCH + c0 + k) * 24 * 2048 + rem4) * 4) = w; hs = hs * cd[k] + v[k]; } }
    }
}
PHASE_FN phase_ssd_out(unsigned char* wsarg, int L, LAS unsigned char* lds) {
    int BID = blockIdx.x, GSZ = ld_grid(); OPAQUE_S(BID); OPAQUE_S(GSZ); OPAQUE_S(lds);
    unsigned char* const WSQ = ld_ws(wsarg);
    int tid_o = threadIdx.x; OPAQUE_V(tid_o);
    const int tid = tid_o, lane = tid & 63, wave = tid >> 6, li = lane & 15, q = lane >> 4;
    const bf16* U = (const bf16*)(WSQ + WS_BIG); const bf16* XC = (const bf16*)(WSQ + WS_XC); const bf16* PVB = (const bf16*)(WSQ + WS_PVB); bf16* CAT = (bf16*)(WSQ + WS_CAT);
    const float* nw = inp(lds, I_NW) + (size_t)L * 1536;
    LAS float* DT = (LAS float*)(lds + SL_DT); LAS float* ACS = (LAS float*)(lds + SL_ACS); LAS bf16* CC = (LAS bf16*)(lds + SL_CI); LAS bf16* BC = (LAS bf16*)(lds + SL_BI);
    LAS bf16* XI = (LAS bf16*)(lds + SL_XI); LAS bf16* PV = (LAS bf16*)(lds + SL_PV);
    for (int it = BID; it < BATCH * NCH * 4; it += GSZ) {
        const int g = it & 3, c = (it >> 2) % NCH, b = (it >> 2) / NCH, m0 = b * SEQ + c * 128;
        u32x4 xr[2], pr[2];
#pragma unroll
        for (int i = 0; i < 2; ++i) { const int ci = tid + 512 * i; xr[i] = *(const u32x4*)(XC + (size_t)(m0 + (ci >> 3)) * 2560 + (g * 6) * 64 + 8 * (ci & 7)); pr[i] = *(const u32x4*)(PVB + (size_t)((b * NCH + c) * 24 + g * 6) * 8192 + 8 * ci); }
        ssd_dt_scan(L, U, m0, g, lds, wave, lane);
#pragma unroll
        for (int i = 0; i < 4; ++i) { const int ci = tid + 512 * i, row = ci >> 4, ch = ci & 15; const bf16* src = XC + (size_t)(m0 + row) * 2560 + 1536 + g * 128 + 8 * ch;
            *(LAS u32x4*)(BC + row * BI_STRIDE + 8 * ch) = *(const u32x4*)src; *(LAS u32x4*)(CC + row * BI_STRIDE + 8 * ch) = *(const u32x4*)(src + 512); }
        __syncthreads();
        float* YS = (float*)(WSQ + WS_YS) + (size_t)BID * (6 * 16 * 512) + tid; float ssq[4] = {0.f, 0.f, 0.f, 0.f};
#pragma unroll 1
        for (int j = 0; j < 6; ++j) { const int h = g * 6 + j;
#pragma unroll
            for (int i = 0; i < 2; ++i) { const int ci = tid + 512 * i, row = ci >> 3, ch = ci & 7; const float wgt = DT[row * 8 + j]; u32x4 o;
#pragma unroll
                for (int e = 0; e < 4; ++e) o[e] = pk2(__uint_as_float(xr[i][e] << 16) * wgt, __uint_as_float(xr[i][e] & 0xffff0000u) * wgt);
                *(LAS u32x4*)(XI + row * XI_STRIDE + 8 * ch) = o; *(LAS u32x4*)(PV + (ci >> 4) * 136 + 8 * (ci & 15)) = pr[i]; }
            __syncthreads();
            if (j < 5) {
#pragma unroll
                for (int i = 0; i < 2; ++i) { const int ci = tid + 512 * i; xr[i] = *(const u32x4*)(XC + (size_t)(m0 + (ci >> 3)) * 2560 + (h + 1) * 64 + 8 * (ci & 7)); pr[i] = *(const u32x4*)(PVB + (size_t)((b * NCH + c) * 24 + h + 1) * 8192 + 8 * ci); } }
            unsigned short zr[16];
#pragma unroll
            for (int pb = 0; pb < 4; ++pb)
#pragma unroll
                for (int r = 0; r < 4; ++r) zr[pb * 4 + r] = U[(size_t)(m0 + 16 * wave + 4 * q + r) * NU + UZ + h * 64 + 16 * pb + li];
            f32x4 acc[4];
#pragma unroll
            for (int pb = 0; pb < 4; ++pb) acc[pb] = (f32x4){0.f, 0.f, 0.f, 0.f};
#pragma unroll
            for (int ks = 0; ks < 4; ++ks) { const bf16x8 afr = *(const LAS bf16x8*)(CC + (16 * wave + li) * 136 + 32 * ks + 8 * q);
#pragma unroll
                for (int pb = 0; pb < 4; ++pb) { const bf16x8 bfr = *(const LAS bf16x8*)(PV + (16 * pb + li) * 136 + 32 * ks + 8 * q); acc[pb] = __builtin_amdgcn_mfma_f32_16x16x32_bf16(afr, bfr, acc[pb], 0, 0, 0); } }
#pragma unroll
            for (int r = 0; r < 4; ++r) { const float e = __expf(ACS[(16 * wave + 4 * q + r) * 8 + j]);
#pragma unroll
                for (int pb = 0; pb < 4; ++pb) acc[pb][r] *= e; }
            int l_o = 16 * wave + li; OPAQUE_V(l_o); const int l_a = l_o; const float acs_l = ACS[l_a * 8 + j];
            const float ddt = inp(lds, I_SD)[L * 24 + h] * rcp_f(DT[l_a * 8 + j]);
#pragma unroll
            for (int ks2 = 0; ks2 < 4; ++ks2) {
                if (2 * ks2 <= wave) {
                    f32x4 c0 = {0.f, 0.f, 0.f, 0.f}, c1 = {0.f, 0.f, 0.f, 0.f};
#pragma unroll
                    for (int ks = 0; ks < 4; ++ks) { const bf16x8 bfr = *(const LAS bf16x8*)(CC + (16 * wave + li) * 136 + 32 * ks + 8 * q);
                        const bf16x8 a0 = *(const LAS bf16x8*)(BC + (32 * ks2 + li) * 136 + 32 * ks + 8 * q), a1 = *(const LAS bf16x8*)(BC + (32 * ks2 + 16 + li) * 136 + 32 * ks + 8 * q);
                        c0 = __builtin_amdgcn_mfma_f32_16x16x32_bf16(a0, bfr, c0, 0, 0, 0); c1 = __builtin_amdgcn_mfma_f32_16x16x32_bf16(a1, bfr, c1, 0, 0, 0); }
                    bf16x8 afr;
#pragma unroll
                    for (int e = 0; e < 8; ++e) { const int s = 32 * ks2 + (e < 4 ? 4 * q + e : 16 + 4 * q + (e - 4)); const float cbv_ = e < 4 ? c0[e & 3] : c1[e & 3];
                        const float gv = cbv_ * __expf(fminf(acs_l - ACS[s * 8 + j], 0.f)) * (float)min(max(l_a - s + 1, 0), 1) + ddt * (float)(1 - min(abs(l_a - s), 1)); afr[e] = (short)f2bf(gv); }
#pragma unroll
                    for (int pb = 0; pb < 4; ++pb) { const LAS bf16* p0 = XI + (32 * ks2 + 4 * q + (li >> 2)) * XI_STRIDE + 16 * pb + 4 * (li & 3);
                        const bf16x8 bfr = tr_read2(p0, p0 + 16 * XI_STRIDE); acc[pb] = __builtin_amdgcn_mfma_f32_16x16x32_bf16(afr, bfr, acc[pb], 0, 0, 0); } } }
#pragma unroll
            for (int pb = 0; pb < 4; ++pb)
#pragma unroll
                for (int r = 0; r < 4; ++r) { const float y = acc[pb][r] * silu_f(bf2f(zr[pb * 4 + r]));
                    YS[(j * 16 + pb * 4 + r) * 512] = y; ssq[r] += y * y; }
            __syncthreads();
        }
#pragma unroll
        for (int r = 0; r < 4; ++r) { float s = ssq[r]; s += shfl_f(s, lane ^ 1); s += shfl_f(s, lane ^ 2); s += shfl_f(s, lane ^ 4); s += shfl_f(s, lane ^ 8); ssq[r] = __builtin_amdgcn_rsqf(s * (1.f / 384.f) + RMS_EPS); }
#pragma unroll 1
        for (int j = 0; j < 6; ++j)
#pragma unroll
            for (int pb = 0; pb < 4; ++pb)
#pragma unroll
                for (int r = 0; r < 4; ++r) { const int l = 16 * wave + 4 * q + r, ch = (g * 6 + j) * 64 + 16 * pb + li; CAT[(size_t)(m0 + l) * CAT_PITCH + CAT_SSM + ch] = f2bf(YS[(j * 16 + pb * 4 + r) * 512] * ssq[r] * nw[ch]); }
    }
}

static_assert(DM % 1024 == 0, "phase_resln: DM must be a multiple of 1024");
template <bool GATE> PHASE_FN phase_resln(unsigned char* wsarg, float* outarg, int L, int which, LAS unsigned char* lds, bool dry = false) {
    unsigned char* const WSQ = ld_ws(wsarg);
    const float* x32 = (L == 0 && which == 0) ? inp(lds, I_X) : nullptr;
    bf16* xb = (bf16*)(WSQ + WS_XB); const bf16* fb = (const bf16*)(WSQ + WS_XF); const bf16* emb = (const bf16*)(WSQ + WS_EMB);
    float* out32 = (L == DEPTH - 1 && which == 2 && !dry) ? ld_out(outarg) : nullptr; bf16* xo = dry ? (bf16*)(WSQ + WS_CAT) : xb;
    const float* gam = inp(lds, which == 0 ? I_L1G : (which == 1 ? I_L2G : I_L3G)) + (size_t)L * DM; const float* bet = inp(lds, which == 0 ? I_L1B : (which == 1 ? I_L2B : I_L3B)) + (size_t)L * DM;
    int BID = blockIdx.x, GSZ = ld_grid(); OPAQUE_S(BID); OPAQUE_S(GSZ);
    int tid_o = threadIdx.x; OPAQUE_V(tid_o);
    const int lane = tid_o & 63, wave = __builtin_amdgcn_readfirstlane(tid_o >> 6), pair = wave >> 1, half = wave & 1;
    const bool q8 = (((which == 0) && ((UP_INT8 >> L) & 1)) || ((which == 1) && GATE_INT8)) && !dry;
    LAS float* RS = (LAS float*)lds; LAS float* RQ = RS + 8;
    constexpr int NJ = DM / 1024;
    const int niter = (M + 4 * GSZ - 1) / (4 * GSZ);
    for (int itn = 0; itn < niter; ++itn) {
        const int m = (itn * GSZ + BID) * 4 + pair; const bool live = m < M;
        float v[NJ][8]; float s = 0.f;
        if (live) {
#pragma unroll
        for (int j = 0; j < NJ; ++j) { const size_t o = (size_t)m * DM + (size_t)((half * NJ + j) * 64 + lane) * 8;
            float xv[8];
            if (x32) { const f32x4 a = NT_LOAD((const f32x4*)(x32 + o)), b = NT_LOAD((const f32x4*)(x32 + o + 4)); xv[0] = a[0]; xv[1] = a[1]; xv[2] = a[2]; xv[3] = a[3]; xv[4] = b[0]; xv[5] = b[1]; xv[6] = b[2]; xv[7] = b[3]; }
            else { const u32x4 a = NT_LOAD((const u32x4*)(xb + o));
#pragma unroll
                for (int k = 0; k < 4; ++k) { xv[2 * k] = __uint_as_float(a[k] << 16); xv[2 * k + 1] = __uint_as_float(a[k] & 0xffff0000u); } }
            const u32x4 f = NT_LOAD((const u32x4*)(fb + o)); float fv[8];
#pragma unroll
            for (int k = 0; k < 4; ++k) { fv[2 * k] = __uint_as_float(f[k] << 16); fv[2 * k + 1] = __uint_as_float(f[k] & 0xffff0000u); }
            if (GATE) { const u32x4 e = NT_LOAD((const u32x4*)(emb + o));
#pragma unroll
                for (int k = 0; k < 4; ++k) { fv[2 * k] = __uint_as_float(e[k] << 16) * rcp_f(1.f + __expf(-fv[2 * k])); fv[2 * k + 1] = __uint_as_float(e[k] & 0xffff0000u) * rcp_f(1.f + __expf(-fv[2 * k + 1])); } }
#pragma unroll
            for (int k = 0; k < 8; ++k) { v[j][k] = DN_ALPHA * xv[k] + fv[k]; s += v[j][k]; } }
        }
        s = wave_sum(s, lane); if (lane == 0) RS[pair * 2 + half] = s;
        __syncthreads();
        const float mean = (RS[pair * 2] + RS[pair * 2 + 1]) * (1.f / DM); float s2 = 0.f;
        if (live) {
#pragma unroll
        for (int j = 0; j < NJ; ++j)
#pragma unroll
            for (int k = 0; k < 8; ++k) { v[j][k] -= mean; s2 += v[j][k] * v[j][k]; }
        }
        s2 = wave_sum(s2, lane); if (lane == 0) RQ[pair * 2 + half] = s2;
        __syncthreads();
        const float rstd = __builtin_amdgcn_rsqf((RQ[pair * 2] + RQ[pair * 2 + 1]) * (1.f / DM) + LN_EPS);
        float ymax = 0.f;
        if (live) {
#pragma unroll
        for (int j = 0; j < NJ; ++j) { const size_t c = (size_t)((half * NJ + j) * 64 + lane) * 8, o = (size_t)m * DM + c;
            const f32x4 g0 = *(const f32x4*)(gam + c), g1 = *(const f32x4*)(gam + c + 4), b0 = *(const f32x4*)(bet + c), b1 = *(const f32x4*)(bet + c + 4);
            float y[8];
#pragma unroll
            for (int k = 0; k < 4; ++k) { y[k] = v[j][k] * rstd * g0[k] + b0[k]; y[4 + k] = v[j][4 + k] * rstd * g1[k] + b1[k]; }
            if (out32) { *(f32x4*)(out32 + o) = (f32x4){y[0], y[1], y[2], y[3]}; *(f32x4*)(out32 + o + 4) = (f32x4){y[4], y[5], y[6], y[7]}; }
            else { u32x4 w; w.x = pk2(y[0], y[1]); w.y = pk2(y[2], y[3]); w.z = pk2(y[4], y[5]); w.w = pk2(y[6], y[7]); *(u32x4*)(xo + o) = w;
                   if ((GATE_FP8 && !GATE_INT8 && which == 1) || (QKV_FP8 && which == 2)) { u32x2 w8; w8.x = pk4_fp8(y[0], y[1], y[2], y[3]); w8.y = pk4_fp8(y[4], y[5], y[6], y[7]); *(u32x2*)(WSQ + WS_X8 + o) = w8; } }
            if (q8) {
#pragma unroll
                for (int k = 0; k < 8; ++k) { v[j][k] = y[k]; ymax = fmaxf(ymax, fabsf(y[k])); } } }
        }
        if (q8) {
            ymax = wave_max(ymax, lane); if (lane == 0) RS[16 + pair * 2 + half] = ymax;
            __syncthreads();
            const float rmx = fmaxf(fmaxf(RS[16 + pair * 2], RS[16 + pair * 2 + 1]), 1e-30f), iv = 127.f / rmx;
            if (live) {
#pragma unroll
                for (int j = 0; j < NJ; ++j) { const size_t o = (size_t)m * DM + (size_t)((half * NJ + j) * 64 + lane) * 8; u32x2 w8;
                    unsigned a = 0, b = 0;
#pragma unroll
                    for (int k = 0; k < 4; ++k) { a |= ((unsigned)(__float2int_rn(v[j][k] * iv) & 0xff)) << (8 * k); b |= ((unsigned)(__float2int_rn(v[j][4 + k] * iv) & 0xff)) << (8 * k); }
                    w8.x = a; w8.y = b; *(u32x2*)(WSQ + WS_X8 + o) = w8; }
                if (half == 0 && lane == 0) ((float*)(WSQ + WS_SA))[m] = rmx * (1.f / 127.f); }
        }
    }
    __syncthreads();
}

constexpr int PH_PER_LAYER = 13, N_PHASES = DEPTH * PH_PER_LAYER;
#ifndef REP_G3
#define REP_G3 1
#endif
#ifndef REP_G4
#define REP_G4 1
#endif
#ifndef REP_SCAN
#define REP_SCAN 1
#endif
#ifndef REP_MISC
#define REP_MISC 1
#endif
#ifndef REP_BAR
#define REP_BAR 1
#endif
#ifndef GEMM_ALIGN
#define GEMM_ALIGN true
#endif
#ifndef GEMM_SP2
#define GEMM_SP2 true
#endif
#ifndef REP_GEMM
#define REP_GEMM 1
#endif
#ifndef ATTN_NAIVE
#define ATTN_NAIVE 0
#endif
#ifndef REP_W
#define REP_W 1
#endif
#ifndef REP_LN
#define REP_LN 1
#endif
#ifndef REP_ATT
#define REP_ATT 1
#endif
#ifndef REP_SSD1
#define REP_SSD1 1
#endif
#ifndef REP_SSD3
#define REP_SSD3 1
#endif
#ifndef REP_SC
#define REP_SC 1
#endif
#ifndef PHASE_MASK
#define PHASE_MASK 0x1fff
#endif
#if ONE_LAUNCH && !defined(EMU)
#define IN(k) ((PHASE_MASK >> (((k) % PH_PER_LAYER))) & 1)
#define SEAM(k) do { if ((k) + 1 < N_PHASES) { XcdBarrier b_; b_.bar = (unsigned*)(ld_ws(P.ws) + WS_CTL) + 4096; b_.x = xb_xcc_id(); b_.st = (volatile LAS unsigned*)(lds + MISC_OFF) + 8; for (int rb_ = 0; rb_ < REP_BAR; ++rb_) xcd_barrier(b_); } } while (0)
#else
#define IN(k) (((PHASE_MASK >> (((k) % PH_PER_LAYER))) & 1) && P.ph_lo <= (k) && (k) < P.ph_hi)
#define SEAM(k) do { if (IN(k) && IN((k) + 1)) { XcdBarrier b_; b_.bar = (unsigned*)(ld_ws(P.ws) + WS_CTL) + 4096; b_.x = xb_xcc_id(); b_.st = (volatile LAS unsigned*)(lds + MISC_OFF) + 8; xcd_barrier(b_); } } while (0)
#endif
template <int L> DI void layer_program(const Params& P, LAS unsigned char* lds) {
    {
        constexpr int pb = L * PH_PER_LAYER;
#define WSP unsigned char* const ws = ld_ws(P.ws); (void)ws
#define GEMM_PHASE(EPI, A_, B_, N_, K_, ...) GEMM_PHASE_R(0, 0, EPI, A_, B_, N_, K_, __VA_ARGS__)
#define GEMM_PHASE_X(F8_, EPI, A_, B_, N_, K_, ...) GEMM_PHASE_R(F8_, 0, EPI, A_, B_, N_, K_, __VA_ARGS__)
#define GEMM_PHASE_R(F8_, ROT_, EPI, A_, B_, N_, K_, ...) do { pg8::Gemm g{(const bf16*)(A_), (const bf16*)(B_), M, (N_), (K_)}; int bid_ = blockIdx.x, gsz_ = ld_grid(); if (ROT_) bid_ = (bid_ + gsz_ / 2) % gsz_; OPAQUE_S(bid_); OPAQUE_S(gsz_); auto lds_ = lds; OPAQUE_S(lds_); pg8::StaticOrder S; S.init(M, (N_), gsz_, bid_); \
            EPI E{__VA_ARGS__}; for (int rep = 0; rep < REP_GEMM; ++rep) pg8::gemm_phase<EPI, pg8::StaticOrder, GEMM_ALIGN, GEMM_SP2, F8_>(lds_, g, S, E); } while (0)
        if (IN(pb + 0)) for (int rep = 0; rep < REP_W; ++rep) phase_weights(P.ws, L, lds, rep);
        SEAM(pb + 0);
        if (IN(pb + 1)) { WSP;
            if (QKV_FP8) { GEMM_PHASE_X(1, pg8::EpiBf16<2>, ws + WS_X8, ws + WS_WIN, NQKV, DM / 2, (bf16*)(ws + WS_BIG), NU);
                           GEMM_PHASE_R(0, 1, pg8::EpiBf16<0>, ws + WS_XB, ws + WS_WIN + WINB_OFF, NREST, DM, (bf16*)(ws + WS_BIG) + NQKV, NU); }
            else GEMM_PHASE(pg8::EpiBf16<0>, ws + WS_XB, ws + WS_WIN, NU, DM, (bf16*)(ws + WS_BIG), NU); }
        SEAM(pb + 1);
        if (IN(pb + 2)) { phase_rope(P.ws, lds); for (int rm_ = 0; rm_ < REP_MISC; ++rm_) { phase_conv(P.ws, L, lds); WSP; GEMM_PHASE(pg8::EpiBf16<0>, (const bf16*)(ws + WS_PB) + (size_t)L * M * DPLE, ws + WS_WPE, DM, DPLE, (bf16*)(ws + WS_EMB), DM); } }
        SEAM(pb + 2);
        if (IN(pb + 3)) { for (int rep = 0; rep < REP_SSD1; ++rep) phase_ssd_states(P.ws, L, lds); for (int rep = 0; rep < REP_ATT; ++rep) { if (ATTN_NAIVE) phase_attn_naive(P.ws, lds); else phase_attn_mfma(P.ws, lds); } for (int rep = 0; rep < REP_SC; ++rep) phase_shortconv(P.ws, L, lds); }
        SEAM(pb + 3);
        if (IN(pb + 4)) { for (int rs_ = 0; rs_ < REP_SCAN; ++rs_) phase_ssd_scan(P.ws, rs_ + 1 < REP_SCAN); phase_attn_mix(P.ws); }
        SEAM(pb + 4);
        if (IN(pb + 5)) for (int rep = 0; rep < REP_SSD3; ++rep) phase_ssd_out(P.ws, L, lds);
        SEAM(pb + 5);
        if (IN(pb + 6)) { WSP; if (ATT_FP8) GEMM_PHASE_X(3, pg8::EpiBf16<0>, ws + WS_CAT, ws + WS_WOUT, DM, CAT_PITCH, (bf16*)(ws + WS_XF), DM);
            else GEMM_PHASE(pg8::EpiBf16<0>, ws + WS_CAT, ws + WS_WOUT, DM, DMIX, (bf16*)(ws + WS_XF), DM); }
        SEAM(pb + 6);
        if (IN(pb + 7)) for (int rep = 0; rep < REP_LN; ++rep) phase_resln<false>(P.ws, P.out, L, 0, lds, rep + 1 < REP_LN);
        SEAM(pb + 7);
        if (IN(pb + 8)) for (int r3_ = 0; r3_ < REP_G3; ++r3_) { WSP; if constexpr ((UP_INT8 >> L) & 1) GEMM_PHASE_X(2, pg8::EpiI8<1>, ws + WS_X8, ws + WS_WUP, DFF, DM / 2, (bf16*)(ws + WS_BIG), DFF, (const float*)(ws + WS_SA), (const float*)(ws + WS_SW));
            else GEMM_PHASE(pg8::EpiBf16<1>, ws + WS_XB, ws + WS_WUP, DFF, DM, (bf16*)(ws + WS_BIG), DFF); }
        SEAM(pb + 8);
        if (IN(pb + 9)) for (int r4_ = 0; r4_ < REP_G4; ++r4_) { WSP; GEMM_PHASE(pg8::EpiBf16<0>, ws + WS_BIG, ws + WS_WDN, DM, DFF, (bf16*)(ws + WS_XF), DM); }
        SEAM(pb + 9);
        if (IN(pb + 10)) for (int rep = 0; rep < REP_LN; ++rep) phase_resln<false>(P.ws, P.out, L, 1, lds, rep + 1 < REP_LN);
        SEAM(pb + 10);
        if (IN(pb + 11)) { WSP; if (GATE_INT8) GEMM_PHASE_X(2, pg8::EpiI8<0>, ws + WS_X8, ws + WS_WGT, DM, DM / 2, (bf16*)(ws + WS_XF), DM, (const float*)(ws + WS_SA), (const float*)(ws + WS_SWG));
            else if (GATE_FP8) GEMM_PHASE_X(true, pg8::EpiBf16<2>, ws + WS_X8, ws + WS_WGT, DM, DM / 2, (bf16*)(ws + WS_XF), DM);
            else GEMM_PHASE(pg8::EpiBf16<0>, ws + WS_XB, ws + WS_WGT, DM, DM, (bf16*)(ws + WS_XF), DM); }
        SEAM(pb + 11);
        if (IN(pb + 12)) for (int rep = 0; rep < REP_LN; ++rep) phase_resln<true>(P.ws, P.out, L, 2, lds, rep + 1 < REP_LN);
        SEAM(pb + 12);
#undef WSP
#undef GEMM_PHASE
#undef GEMM_PHASE_X
#undef GEMM_PHASE_R
    }
}
#undef IN
#undef SEAM

__global__ void __launch_bounds__(512, 2) hymba_fwd(Params P) {
#ifdef EMU
    unsigned char* lds = emu::lds_base();
#else
    extern __shared__ __attribute__((aligned(16))) unsigned char lds_raw[];
    LAS unsigned char* lds = (LAS unsigned char*)lds_raw;
#endif
    volatile LAS unsigned* MISC = (volatile LAS unsigned*)(lds + MISC_OFF);
    for (int u = threadIdx.x; u < 64; u += 512) MISC[u] = 0u;
    { LAS unsigned long long* pt = (LAS unsigned long long*)(lds + PTAB_OFF);
#pragma unroll
      for (int i = 0; i < 21; ++i) if (threadIdx.x == i) pt[i] = (unsigned long long)(size_t)P.in[i]; }
    __syncthreads();
    if ((P.ph_hi - P.ph_lo) > 1) (void)xcd_barrier_post((unsigned*)(P.ws + WS_CTL) + 4096, MISC + 8);
    layer_program<0>(P, lds);
    layer_program<1>(P, lds);
    static_assert(DEPTH == 2, "layer_program instantiations");

}

extern "C" void kernel_launch(void* const* d_in, const int* in_sizes, int n_in, void* d_out, int out_size, void* d_ws, size_t ws_size, hipStream_t stream) {
    static int grid = 0;
    if (grid == 0) {
        if (n_in != 21 || ws_size < WS_END) { fprintf(stderr, "kernel_launch: expected 21 inputs and >= %zu bytes of workspace; got %d inputs, %zu bytes\n", (size_t)WS_END, n_in, ws_size); grid = -1; return; }
        int dev = 0, cus = 0, per_cu = 0;
        if (hipGetDevice(&dev) != hipSuccess || hipDeviceGetAttribute(&cus, hipDeviceAttributeMultiprocessorCount, dev) != hipSuccess) { grid = -1; return; }
        if (hipFuncSetAttribute((const void*)hymba_fwd, hipFuncAttributeMaxDynamicSharedMemorySize, LDS_BYTES) != hipSuccess) { fprintf(stderr, "kernel_launch: hipFuncSetAttribute failed\n"); grid = -1; return; }
        if (hipOccupancyMaxActiveBlocksPerMultiprocessor(&per_cu, (const void*)hymba_fwd, 512, LDS_BYTES) != hipSuccess || per_cu < 1) fprintf(stderr, "kernel_launch: occupancy query reports %d\n", per_cu);
        (void)hipGetLastError();
        grid = cus;
    }
    if (grid < 0) return;
    (void)in_sizes; (void)out_size;
    hipMemsetAsync((char*)d_ws + WS_CTL, 0, CTL_BYTES, stream);
    Params p{};
    for (int i = 0; i < 21; ++i) p.in[i] = (const float*)d_in[i];
    p.out = (float*)d_out; p.ws = (unsigned char*)d_ws; p.grid = grid; p.pad = 0;
#if ONE_LAUNCH
    p.ph_lo = 0; p.ph_hi = N_PHASES;
    hipLaunchKernelGGL(hymba_fwd, dim3(grid), dim3(512), LDS_BYTES, stream, p);
#else
    for (int k = 0; k < N_PHASES; ++k) { p.ph_lo = k; p.ph_hi = k + 1; hipLaunchKernelGGL(hymba_fwd, dim3(grid), dim3(512), LDS_BYTES, stream, p); }
#endif
}
```

```cpp
#ifndef EMU
#include <hip/hip_runtime.h>
#endif
#include <cstdio>
#include <cstdint>
#include <type_traits>

#ifndef CFG_BATCH
#define CFG_BATCH 2
#endif
#ifndef CFG_SEQ
#define CFG_SEQ 8192
#endif
#ifndef CFG_DM
#define CFG_DM 4096
#endif
#ifndef CFG_DFF
#define CFG_DFF 16384
#endif
#ifndef ONE_LAUNCH
#define ONE_LAUNCH 1
#endif

#ifdef EMU
#define LAS
#define GAS
#define WAIT_VM0() ((void)0)
#define WAIT_LGKM0() ((void)0)
#define WAVE_SYNC() emu::wave_barrier()
#define CFENCE() ((void)0)
#else
#define LAS __attribute__((address_space(3)))
#define GAS __attribute__((address_space(1)))
#define WAIT_VM0() asm volatile("s_waitcnt vmcnt(0)" ::: "memory")
#define WAIT_LGKM0() asm volatile("s_waitcnt lgkmcnt(0)" ::: "memory")
#define WAVE_SYNC() do { asm volatile("s_waitcnt lgkmcnt(0)" ::: "memory"); __builtin_amdgcn_wave_barrier(); asm volatile("" ::: "memory"); } while (0)
#define CFENCE() asm volatile("" ::: "memory")
#endif
#define DI __device__ __forceinline__
#ifndef ATT_FP8
#define ATT_FP8 1
#endif
#ifndef QKV_FP8
#define QKV_FP8 1
#endif
#ifndef UP_INT8
#define UP_INT8 3
#endif
#ifndef GATE_INT8
#define GATE_INT8 0
#endif
#ifndef GATE_FP8
#define GATE_FP8 1
#endif
#ifndef USE_NT
#define USE_NT 1
#endif
#if USE_NT
#define NT_LOAD(p) __builtin_nontemporal_load(p)
#else
#define NT_LOAD(p) (*(p))
#endif
#ifdef EMU
#define F8_PAD() ((void)0)
#else
#define F8_PAD() asm volatile("s_nop 15\n\ts_nop 15" ::: "memory")
#endif
#define PHASE_FN __device__ __forceinline__ void
#ifdef EMU
#define OPAQUE_V(x) ((void)0)
#define OPAQUE_S(x) ((void)0)
#else
#define OPAQUE_V(x) asm volatile("" : "+v"(x))
#define OPAQUE_S(x) asm volatile("" : "+s"(x))
#endif

namespace pg8 {
#define PG8_LAS LAS
typedef unsigned short bf16_t;
typedef short bf16x8 __attribute__((ext_vector_type(8)));
typedef float f32x4 __attribute__((ext_vector_type(4)));
typedef unsigned u32x4 __attribute__((ext_vector_type(4)));
typedef int i32x4_t __attribute__((ext_vector_type(4)));
typedef int v8i_t __attribute__((ext_vector_type(8)));
constexpr int BM = 256, BK = 64, HALF = 128, HTB = HALF * BK * 2  , STAGE_BYTES = 8 * HTB, NXCD = 8, WGM = 8;

__host__ __device__ __forceinline__ int lds_byte(int r, int c) { const int st = (r >> 4) * 2 + (c >> 5), rr = r & 15, cc = c & 31, ob = rr * 64 + cc * 2; return st * 1024 + (ob ^ (((ob >> 9) & 1) << 5)); }
__host__ __device__ __forceinline__ void stage_rc(int b, int& R, int& C) { const int st = b / 1024, sb = b % 1024, swz = sb ^ (((sb >> 9) & 1) << 5); R = (st >> 1) * 16 + swz / 64; C = (st & 1) * 32 + (swz % 64) / 2; }
__host__ __device__ __forceinline__ int perm32(int rho) { const int n = rho >> 4, i = rho & 15; return 8 * (i >> 2) + 4 * n + (i & 3); }

struct Unit { int pm, pn; };
struct Gemm { const bf16_t* A; const bf16_t* Bt; int M, N, K; };

struct StaticOrder {
    int nM, nN, nwg, G, c;
    __host__ __device__ void init(int M, int N, int G_, int c_) { nM = M / BM; nN = N / BM; nwg = nM * nN; G = G_; c = c_; }
    __host__ __device__ bool next(int i, Unit& u) const {
        const long L = (long)i * G + c; if (L >= nwg) return false;
        int wgid = (int)L; { const int q = nwg / NXCD, r = nwg % NXCD, xcd = wgid % NXCD, off = wgid / NXCD; wgid = (xcd < r ? xcd * (q + 1) : r * (q + 1) + (xcd - r) * q) + off; }
        const int nig = WGM * nN, gid = wgid / nig, fm = gid * WGM, gsz = (nM - fm) < WGM ? (nM - fm) : WGM;
        u.pm = fm + ((wgid % nig) % gsz); u.pn = (wgid % nig) / gsz; return true;
    }
    __device__ __forceinline__ void a_ready(const Unit&) const {}
    __device__ __forceinline__ void done(const Unit&) const {}
};


#ifdef EMU
__device__ __forceinline__ unsigned cvt_pk_bf16(float lo, float hi) { unsigned a = __float_as_uint(lo), b = __float_as_uint(hi); a = (a + 0x7fffu + ((a >> 16) & 1u)) >> 16; b = (b + 0x7fffu + ((b >> 16) & 1u)) >> 16; return a | (b << 16); }
#else
__device__ __forceinline__ unsigned cvt_pk_bf16(float lo, float hi) { unsigned r; asm volatile("v_cvt_pk_bf16_f32 %0, %1, %2" : "=v"(r) : "v"(lo), "v"(hi)); return r; }
#endif
typedef unsigned u32x2 __attribute__((ext_vector_type(2)));
template <int ACT> struct EpiBf16 {
    static constexpr bool PERM = true, AFTER_DRAIN = false;
    bf16_t* O; int ldc;
    __device__ __forceinline__ void operator()(const f32x4 (&acc)[2][2][4][2], const Unit& u, int wr, int wc, int fr, int fq) const {
        const int row0 = u.pm * BM + wr * 64 + fr, col0 = u.pn * BM + wc * 32 + 8 * fq;
#pragma unroll
        for (int ai = 0; ai < 2; ++ai)
#pragma unroll
            for (int m = 0; m < 4; ++m) { bf16_t* rowp = O + (size_t)(row0 + ai * HALF + m * 16) * ldc + col0;
#pragma unroll
                for (int bj = 0; bj < 2; ++bj) { f32x4 v0 = acc[ai][bj][m][0], v1 = acc[ai][bj][m][1];
                    if (ACT == 1) {
#pragma unroll
                        for (int j = 0; j < 4; ++j) { const float a = v0[j] > 0.f ? v0[j] : 0.f, b = v1[j] > 0.f ? v1[j] : 0.f; v0[j] = a * a; v1[j] = b * b; } }
                    if (ACT == 2) { v0 = v0 * 0.015625f; v1 = v1 * 0.015625f; }
                    u32x4 w; w.x = cvt_pk_bf16(v0[0], v0[1]); w.y = cvt_pk_bf16(v0[2], v0[3]); w.z = cvt_pk_bf16(v1[0], v1[1]); w.w = cvt_pk_bf16(v1[2], v1[3]);
                    *(u32x4*)(rowp + bj * HALF) = w; } }
    }
};
template <bool I8> struct AccSel { typedef f32x4 type; };
template <> struct AccSel<true> { typedef i32x4_t type; };
template <int ACT  > struct EpiI8 {
    static constexpr bool PERM = true, AFTER_DRAIN = false;
    bf16_t* O; int ldc; const float* sa; const float* sw;
    __device__ __forceinline__ void operator()(const i32x4_t (&acc)[2][2][4][2], const Unit& u, int wr, int wc, int fr, int fq) const {
        const int row0 = u.pm * BM + wr * 64 + fr, col0 = u.pn * BM + wc * 32 + 8 * fq;
        f32x4 cs[2][2];
#pragma unroll
        for (int bj = 0; bj < 2; ++bj) { cs[bj][0] = *(const f32x4*)(sw + col0 + bj * HALF); cs[bj][1] = *(const f32x4*)(sw + col0 + bj * HALF + 4); }
#pragma unroll
        for (int ai = 0; ai < 2; ++ai)
#pragma unroll
            for (int m = 0; m < 4; ++m) { const int row = row0 + ai * HALF + m * 16; const float ra = sa[row]; bf16_t* rowp = O + (size_t)row * ldc + col0;
#pragma unroll
                for (int bj = 0; bj < 2; ++bj) { f32x4 v0, v1;
#pragma unroll
                    for (int j = 0; j < 4; ++j) { const float a = (float)acc[ai][bj][m][0][j] * ra * cs[bj][0][j], b = (float)acc[ai][bj][m][1][j] * ra * cs[bj][1][j];
                        if (ACT == 1) { const float ap = fmaxf(a, 0.f), bp = fmaxf(b, 0.f); v0[j] = ap * ap; v1[j] = bp * bp; } else { v0[j] = a; v1[j] = b; } }
                    u32x4 w; w.x = cvt_pk_bf16(v0[0], v0[1]); w.y = cvt_pk_bf16(v0[2], v0[3]); w.z = cvt_pk_bf16(v1[0], v1[1]); w.w = cvt_pk_bf16(v1[2], v1[3]);
                    *(u32x4*)(rowp + bj * HALF) = w; } }
    }
};
template <bool GATE> struct EpiRes {
    static constexpr bool PERM = false, AFTER_DRAIN = false;
    const float* base; float* out; int ldc; float alpha; const bf16_t* emb;
    __device__ __forceinline__ void operator()(const f32x4 (&acc)[2][2][4][2], const Unit& u, int wr, int wc, int fr, int fq) const {
        const int row0 = u.pm * BM + wr * 64 + fr, col0 = u.pn * BM + wc * 32 + 4 * fq;
#pragma unroll
        for (int ai = 0; ai < 2; ++ai)
#pragma unroll
            for (int m = 0; m < 4; ++m) { const size_t off = (size_t)(row0 + ai * HALF + m * 16) * ldc + col0;
#pragma unroll
                for (int bj = 0; bj < 2; ++bj)
#pragma unroll
                    for (int n = 0; n < 2; ++n) { const size_t o = off + bj * HALF + n * 16; const f32x4 bs = *(const f32x4*)(base + o); f32x4 v = acc[ai][bj][m][n];
                        if (GATE) { const u32x2 e = *(const u32x2*)(emb + o);
                            const float e0 = __uint_as_float(e.x << 16), e1 = __uint_as_float(e.x & 0xffff0000u), e2 = __uint_as_float(e.y << 16), e3 = __uint_as_float(e.y & 0xffff0000u);
                            v[0] = e0 / (1.f + __expf(-v[0])); v[1] = e1 / (1.f + __expf(-v[1])); v[2] = e2 / (1.f + __expf(-v[2])); v[3] = e3 / (1.f + __expf(-v[3])); }
                        *(f32x4*)(out + o) = bs * alpha + v; } }
    }
};

#ifdef EMU
__device__ __forceinline__ void mfma_f8_acc(f32x4& c, v8i_t a, v8i_t b, int) { c = __builtin_amdgcn_mfma_scale_f32_16x16x128_f8f6f4(a, b, c, 0, 0, 0, 0x7f7f7f7f, 0, 0x7f7f7f7f); }
#else
__device__ __forceinline__ void mfma_f8_acc(f32x4& c, v8i_t a, v8i_t b, int sc) { asm volatile("v_mfma_scale_f32_16x16x128_f8f6f4 %0, %1, %2, %0, %3, %3 op_sel_hi:[0,0,0]" : "+v"(c) : "v"(a), "v"(b), "v"(sc)); }
#endif
#ifdef EMU
__device__ __forceinline__ void mfma_f8_acc2(f32x4& c, v8i_t a, v8i_t b, int sa, int sb, int, int) { c = __builtin_amdgcn_mfma_scale_f32_16x16x128_f8f6f4(a, b, c, 0, 0, 0, sa, 0, sb); }
#else
__device__ __forceinline__ void mfma_f8_acc2(f32x4& c, v8i_t a, v8i_t b, int, int, int va, int vb) { asm volatile("v_mfma_scale_f32_16x16x128_f8f6f4 %0, %1, %2, %0, %3, %4 op_sel_hi:[0,0,0]" : "+v"(c) : "v"(a), "v"(b), "v"(va), "v"(vb)); }
#endif
template <class Epi, class Sched, bool ALIGN_EPI = false, bool SP2 = false, int QM = 0>
__device__ __forceinline__ void gemm_phase(PG8_LAS unsigned char* lds, const Gemm g, const Sched& S, const Epi& E) {
    int tid_o = threadIdx.x; OPAQUE_V(tid_o);
    constexpr bool MX = (QM == 3), F8 = (QM == 1) || MX, I8 = (QM == 2); typedef typename AccSel<I8>::type acc_v;
    constexpr int NT8 = 12;
    const int tid = tid_o, wid = __builtin_amdgcn_readfirstlane(tid >> 6), lane = tid & 63, wr = wid >> 2, wc = wid & 3, fr = lane & 15, fq = lane >> 4;
    const int K = g.K, nt = K / BK;
    unsigned voffA[2], voffB[2];
#pragma unroll
    for (int i = 0; i < 2; ++i) { int R, C; stage_rc(tid * 16 + i * 8192, R, C); const int Rb = Epi::PERM ? ((R & ~31) + perm32(R & 31)) : R;
        voffA[i] = (unsigned)(R * K + C) * 2u; voffB[i] = (unsigned)(Rb * K + C) * 2u; }
    const size_t kstep = (size_t)(BK * 2);
    const size_t hstep = (size_t)HALF * K * 2;
    const size_t tstep = 2 * hstep;
    const unsigned ldsw = (unsigned)wid * 1024u;
    const int aoff = lds_byte(wr * 64 + fr, fq * 8), boff = lds_byte(wc * 32 + fr, fq * 8);
#define PG8_SA(b, h) (((b) * 2 + (h)) * HTB)
#define PG8_SB(b, h) ((4 + (b) * 2 + (h)) * HTB)
#define PG8_STAGE(bufoff, gbase, voff) do { _Pragma("unroll") for (int _i = 0; _i < 2; ++_i) \
        __builtin_amdgcn_global_load_lds((const unsigned*)((const char*)(gbase) + (voff)[_i]), (PG8_LAS unsigned*)(lds + (bufoff) + ldsw + _i * 8192), 16, 0, 0); } while (0)
#define PG8_LDA(dst, b, h) do { if constexpr (F8) { _Pragma("unroll") for (int m = 0; m < 4; ++m) dst##8[m] = __builtin_shufflevector(*(const PG8_LAS i32x4_t*)(lds + PG8_SA(b, h) + aoff + m * 2048), *(const PG8_LAS i32x4_t*)(lds + PG8_SA(b, h) + aoff + m * 2048 + 1024), 0, 1, 2, 3, 4, 5, 6, 7); } \
        else { _Pragma("unroll") for (int m = 0; m < 4; ++m) _Pragma("unroll") for (int k = 0; k < 2; ++k) dst[m][k] = *(const PG8_LAS bf16x8*)(lds + PG8_SA(b, h) + aoff + m * 2048 + k * 1024); } } while (0)
#define PG8_LDB(dst, b, h) do { if constexpr (F8) { _Pragma("unroll") for (int n = 0; n < 2; ++n) dst##8[n] = __builtin_shufflevector(*(const PG8_LAS i32x4_t*)(lds + PG8_SB(b, h) + boff + n * 2048), *(const PG8_LAS i32x4_t*)(lds + PG8_SB(b, h) + boff + n * 2048 + 1024), 0, 1, 2, 3, 4, 5, 6, 7); } \
        else { _Pragma("unroll") for (int n = 0; n < 2; ++n) _Pragma("unroll") for (int k = 0; k < 2; ++k) dst[n][k] = *(const PG8_LAS bf16x8*)(lds + PG8_SB(b, h) + boff + n * 2048 + k * 1024); } } while (0)
#ifndef GEMM_PRIO
#define GEMM_PRIO 1
#endif
#define PG8_MMA(ai, bj, At, Bt) do { if (GEMM_PRIO) __builtin_amdgcn_s_setprio(GEMM_PRIO); \
        if constexpr (MX) { if constexpr (mx8) { _Pragma("unroll") for (int m = 0; m < 4; ++m) _Pragma("unroll") for (int n = 0; n < 2; ++n) mfma_f8_acc2(acc[ai][bj][m][n], Bt##8[n], At##8[m], 0x79797979, 0x7b7b7b7b, mx_sw, mx_sa); } \
            else { _Pragma("unroll") for (int m = 0; m < 4; ++m) _Pragma("unroll") for (int n = 0; n < 2; ++n) { \
                acc[ai][bj][m][n] = __builtin_amdgcn_mfma_f32_16x16x32_bf16(__builtin_bit_cast(bf16x8, __builtin_shufflevector(Bt##8[n], Bt##8[n], 0, 1, 2, 3)), __builtin_bit_cast(bf16x8, __builtin_shufflevector(At##8[m], At##8[m], 0, 1, 2, 3)), acc[ai][bj][m][n], 0, 0, 0); \
                acc[ai][bj][m][n] = __builtin_amdgcn_mfma_f32_16x16x32_bf16(__builtin_bit_cast(bf16x8, __builtin_shufflevector(Bt##8[n], Bt##8[n], 4, 5, 6, 7)), __builtin_bit_cast(bf16x8, __builtin_shufflevector(At##8[m], At##8[m], 4, 5, 6, 7)), acc[ai][bj][m][n], 0, 0, 0); } } } \
        else if constexpr (F8) { _Pragma("unroll") for (int m = 0; m < 4; ++m) _Pragma("unroll") for (int n = 0; n < 2; ++n) \
            mfma_f8_acc(acc[ai][bj][m][n], Bt##8[n], At##8[m], f8_scale); } \
        else if constexpr (I8) { _Pragma("unroll") for (int m = 0; m < 4; ++m) _Pragma("unroll") for (int n = 0; n < 2; ++n) _Pragma("unroll") for (int k = 0; k < 2; ++k) \
            acc[ai][bj][m][n] = __builtin_amdgcn_mfma_i32_16x16x64_i8(__builtin_bit_cast(i32x4_t, Bt[n][k]), __builtin_bit_cast(i32x4_t, At[m][k]), acc[ai][bj][m][n], 0, 0, 0); } \
        else { _Pragma("unroll") for (int m = 0; m < 4; ++m) _Pragma("unroll") for (int n = 0; n < 2; ++n) _Pragma("unroll") for (int k = 0; k < 2; ++k) \
            acc[ai][bj][m][n] = __builtin_amdgcn_mfma_f32_16x16x32_bf16(Bt[n][k], At[m][k], acc[ai][bj][m][n], 0, 0, 0); } \
        if (GEMM_PRIO) __builtin_amdgcn_s_setprio(0); } while (0)
#ifdef EMU
#define PG8_WAIT_V(n) ((void)0)
#define PG8_WAIT_L(n) ((void)0)
#else
#define PG8_WAIT_V(n) asm volatile("s_waitcnt vmcnt(" #n ")" ::: "memory")
#define PG8_WAIT_L(n) asm volatile("s_waitcnt lgkmcnt(" #n ")" ::: "memory")
#endif
#define PG8_BAR __builtin_amdgcn_s_barrier()
#define PG8_SCHED __builtin_amdgcn_sched_barrier(0)
    Unit cur, nxt; int ui = 0;
    if (!S.next(0, cur)) return;
    acc_v acc[2][2][4][2];
#pragma unroll
    for (int a = 0; a < 2; ++a)
#pragma unroll
        for (int b = 0; b < 2; ++b)
#pragma unroll
            for (int m = 0; m < 4; ++m)
#pragma unroll
                for (int n = 0; n < 2; ++n) acc[a][b][m][n] = (acc_v){0, 0, 0, 0};
    int f8_scale = 0x7f7f7f7f; OPAQUE_V(f8_scale);
    int mx_sw = 0x79797979, mx_sa = 0x7b7b7b7b; OPAQUE_V(mx_sw); OPAQUE_V(mx_sa);
    bf16x8 At[4][2], B0[2][2], B1[2][2]; v8i_t At8[4], B08[2], B18[2];
    const char* cA = (const char*)g.A + (size_t)cur.pm * tstep; const char* cB = (const char*)g.Bt + (size_t)cur.pn * tstep;
    S.a_ready(cur);
    if constexpr (SP2) {
        PG8_STAGE(PG8_SB(0, 0), cB, voffB); PG8_STAGE(PG8_SB(0, 1), cB + hstep, voffB); PG8_STAGE(PG8_SA(0, 0), cA, voffA); PG8_STAGE(PG8_SA(0, 1), cA + hstep, voffA);
        if (wr == 1) PG8_BAR;
        PG8_WAIT_V(2); PG8_BAR;
        PG8_STAGE(PG8_SB(1, 0), cB + kstep, voffB); PG8_STAGE(PG8_SA(1, 0), cA + kstep, voffA); PG8_STAGE(PG8_SB(1, 1), cB + hstep + kstep, voffB);
        PG8_WAIT_V(6); PG8_BAR;
    } else {
        PG8_STAGE(PG8_SB(0, 0), cB, voffB); PG8_STAGE(PG8_SA(0, 0), cA, voffA); PG8_STAGE(PG8_SB(0, 1), cB + hstep, voffB); PG8_STAGE(PG8_SA(0, 1), cA + hstep, voffA);
        if (wr == 1) PG8_BAR;
        PG8_WAIT_V(4); PG8_BAR;
        PG8_STAGE(PG8_SB(1, 0), cB + kstep, voffB); PG8_STAGE(PG8_SA(1, 0), cA + kstep, voffA); PG8_STAGE(PG8_SB(1, 1), cB + hstep + kstep, voffB);
        PG8_WAIT_V(6); PG8_BAR;
    }
    for (;;) {
        const bool has_next = S.next(ui + 1, nxt);
        const char* nA = has_next ? (const char*)g.A + (size_t)nxt.pm * tstep : cA; const char* nB = has_next ? (const char*)g.Bt + (size_t)nxt.pn * tstep : cB;
        auto kiter = [&](auto mxtag, const int t) __attribute__((always_inline)) {
            constexpr bool mx8 = MX && decltype(mxtag)::value; (void)mx8;
            const bool last = (t == nt - 2);
            const char* a1 = cA + (size_t)(t + 1) * kstep;
            const char* a2 = last ? nA : cA + (size_t)(t + 2) * kstep; const char* b2 = last ? nB : cB + (size_t)(t + 2) * kstep;
            const char* a3 = a2 + kstep; const char* b3 = b2 + kstep;
            if (last && has_next) S.a_ready(nxt);
            if constexpr (SP2) {
            PG8_LDB(B0, 0, 0); PG8_LDB(B1, 0, 1); PG8_SCHED; PG8_LDA(At, 0, 0); PG8_STAGE(PG8_SA(1, 1), a1 + hstep, voffA);
            PG8_WAIT_V(8); PG8_WAIT_L(0); PG8_BAR; PG8_MMA(0, 0, At, B0); PG8_MMA(0, 1, At, B1); PG8_BAR; PG8_SCHED;
            PG8_LDA(At, 0, 1); PG8_STAGE(PG8_SB(0, 0), b2, voffB); PG8_STAGE(PG8_SB(0, 1), b2 + hstep, voffB); PG8_STAGE(PG8_SA(0, 0), a2, voffA);
            PG8_WAIT_V(8); PG8_WAIT_L(0); PG8_BAR; PG8_MMA(1, 0, At, B0); PG8_MMA(1, 1, At, B1); PG8_BAR; PG8_SCHED;
            PG8_LDB(B0, 1, 0); PG8_LDB(B1, 1, 1); PG8_SCHED; PG8_LDA(At, 1, 0); PG8_STAGE(PG8_SA(0, 1), a2 + hstep, voffA);
            PG8_WAIT_V(8); PG8_WAIT_L(0); PG8_BAR; PG8_MMA(0, 0, At, B0); PG8_MMA(0, 1, At, B1); PG8_BAR; PG8_SCHED;
            PG8_LDA(At, 1, 1); PG8_STAGE(PG8_SB(1, 0), b3, voffB); PG8_STAGE(PG8_SB(1, 1), b3 + hstep, voffB); PG8_STAGE(PG8_SA(1, 0), a3, voffA);
            PG8_WAIT_V(8); PG8_WAIT_L(0); PG8_BAR; PG8_MMA(1, 0, At, B0); PG8_MMA(1, 1, At, B1); PG8_BAR; PG8_SCHED;
            } else {
            PG8_LDB(B0, 0, 0); PG8_SCHED; PG8_LDA(At, 0, 0); PG8_STAGE(PG8_SA(1, 1), a1 + hstep, voffA);
            PG8_WAIT_L(8); PG8_BAR; PG8_WAIT_L(0); PG8_MMA(0, 0, At, B0); PG8_BAR; PG8_SCHED;
            PG8_LDB(B1, 0, 1); PG8_STAGE(PG8_SB(0, 0), b2, voffB);
            PG8_BAR; PG8_WAIT_L(0); PG8_MMA(0, 1, At, B1); PG8_BAR;
            PG8_LDA(At, 0, 1); PG8_STAGE(PG8_SA(0, 0), a2, voffA);
            PG8_BAR; PG8_WAIT_L(0); PG8_MMA(1, 0, At, B0); PG8_BAR; PG8_SCHED;
            PG8_STAGE(PG8_SB(0, 1), b2 + hstep, voffB);
            PG8_WAIT_V(6); PG8_BAR; PG8_MMA(1, 1, At, B1); PG8_BAR;
            PG8_LDB(B0, 1, 0); PG8_SCHED; PG8_LDA(At, 1, 0); PG8_STAGE(PG8_SA(0, 1), a2 + hstep, voffA);
            PG8_WAIT_L(8); PG8_BAR; PG8_WAIT_L(0); PG8_MMA(0, 0, At, B0); PG8_BAR; PG8_SCHED;
            PG8_LDB(B1, 1, 1); PG8_STAGE(PG8_SB(1, 0), b3, voffB);
            PG8_BAR; PG8_WAIT_L(0); PG8_MMA(0, 1, At, B1); PG8_BAR;
            PG8_LDA(At, 1, 1); PG8_STAGE(PG8_SA(1, 0), a3, voffA);
            PG8_BAR; PG8_WAIT_L(0); PG8_MMA(1, 0, At, B0); PG8_BAR; PG8_SCHED;
            PG8_STAGE(PG8_SB(1, 1), b3 + hstep, voffB);
            PG8_WAIT_V(6); PG8_BAR; PG8_MMA(1, 1, At, B1); PG8_BAR;
            }
        };
        if constexpr (MX) { for (int t = 0; t < NT8; t += 2) kiter(std::true_type{}, t); for (int t = NT8; t < nt; t += 2) kiter(std::false_type{}, t); }
        else { for (int t = 0; t < nt; t += 2) kiter(std::false_type{}, t); }
        if constexpr (ALIGN_EPI) { if (wr == 0) PG8_BAR; }
        if constexpr (F8) { F8_PAD(); }
        if constexpr (!Epi::AFTER_DRAIN) { E(acc, cur, wr, wc, fr, fq); S.done(cur); }
        if (!has_next) break;
#pragma unroll
        for (int a = 0; a < 2; ++a)
#pragma unroll
            for (int b = 0; b < 2; ++b)
#pragma unroll
                for (int m = 0; m < 4; ++m)
#pragma unroll
                    for (int n = 0; n < 2; ++n) acc[a][b][m][n] = (acc_v){0, 0, 0, 0};
        cur = nxt; cA = nA; cB = nB; ++ui;
        if constexpr (ALIGN_EPI) { if (wr == 1) PG8_BAR; }
    }
    PG8_WAIT_V(0);
    if constexpr (!ALIGN_EPI) { if (wr == 0) PG8_BAR; }
    PG8_BAR;
    if constexpr (Epi::AFTER_DRAIN) { E.fused(acc, cur, wr, wc, fr, fq, lds, wid, lane); S.done(cur); }
#undef PG8_SA
#undef PG8_SB
#undef PG8_STAGE
#undef PG8_LDA
#undef PG8_LDB
#undef PG8_MMA
#undef PG8_WAIT_V
#undef PG8_WAIT_L
#undef PG8_BAR
#undef PG8_SCHED
}
}


constexpr int BATCH = CFG_BATCH, SEQ = CFG_SEQ, DM = CFG_DM, DFF = CFG_DFF, DEPTH = 2;
constexpr int M = BATCH * SEQ, NCH = SEQ / 128;
constexpr int DMIX = 4096, DPLE = 256, D_IN = 11800;
constexpr int NU = 12032;
constexpr int UQ = 0, UK = 1536, UV = 3072, UZ = 4608, UX = 6144, UB = 7680, UC = 8192, USB = 8704, USC = 9728, USH = 10752, UDT = 11776;
constexpr float LN_EPS = 1e-5f, RMS_EPS = 1e-5f, DN_ALPHA = 1.41421356237f, ATT_SCALE = 0.08838834764831845f;
static_assert(SEQ % 2048 == 0 && M % 256 == 0 && DM % 256 == 0 && DFF % 256 == 0 && DM <= DMIX, "shape");
constexpr int NQKV = 4608, NREST = NU - NQKV;
constexpr size_t WINB_OFF = (size_t)NQKV * DM;
DI int remap_u(int n) { return n < 8704 ? n : (n < 8728 ? UDT + (n - 8704) : n - 24); }

constexpr int CAT_PITCH = ATT_FP8 ? 3328 : 4096;
constexpr int CAT_SSM = ATT_FP8 ? 768 : 1536, CAT_SC = CAT_SSM + 1536;
constexpr int ATT_PITCH = ATT_FP8 ? 1536 : CAT_PITCH;
typedef pg8::bf16_t bf16;
typedef pg8::f32x4 f32x4;
typedef pg8::u32x4 u32x4;
typedef pg8::bf16x8 bf16x8;
typedef pg8::u32x2 u32x2;
typedef short s16x4 __attribute__((ext_vector_type(4)));

constexpr size_t al256(size_t x) { return (x + 255) & ~(size_t)255; }
constexpr size_t WS_CTL = 0, CTL_BYTES = 1u << 20;
constexpr size_t WS_WIN = WS_CTL + CTL_BYTES;
constexpr size_t WS_WOUT = WS_WIN + al256((size_t)NU * DM * 2);
constexpr size_t WS_WUP = WS_WOUT + al256((size_t)DM * DMIX * 2);
constexpr size_t WS_WDN = WS_WUP + al256((size_t)DFF * DM * 2);
constexpr size_t WS_WGT = WS_WDN + al256((size_t)DM * DFF * 2);
constexpr size_t WS_WPE = WS_WGT + al256((size_t)DM * DM * 2);
constexpr size_t WS_XB = WS_WPE + al256((size_t)DM * DPLE * 2);
constexpr size_t WS_XF = WS_XB + al256((size_t)M * DM * 2);
constexpr size_t WS_CAT = WS_XF + al256((size_t)M * DM * 2);
constexpr size_t WS_PB = WS_CAT + al256((size_t)M * DMIX * 2);
constexpr size_t WS_LSE = WS_PB + al256((size_t)DEPTH * M * DPLE * 2);
constexpr size_t WS_ROPE = WS_LSE + al256((size_t)M * 12 * 4);
constexpr size_t WS_CD = WS_ROPE + al256((size_t)SEQ * 32 * 4);
constexpr size_t WS_EMB = WS_CD + al256((size_t)BATCH * NCH * 24 * 4);
constexpr size_t WS_YS = WS_EMB + al256((size_t)M * DM * 2);
constexpr size_t WS_XC = WS_YS + al256((size_t)256 * 6 * 16 * 512 * 4);
constexpr size_t WS_PVB = WS_XC + al256((size_t)M * 2560 * 2);
constexpr size_t WS_X8 = WS_PVB + al256((size_t)BATCH * NCH * 24 * 8192 * 2);
constexpr size_t WS_SA = WS_X8 + al256((size_t)M * DM);
constexpr size_t WS_SW = WS_SA + al256((size_t)M * 4);
constexpr size_t WS_SWG = WS_SW + al256((size_t)DFF * 4);
constexpr size_t WS_ATT = WS_SWG + al256((size_t)DM * 4);
constexpr size_t WS_BIG = WS_ATT + al256((size_t)M * 1536 * 2);
constexpr size_t BIG_U_BYTES = al256((size_t)M * NU * 2), BIG_ST_BYTES = al256((size_t)BATCH * NCH * 24 * 64 * 128 * 4), BIG_H_BYTES = al256((size_t)M * DFF * 2);
constexpr size_t BIG_BYTES = (BIG_U_BYTES + BIG_ST_BYTES) > BIG_H_BYTES ? (BIG_U_BYTES + BIG_ST_BYTES) : BIG_H_BYTES;
constexpr size_t WS_END = WS_BIG + BIG_BYTES;

constexpr int RING_BYTES = 139264;
constexpr int MISC_OFF = RING_BYTES;
constexpr int LDS_BYTES = 147456;

DI float bf2f(unsigned short b) { return __uint_as_float(((unsigned)b) << 16); }
DI unsigned short f2bf(float f) { unsigned u = __float_as_uint(f); return (unsigned short)((u + 0x7fffu + ((u >> 16) & 1u)) >> 16); }
DI unsigned pk2(float lo, float hi) { return (unsigned)f2bf(lo) | ((unsigned)f2bf(hi) << 16); }
DI float rcp_f(float x) { return __builtin_amdgcn_rcpf(x); }
DI float silu_f(float x) { return x * rcp_f(1.f + __expf(-x)); }
DI float softplus_f(float x) { return (x > 0.f ? x : 0.f) + log1pf(__expf(-fabsf(x))); }
#ifdef EMU
DI bf16x8 tr_read2(const bf16* p_lo, const bf16* p_hi) { const emu_s16x4 a = emu_tr_read_b64(p_lo), b = emu_tr_read_b64(p_hi); return __builtin_shufflevector(a, b, 0, 1, 2, 3, 4, 5, 6, 7); }
#else
DI bf16x8 tr_read2(const LAS bf16* p_lo, const LAS bf16* p_hi) { s16x4 a, b;
    asm volatile("ds_read_b64_tr_b16 %0, %2\n\tds_read_b64_tr_b16 %1, %3\n\ts_waitcnt lgkmcnt(0)" : "=&v"(a), "=&v"(b) : "v"((unsigned)(size_t)p_lo), "v"((unsigned)(size_t)p_hi) : "memory");
    return __builtin_shufflevector(a, b, 0, 1, 2, 3, 4, 5, 6, 7); }
#endif
#ifdef EMU
DI float shfl_f(float v, int src) { return emu::shfl_idx(v, src); }
#else
DI float shfl_f(float v, int src) { return __int_as_float(__builtin_amdgcn_ds_bpermute(src << 2, __float_as_int(v))); }
#endif
#ifdef EMU
DI int bcast_lane0(int v) { return emu::shfl_idx(v, 0); }
#else
DI int bcast_lane0(int v) { return __builtin_amdgcn_readfirstlane(v); }
#endif
DI float wave_sum(float v, int lane) {
#pragma unroll
    for (int o = 1; o < 64; o <<= 1) v += shfl_f(v, lane ^ o);
    return v; }
DI float wave_max(float v, int lane) {
#pragma unroll
    for (int o = 1; o < 64; o <<= 1) v = fmaxf(v, shfl_f(v, lane ^ o));
    return v; }

#ifdef EMU
DI unsigned char* ld_ws(unsigned char* p) { return p; }
DI float* ld_out(float* p) { return p; }
DI int ld_grid() { return (int)gridDim.x; }
#else
DI int ld_grid() { int v; asm volatile("s_load_dword %0, %1, 0xc0\n\ts_waitcnt lgkmcnt(0)" : "=s"(v) : "s"(__builtin_amdgcn_kernarg_segment_ptr())); return v; }
DI unsigned long long karg_u64_168() { unsigned long long v; asm volatile("s_load_dwordx2 %0, %1, 0xa8\n\ts_waitcnt lgkmcnt(0)" : "=s"(v) : "s"(__builtin_amdgcn_kernarg_segment_ptr())); return v; }
DI unsigned long long karg_u64_176() { unsigned long long v; asm volatile("s_load_dwordx2 %0, %1, 0xb0\n\ts_waitcnt lgkmcnt(0)" : "=s"(v) : "s"(__builtin_amdgcn_kernarg_segment_ptr())); return v; }
DI unsigned char* ld_ws(unsigned char*) { return (unsigned char*)(GAS unsigned char*)karg_u64_176(); }
DI float* ld_out(float*) { return (float*)(GAS float*)karg_u64_168(); }
#endif
#define XB_TMO      128
#define XB_XCNT(j)  (256  + 64 * (j))
#define XB_XSUB(j)  (1280 + 64 * (j))
#define XB_XGEN(j)  (2304 + 64 * (j))
#define XB_TOP      3328
#define XB_TOPGEN   3392
#define XCD_BAR_WORDS 3456
#define XB_SPIN_CAP (1u << 18)

__device__ __forceinline__ unsigned xb_ld(unsigned* p)              { return __hip_atomic_load(p, __ATOMIC_RELAXED, __HIP_MEMORY_SCOPE_AGENT); }
__device__ __forceinline__ unsigned xb_add(unsigned* p, unsigned v) { return __hip_atomic_fetch_add(p, v, __ATOMIC_RELAXED, __HIP_MEMORY_SCOPE_AGENT); }
__device__ __forceinline__ unsigned xb_xcc_id() { return (unsigned)__builtin_amdgcn_s_getreg((3 << 11) | 20) & 0xFu; }
#define XB_SPIN(cond, bar) do { unsigned _sp = 0; while (cond) { __builtin_amdgcn_s_sleep(1); \
    if ((++_sp & 255u) == 0u) { if (xb_ld(&(bar)[XB_TMO])) break; if (_sp > XB_SPIN_CAP) { atomicAdd(&(bar)[XB_TMO], 1u); break; } } } } while (0)

struct XcdBarrier {
    unsigned* bar; unsigned x;
    volatile LAS unsigned* st;
};

__device__ __forceinline__ XcdBarrier xcd_barrier_post(unsigned* bar, volatile LAS unsigned* st) {
    XcdBarrier b; b.bar = bar; b.x = xb_xcc_id(); b.st = st;
    if (threadIdx.x == 0) (void)xb_add(&bar[XB_XCNT(b.x)], 1u);
    return b;
}
__device__ __forceinline__ void xcd_barrier_complete(unsigned* bar, unsigned x, unsigned& nloc, unsigned& nx) {
    const unsigned G = (unsigned)ld_grid();
    unsigned sum, cnt, mine, sp = 0u;
    for (;;) {
        sum = 0u; cnt = 0u; mine = 0u;
#pragma unroll
        for (unsigned j = 0; j < 16; ++j) { const unsigned c = xb_ld(&bar[XB_XCNT(j)]); sum += c; cnt += (c > 0u) ? 1u : 0u; mine = (j == x) ? c : mine; }
        if (sum == G) break;
        __builtin_amdgcn_s_sleep(1);
        if ((++sp & 255u) == 0u) { if (xb_ld(&bar[XB_TMO])) break; if (sp > XB_SPIN_CAP) { atomicAdd(&bar[XB_TMO], 1u); break; } }
    }
    nloc = mine > 0u ? mine : 1u; nx = cnt > 0u ? cnt : 1u;
}

__device__ __forceinline__ void xcd_barrier(const XcdBarrier& b) {
    WAIT_VM0();
    __syncthreads();
    if (threadIdx.x == 0) {
        unsigned* bar = b.bar;
        __builtin_amdgcn_s_waitcnt(0);
        unsigned nloc = b.st[0], nx = b.st[1];
        if (nloc == 0u) { xcd_barrier_complete(bar, b.x, nloc, nx); b.st[0] = nloc; b.st[1] = nx; }
        const unsigned old = xb_add(&bar[XB_XSUB(b.x)], 1u);
        const unsigned gen = old / nloc;
        if (old + 1u == (gen + 1u) * nloc) {
            __builtin_amdgcn_fence(__ATOMIC_RELEASE, "agent");
            WAIT_VM0();
            const unsigned og = xb_add(&bar[XB_TOP], 1u);
            const unsigned tg = og / nx;
            if (og + 1u == (tg + 1u) * nx) xb_add(&bar[XB_TOPGEN], 1u);
            else XB_SPIN(xb_ld(&bar[XB_TOPGEN]) == tg, bar);
            __builtin_amdgcn_fence(__ATOMIC_ACQUIRE, "agent");
            xb_add(&bar[XB_XGEN(b.x)], 1u);
            WAIT_VM0();
        } else {
            XB_SPIN(xb_ld(&bar[XB_XGEN(b.x)]) == gen, bar);
            __builtin_amdgcn_fence(__ATOMIC_ACQUIRE, "agent");
            WAIT_VM0();
        }
    }
    __syncthreads();
}

constexpr int PTAB_OFF = MISC_OFF + 256;
DI const float* inp(LAS unsigned char* lds, int i) { const LAS unsigned* t = (const LAS unsigned*)(lds + PTAB_OFF) + 2 * i;
    const unsigned lo = __builtin_amdgcn_readfirstlane(t[0]), hi = __builtin_amdgcn_readfirstlane(t[1]); return (const float*)(const GAS float*)(((unsigned long long)hi << 32) | (unsigned long long)lo); }
DI unsigned char* opq(unsigned char* p) { unsigned lo = __builtin_amdgcn_readfirstlane((unsigned)(size_t)p), hi = __builtin_amdgcn_readfirstlane((unsigned)((size_t)p >> 32)); OPAQUE_S(lo); OPAQUE_S(hi); return (unsigned char*)(GAS unsigned char*)(((size_t)hi << 32) | (size_t)lo); }
struct Params { const float* in[21]; float* out; unsigned char* ws; int ph_lo, ph_hi; int grid, pad; };
enum { I_X = 0, I_P, I_WIN, I_CW, I_CB, I_DTB, I_ALOG, I_SD, I_NW, I_SCW, I_WOUT, I_L1G, I_L1B, I_WUP, I_WDN, I_L2G, I_L2B, I_WPE, I_WGT, I_L3G, I_L3B };

template <bool REMAP> DI void transpose_item(const float* W, int K, int N, bf16* WT, LAS float* scr, int item, int lane, int row_off = 0, int dpitch = 0, int koff = 0) {
    const int nblk = (N + 63) / 64, kb = item / nblk, nb = item % nblk, k0 = 64 * kb, n0 = 64 * nb;
    const int r4 = lane >> 4, c4 = lane & 15, nl = n0 + 4 * c4;
    f32x4 v[16];
#pragma unroll
    for (int i = 0; i < 16; ++i) v[i] = nl < N ? NT_LOAD((const f32x4*)(W + (size_t)(k0 + 4 * i + r4) * N + nl)) : (f32x4){0.f, 0.f, 0.f, 0.f};
#pragma unroll
    for (int i = 0; i < 16; ++i) { LAS float* d = scr + (4 * i + r4) * 65 + 4 * c4; d[0] = v[i][0]; d[1] = v[i][1]; d[2] = v[i][2]; d[3] = v[i][3]; }
    WAVE_SYNC();
#pragma unroll
    for (int j = 0; j < 8; ++j) { const int chunk = lane + 64 * j, nn = chunk >> 3, kc = chunk & 7, n = n0 + nn; const LAS float* s = scr + (8 * kc) * 65 + nn;
        u32x4 o; o.x = pk2(s[0 * 65], s[1 * 65]); o.y = pk2(s[2 * 65], s[3 * 65]); o.z = pk2(s[4 * 65], s[5 * 65]); o.w = pk2(s[6 * 65], s[7 * 65]);
        if (n < N) { const int row = (REMAP ? remap_u(n) : n) - row_off; *(u32x4*)(WT + (size_t)row * (dpitch ? dpitch : K) + k0 + koff + 8 * kc) = o; } }
    WAVE_SYNC();
}
DI unsigned pk4_fp8(float a, float b, float c, float d) { int w = 0; w = __builtin_amdgcn_cvt_pk_fp8_f32(a, b, w, false); w = __builtin_amdgcn_cvt_pk_fp8_f32(c, d, w, true); return (unsigned)w; }
DI void transpose_item_fp8(const float* W, int K, int N, unsigned char* WT8, LAS float* scr, int item, int lane, int dpitch = 0) {
    const int nblk = (N + 63) / 64, kb = item / nblk, nb = item % nblk, k0 = 64 * kb, n0 = 64 * nb;
    const int r4 = lane >> 4, c4 = lane & 15, nl = n0 + 4 * c4;
    f32x4 v[16];
#pragma unroll
    for (int i = 0; i < 16; ++i) v[i] = nl < N ? NT_LOAD((const f32x4*)(W + (size_t)(k0 + 4 * i + r4) * N + nl)) : (f32x4){0.f, 0.f, 0.f, 0.f};
#pragma unroll
    for (int i = 0; i < 16; ++i) { LAS float* d = scr + (4 * i + r4) * 65 + 4 * c4; d[0] = v[i][0]; d[1] = v[i][1]; d[2] = v[i][2]; d[3] = v[i][3]; }
    WAVE_SYNC();
#pragma unroll
    for (int j = 0; j < 4; ++j) { const int chunk = lane + 64 * j, nn = chunk >> 2, kc = chunk & 3, n = n0 + nn; const LAS float* s = scr + (16 * kc) * 65 + nn;
        u32x4 o;
#pragma unroll
        for (int e = 0; e < 4; ++e) o[e] = pk4_fp8(s[(4 * e) * 65] * 64.f, s[(4 * e + 1) * 65] * 64.f, s[(4 * e + 2) * 65] * 64.f, s[(4 * e + 3) * 65] * 64.f);
        if (n < N) *(u32x4*)(WT8 + (size_t)n * (dpitch ? dpitch : K) + k0 + 16 * kc) = o; }
    WAVE_SYNC();
}
DI void upq_strips(const float* W, int K, int N, signed char* WT8, float* sw_out, LAS unsigned char* lds, int BID, int GSZ, int wave, int lane) {
    LAS float* scr = (LAS float*)(lds + wave * 16640); LAS float* cmx = (LAS float*)(lds + 8 * 16640); LAS float* inv = cmx + 8 * 64;
    const int r4 = lane >> 4, c4 = lane & 15, ntile = K / 64;
    for (int s = BID; s < N / 64; s += GSZ) { const int n0 = 64 * s;
        f32x4 mx = {0.f, 0.f, 0.f, 0.f};
        for (int kb = wave; kb < ntile; kb += 16) {
            f32x4 v[2][16]; const bool two = kb + 8 < ntile;
#pragma unroll
            for (int i = 0; i < 16; ++i) { v[0][i] = *(const f32x4*)(W + (size_t)(64 * kb + 4 * i + r4) * N + n0 + 4 * c4); v[1][i] = two ? *(const f32x4*)(W + (size_t)(64 * (kb + 8) + 4 * i + r4) * N + n0 + 4 * c4) : (f32x4){0.f, 0.f, 0.f, 0.f}; }
#pragma unroll
            for (int i = 0; i < 16; ++i)
#pragma unroll
                for (int e = 0; e < 4; ++e) mx[e] = fmaxf(mx[e], fmaxf(fabsf(v[0][i][e]), fabsf(v[1][i][e]))); }
#pragma unroll
        for (int e = 0; e < 4; ++e) { mx[e] = fmaxf(mx[e], shfl_f(mx[e], lane ^ 16)); mx[e] = fmaxf(mx[e], shfl_f(mx[e], lane ^ 32)); }
        if (r4 == 0) { cmx[wave * 64 + 4 * c4] = mx[0]; cmx[wave * 64 + 4 * c4 + 1] = mx[1]; cmx[wave * 64 + 4 * c4 + 2] = mx[2]; cmx[wave * 64 + 4 * c4 + 3] = mx[3]; }
        __syncthreads();
        if (wave == 0) { float m = 0.f;
#pragma unroll
            for (int w = 0; w < 8; ++w) m = fmaxf(m, cmx[w * 64 + lane]);
            m = fmaxf(m, 1e-30f); inv[lane] = 127.f / m; sw_out[n0 + lane] = m * (1.f / 127.f); }
        __syncthreads();
        f32x4 v[16];
#pragma unroll
        for (int i = 0; i < 16; ++i) v[i] = *(const f32x4*)(W + (size_t)(64 * wave + 4 * i + r4) * N + n0 + 4 * c4);
        for (int kb = wave; kb < ntile; kb += 8) { const int k0 = 64 * kb;
#pragma unroll
            for (int i = 0; i < 16; ++i) { LAS float* d = scr + (4 * i + r4) * 65 + 4 * c4; d[0] = v[i][0]; d[1] = v[i][1]; d[2] = v[i][2]; d[3] = v[i][3]; }
            if (kb + 8 < ntile) {
#pragma unroll
                for (int i = 0; i < 16; ++i) v[i] = *(const f32x4*)(W + (size_t)(k0 + 512 + 4 * i + r4) * N + n0 + 4 * c4); }
            WAVE_SYNC();
#pragma unroll
            for (int j = 0; j < 4; ++j) { const int chunk = lane + 64 * j, nn = chunk >> 2, kc = chunk & 3; const LAS float* sp = scr + (16 * kc) * 65 + nn; const float iv = inv[nn];
                u32x4 o;
#pragma unroll
                for (int e = 0; e < 4; ++e) { unsigned w = 0;
#pragma unroll
                    for (int b = 0; b < 4; ++b) w |= ((unsigned)(__float2int_rn(sp[(4 * e + b) * 65] * iv) & 0xff)) << (8 * b);
                    o[e] = w; }
                *(u32x4*)(WT8 + (size_t)(n0 + nn) * K + k0 + 16 * kc) = o; }
            WAVE_SYNC(); }
        __syncthreads();
    }
}
PHASE_FN phase_weights(unsigned char* wsarg, int L, LAS unsigned char* lds, int qsel = 0) {
    int BID = blockIdx.x, GSZ = ld_grid(); OPAQUE_S(BID); OPAQUE_S(GSZ); OPAQUE_S(lds);
    unsigned char* const WSQ = ld_ws(wsarg);
    int tid_o = threadIdx.x; OPAQUE_V(tid_o);
    const int tid = tid_o, lane = tid & 63, wave = __builtin_amdgcn_readfirstlane(tid >> 6);
    LAS float* scr = (LAS float*)(lds + wave * 16640);
    const int gw = BID * 8 + wave, NGW = GSZ * 8;
    unsigned char* ws = WSQ;
    const float* win = inp(lds, I_WIN) + (size_t)L * DM * D_IN; const float* wout = inp(lds, I_WOUT) + (size_t)L * DMIX * DM; const float* wup = inp(lds, I_WUP) + (size_t)L * DM * DFF;
    const float* wdn = inp(lds, I_WDN) + (size_t)L * DFF * DM; const float* wgt = inp(lds, I_WGT) + (size_t)L * DM * DM; const float* wpe = inp(lds, I_WPE) + (size_t)L * DPLE * DM;
    constexpr int I_1 = (DM / 64) * ((D_IN + 63) / 64), I_2 = (DMIX / 64) * (DM / 64), I_3 = (DM / 64) * (DFF / 64), I_4 = (DFF / 64) * (DM / 64), I_5 = (DM / 64) * (DM / 64), I_6 = (DPLE / 64) * (DM / 64);
    static_assert(8 * 16640 + 8 * 64 * 4 + 256 <= RING_BYTES && D_IN % 4 == 0 && DM % 64 == 0 && DFF % 64 == 0, "weights phase tiles");
    constexpr int NIT = I_1 + I_2 + I_3 + I_4 + I_5 + I_6;
    if ((UP_INT8 >> L) & 1) upq_strips(wup, DM, DFF, (signed char*)(ws + WS_WUP), (float*)(ws + WS_SW), lds, BID, GSZ, wave, lane);
    if (GATE_INT8) upq_strips(wgt, DM, DM, (signed char*)(ws + WS_WGT), (float*)(ws + WS_SWG), lds, (BID + GSZ / 2) % GSZ, GSZ, wave, lane);
    unsigned* qctr = (unsigned*)(ws + WS_CTL) + 12288 + 64 * (2 * L + (int)(qsel & 1)); (void)gw; (void)NGW;
    for (;;) { unsigned c0 = 0; if (lane == 0) c0 = __hip_atomic_fetch_add(qctr, 16u, __ATOMIC_RELAXED, __HIP_MEMORY_SCOPE_AGENT);
      c0 = (unsigned)bcast_lane0((int)c0); if (c0 >= (unsigned)NIT) break;
      for (int it = (int)c0; it < (int)c0 + 16 && it < NIT; ++it) {
        int r = it;
        if (r < I_1) { if (QKV_FP8) { if (r % ((D_IN + 63) / 64) < NQKV / 64) transpose_item_fp8(win, DM, D_IN, ws + WS_WIN, scr, r, lane); else transpose_item<true>(win, DM, D_IN, (bf16*)(ws + WS_WIN + WINB_OFF), scr, r, lane, NQKV); }
                       else transpose_item<true>(win, DM, D_IN, (bf16*)(ws + WS_WIN), scr, r, lane); continue; } r -= I_1;
        if (r < I_2) { if (ATT_FP8) { if (r / (DM / 64) < 1536 / 64) transpose_item_fp8(wout, DMIX, DM, ws + WS_WOUT, scr, r, lane, CAT_PITCH * 2); else transpose_item<false>(wout, DMIX, DM, (bf16*)(ws + WS_WOUT), scr, r, lane, 0, CAT_PITCH, -768); }
                       else transpose_item<false>(wout, DMIX, DM, (bf16*)(ws + WS_WOUT), scr, r, lane); continue; } r -= I_2;
        if (r < I_3) { if (!((UP_INT8 >> L) & 1)) transpose_item<false>(wup, DM, DFF, (bf16*)(ws + WS_WUP), scr, r, lane); continue; } r -= I_3;
        if (r < I_4) { transpose_item<false>(wdn, DFF, DM, (bf16*)(ws + WS_WDN), scr, r, lane); continue; } r -= I_4;
        if (r < I_5) { if (GATE_INT8) {} else if (GATE_FP8) transpose_item_fp8(wgt, DM, DM, ws + WS_WGT, scr, r, lane); else transpose_item<false>(wgt, DM, DM, (bf16*)(ws + WS_WGT), scr, r, lane); continue; } r -= I_5;
        transpose_item<false>(wpe, DPLE, DM, (bf16*)(ws + WS_WPE), scr, r, lane);
      } }
    const size_t gt = (size_t)BID * 512 + tid, GT = (size_t)GSZ * 512;
    if (L == 0) {
        { u32x4* z = QKV_FP8 ? (u32x4*)((bf16*)(ws + WS_WIN + WINB_OFF) + (size_t)(D_IN - NQKV) * DM) : (u32x4*)((bf16*)(ws + WS_WIN) + (size_t)D_IN * DM); const size_t n16 = (size_t)(NU - D_IN) * DM / 8; for (size_t i = gt; i < n16; i += GT) z[i] = (u32x4){0u, 0u, 0u, 0u}; }
        { const f32x4* x4 = (const f32x4*)inp(lds, I_X); u32x2* o = (u32x2*)(ws + WS_XB); unsigned* o8 = (unsigned*)(ws + WS_X8); for (size_t i = gt; i < (size_t)M * DM / 4; i += GT) { const f32x4 v = x4[i]; u32x2 w; w.x = pk2(v[0], v[1]); w.y = pk2(v[2], v[3]); o[i] = w; if (QKV_FP8) o8[i] = pk4_fp8(v[0], v[1], v[2], v[3]); } }
        { const f32x4* p4 = (const f32x4*)inp(lds, I_P); u32x2* o = (u32x2*)(ws + WS_PB); for (size_t i = gt; i < (size_t)DEPTH * M * DPLE / 4; i += GT) { const f32x4 v = p4[i]; u32x2 w; w.x = pk2(v[0], v[1]); w.y = pk2(v[2], v[3]); o[i] = w; } }
        { float* rt = (float*)(ws + WS_ROPE); for (size_t i = gt; i < (size_t)SEQ * 16; i += GT) { const int pos = (int)(i >> 4), k = (int)(i & 15);
            const float inv = exp2f(-(float)k * (18.931568569324174f / 16.0f)); const float ang = (float)pos * inv; rt[pos * 32 + k] = cosf(ang); rt[pos * 32 + 16 + k] = sinf(ang); } }
    }
}

PHASE_FN phase_rope(unsigned char* wsarg, LAS unsigned char* lds) {
    int BID = blockIdx.x, GSZ = ld_grid(); OPAQUE_S(BID); OPAQUE_S(GSZ); OPAQUE_S(lds);
    unsigned char* const WSQ = ld_ws(wsarg);
    bf16* U = (bf16*)(WSQ + WS_BIG); const float* rt = (const float*)(WSQ + WS_ROPE);
    int tid_o = threadIdx.x; OPAQUE_V(tid_o);
    const size_t gt = (size_t)BID * 512 + tid_o, GT = (size_t)GSZ * 512;
    for (size_t i = gt; i < (size_t)M * 24; i += GT) {
        const int m = (int)(i / 24), hh = (int)(i % 24), pos = m % SEQ;
        bf16* p = U + (size_t)m * NU + (hh < 12 ? UQ + hh * 128 : UK + (hh - 12) * 128);
        const float* cs = rt + pos * 32;
#pragma unroll
        for (int h2 = 0; h2 < 2; ++h2) { u32x4 a = *(u32x4*)(p + 8 * h2), bq = *(u32x4*)(p + 16 + 8 * h2);
#pragma unroll
            for (int w = 0; w < 4; ++w) { const int k = h2 * 8 + w * 2; const unsigned xa = a[w], xb = bq[w];
                const float x1l = __uint_as_float(xa << 16), x1h = __uint_as_float(xa & 0xffff0000u), x2l = __uint_as_float(xb << 16), x2h = __uint_as_float(xb & 0xffff0000u);
                const float c0 = cs[k], c1 = cs[k + 1], s0 = cs[16 + k], s1 = cs[16 + k + 1];
                a[w] = pk2(x1l * c0 - x2l * s0, x1h * c1 - x2h * s1); bq[w] = pk2(x2l * c0 + x1l * s0, x2h * c1 + x1h * s1); }
            *(u32x4*)(p + 8 * h2) = a; *(u32x4*)(p + 16 + 8 * h2) = bq; }
    }
}

PHASE_FN phase_attn_naive(unsigned char* wsarg, LAS unsigned char* lds) {
    int BID = blockIdx.x, GSZ = ld_grid(); OPAQUE_S(BID); OPAQUE_S(GSZ); OPAQUE_S(lds);
    unsigned char* const WSQ = ld_ws(wsarg);
    int tid_o = threadIdx.x; OPAQUE_V(tid_o);
    const int tid = tid_o, lane = tid & 63, wave = __builtin_amdgcn_readfirstlane(tid >> 6);
    LAS float* qs = (LAS float*)(lds + wave * 2048); LAS float* ps = qs + 128;
    const bf16* U = (const bf16*)(WSQ + WS_BIG); bf16* AO = (bf16*)(WSQ + (ATT_FP8 ? WS_ATT : WS_CAT)); float* LSE = (float*)(WSQ + WS_LSE);
    const int gw = BID * 8 + wave, NGW = GSZ * 8;
    for (int it = gw; it < M * 12; it += NGW) {
        const int head = it % 12, m = it / 12, t = m % SEQ, g = head >> 2, d = g == 0 ? 1 : (g == 1 ? 4 : 16);
        { const unsigned qq = *(const unsigned*)(U + (size_t)m * NU + UQ + head * 128 + 2 * lane); qs[2 * lane] = __uint_as_float(qq << 16) * ATT_SCALE; qs[2 * lane + 1] = __uint_as_float(qq & 0xffff0000u) * ATT_SCALE; }
        WAVE_SYNC();
        float sc[3];
#pragma unroll
        for (int r = 0; r < 3; ++r) { const int j = lane + 64 * r; const bool ok = (j <= 128) && (t - j * d >= 0); float s = -INFINITY;
            if (ok) { const bf16* kr = U + (size_t)(m - j * d) * NU + UK + head * 128; s = 0.f;
                for (int c = 0; c < 16; ++c) { const u32x4 kv = *(const u32x4*)(kr + 8 * c);
#pragma unroll
                    for (int w = 0; w < 4; ++w) s += qs[8 * c + 2 * w] * __uint_as_float(kv[w] << 16) + qs[8 * c + 2 * w + 1] * __uint_as_float(kv[w] & 0xffff0000u); } }
            sc[r] = s; }
        const float mx = wave_max(fmaxf(fmaxf(sc[0], sc[1]), sc[2]), lane);
        float psum = 0.f;
#pragma unroll
        for (int r = 0; r < 3; ++r) { const int j = lane + 64 * r; const float p = (sc[r] == -INFINITY) ? 0.f : __expf(sc[r] - mx); psum += p; if (j <= 128) ps[j] = p; }
        const float den = wave_sum(psum, lane);
        WAVE_SYNC();
        float a0 = 0.f, a1 = 0.f;
        for (int j = 0; j <= 128; ++j) { if (t - j * d < 0) break; const float pj = ps[j]; const unsigned vv = *(const unsigned*)(U + (size_t)(m - j * d) * NU + UV + head * 128 + 2 * lane);
            a0 += pj * __uint_as_float(vv << 16); a1 += pj * __uint_as_float(vv & 0xffff0000u); }
        const float inv = 1.f / den;
        *(unsigned*)(AO + (size_t)m * ATT_PITCH + head * 128 + 2 * lane) = pk2(a0 * inv, a1 * inv);
        if (lane == 0) LSE[(size_t)m * 12 + head] = mx + __logf(den);
        WAVE_SYNC();
    }
}

constexpr int AK_STRIDE = 136, AV_STRIDE = 264;
constexpr int AL_K = 0, AL_V = 256 * AK_STRIDE * 2, AL_END = AL_V + 128 * AV_STRIDE * 2;
PHASE_FN phase_attn_mfma(unsigned char* wsarg, LAS unsigned char* lds) {
    int BID = blockIdx.x, GSZ = ld_grid(); OPAQUE_S(BID); OPAQUE_S(GSZ); OPAQUE_S(lds);
    unsigned char* const WSQ = ld_ws(wsarg);
    int tid_o = threadIdx.x; OPAQUE_V(tid_o);
    const int tid = tid_o, lane = tid & 63, wave = tid >> 6, li = lane & 15, q = lane >> 4;
    const bf16* U = (const bf16*)(WSQ + WS_BIG); bf16* AO = (bf16*)(WSQ + (ATT_FP8 ? WS_ATT : WS_CAT)); float* LSE = (float*)(WSQ + WS_LSE);
    LAS bf16* KS = (LAS bf16*)(lds + AL_K); LAS bf16* VT = (LAS bf16*)(lds + AL_V);
    constexpr int UPH = SEQ / 128, NUNITS = BATCH * 12 * UPH;
    const int per = (NUNITS + (int)GSZ - 1) / (int)GSZ;
    const int u_lo = (int)BID * per, u_hi = (u_lo + per < NUNITS) ? u_lo + per : NUNITS;
    for (int uid = u_lo; uid < u_hi; ++uid) {
        const int idx = uid % UPH, bh = uid / UPH, head = bh % 12, b = bh / 12, g = head >> 2, dsh = 2 * g, d = 1 << dsh;
        const int nblk = UPH >> dsh, r = idx / nblk, n = idx % nblk, u0 = 128 * n;
        const size_t rowbase = (size_t)b * SEQ + r;
#pragma unroll
        for (int i = 0; i < 4; ++i) { const int pidx = tid + 512 * i, rp = pidx >> 4, ch = pidx & 15, k0 = 2 * rp;
            u32x4 ka = {0u, 0u, 0u, 0u}, kb = ka, va = ka, vb = ka;
            if (n > 0 || k0 >= 128) { const bf16* r0 = U + (rowbase + (size_t)(u0 - 128 + k0) * d) * NU + head * 128 + 8 * ch; const bf16* r1 = r0 + (size_t)d * NU;
                ka = *(const u32x4*)(r0 + UK); kb = *(const u32x4*)(r1 + UK); va = *(const u32x4*)(r0 + UV); vb = *(const u32x4*)(r1 + UV); }
            *(LAS u32x4*)(KS + k0 * AK_STRIDE + 8 * ch) = ka; *(LAS u32x4*)(KS + (k0 + 1) * AK_STRIDE + 8 * ch) = kb;
#pragma unroll
            for (int w = 0; w < 4; ++w) {
                *(LAS unsigned*)(VT + (8 * ch + 2 * w) * AV_STRIDE + k0) = (va[w] & 0xffffu) | (vb[w] << 16);
                *(LAS unsigned*)(VT + (8 * ch + 2 * w + 1) * AV_STRIDE + k0) = (va[w] >> 16) | (vb[w] & 0xffff0000u); } }
        int qi_o = 16 * wave + li; OPAQUE_V(qi_o);
        const int qi = qi_o; const size_t qrow = rowbase + (size_t)(u0 + qi) * d;
        bf16x8 qf[4];
#pragma unroll
        for (int ks = 0; ks < 4; ++ks) qf[ks] = *(const bf16x8*)(U + qrow * NU + UQ + head * 128 + 32 * ks + 8 * q);
        __syncthreads();
        f32x4 st[10]; float mx = -INFINITY; const int lb = (n > 0) ? qi : max(qi, 128);
#pragma unroll
        for (int t = 0; t < 9; ++t) { const int kt = wave + t; f32x4 a = {0.f, 0.f, 0.f, 0.f};
#pragma unroll
            for (int ks = 0; ks < 4; ++ks) { const bf16x8 kf = *(const LAS bf16x8*)(KS + (16 * kt + li) * AK_STRIDE + 32 * ks + 8 * q); a = __builtin_amdgcn_mfma_f32_16x16x32_bf16(kf, qf[ks], a, 0, 0, 0); }
#pragma unroll
            for (int e = 0; e < 4; ++e) { const int ki = 16 * kt + 4 * q + e;
                const int m01 = min(max(ki - lb + 1, 0), 1) * min(max(qi + 129 - ki, 0), 1); a[e] = fmaf(a[e], ATT_SCALE, (float)(m01 - 1) * 1e30f); mx = fmaxf(mx, a[e]); }
            st[t] = a; }
        st[9] = (f32x4){0.f, 0.f, 0.f, 0.f};
        mx = fmaxf(mx, shfl_f(mx, lane ^ 16)); mx = fmaxf(mx, shfl_f(mx, lane ^ 32));
        float den = 0.f;
#pragma unroll
        for (int t = 0; t < 9; ++t)
#pragma unroll
            for (int e = 0; e < 4; ++e) { const float p = __expf(st[t][e] - mx); st[t][e] = p; den += p; }
        den += shfl_f(den, lane ^ 16); den += shfl_f(den, lane ^ 32);
        f32x4 oacc[8];
#pragma unroll
        for (int dt = 0; dt < 8; ++dt) oacc[dt] = (f32x4){0.f, 0.f, 0.f, 0.f};
#pragma unroll
        for (int a = 0; a < 5; ++a) { u32x4 pw; pw.x = pg8::cvt_pk_bf16(st[2 * a][0], st[2 * a][1]); pw.y = pg8::cvt_pk_bf16(st[2 * a][2], st[2 * a][3]); pw.z = pg8::cvt_pk_bf16(st[2 * a + 1][0], st[2 * a + 1][1]); pw.w = pg8::cvt_pk_bf16(st[2 * a + 1][2], st[2 * a + 1][3]);
            const bf16x8 pf = __builtin_bit_cast(bf16x8, pw);
            const int ke = 16 * (wave + 2 * a) + 4 * q, ko = (a < 4) ? ke + 16 : ke;
#pragma unroll
            for (int dt = 0; dt < 8; ++dt) { const s16x4 lo = *(const LAS s16x4*)(VT + (16 * dt + li) * AV_STRIDE + ke), hi = *(const LAS s16x4*)(VT + (16 * dt + li) * AV_STRIDE + ko);
                const bf16x8 vf = __builtin_shufflevector(lo, hi, 0, 1, 2, 3, 4, 5, 6, 7); oacc[dt] = __builtin_amdgcn_mfma_f32_16x16x32_bf16(vf, pf, oacc[dt], 0, 0, 0); } }
        const float inv = rcp_f(den);
        bf16* orow = AO + qrow * ATT_PITCH + head * 128 + 4 * q;
#pragma unroll
        for (int dt = 0; dt < 8; ++dt) { u32x2 w; w.x = pg8::cvt_pk_bf16(oacc[dt][0] * inv, oacc[dt][1] * inv); w.y = pg8::cvt_pk_bf16(oacc[dt][2] * inv, oacc[dt][3] * inv); *(u32x2*)(orow + 16 * dt) = w; }
        if (q == 0) LSE[qrow * 12 + head] = mx + __logf(den);
        __syncthreads();
    }
}
PHASE_FN phase_attn_mix(unsigned char* wsarg) {
    int BID = blockIdx.x, GSZ = ld_grid(); OPAQUE_S(BID); OPAQUE_S(GSZ);
    unsigned char* const WSQ = ld_ws(wsarg);
    bf16* CAT = (bf16*)(WSQ + WS_CAT); const float* LSE = (const float*)(WSQ + WS_LSE);
    int tid_o = threadIdx.x; OPAQUE_V(tid_o);
    const size_t gt = (size_t)BID * 512 + tid_o, GT = (size_t)GSZ * 512;
    for (size_t i = gt; i < (size_t)M * 64; i += GT) {
        const int m = (int)(i >> 6), h = (int)((i >> 4) & 3), ch = (int)(i & 15);
        const float l0 = LSE[(size_t)m * 12 + h], l1 = LSE[(size_t)m * 12 + 4 + h], l2 = LSE[(size_t)m * 12 + 8 + h];
        const float mx = fmaxf(l0, fmaxf(l1, l2)); const float e0 = __expf(l0 - mx), e1 = __expf(l1 - mx), e2 = __expf(l2 - mx); const float inv = rcp_f(e0 + e1 + e2);
#pragma unroll
        for (int g = 0; g < 3; ++g) { const float wg_ = (g == 0 ? e0 : (g == 1 ? e1 : e2)) * inv;
            if (ATT_FP8) { const u32x4 v = *(const u32x4*)((const bf16*)(WSQ + WS_ATT) + (size_t)m * 1536 + (g * 4 + h) * 128 + ch * 8); const float w16 = wg_ * 16.f; u32x2 o8;
                o8.x = pk4_fp8(__uint_as_float(v[0] << 16) * w16, __uint_as_float(v[0] & 0xffff0000u) * w16, __uint_as_float(v[1] << 16) * w16, __uint_as_float(v[1] & 0xffff0000u) * w16);
                o8.y = pk4_fp8(__uint_as_float(v[2] << 16) * w16, __uint_as_float(v[2] & 0xffff0000u) * w16, __uint_as_float(v[3] << 16) * w16, __uint_as_float(v[3] & 0xffff0000u) * w16);
                *(u32x2*)((unsigned char*)CAT + (size_t)m * (CAT_PITCH * 2) + (g * 4 + h) * 128 + ch * 8) = o8; }
            else { u32x4* p = (u32x4*)(CAT + (size_t)m * CAT_PITCH + (g * 4 + h) * 128 + ch * 8); u32x4 v = *p;
#pragma unroll
                for (int k = 0; k < 4; ++k) v[k] = pk2(__uint_as_float(v[k] << 16) * wg_, __uint_as_float(v[k] & 0xffff0000u) * wg_);
                *p = v; } }
    }
}

PHASE_FN phase_shortconv(unsigned char* wsarg, int L, LAS unsigned char* lds) {
    int BID = blockIdx.x, GSZ = ld_grid(); OPAQUE_S(BID); OPAQUE_S(GSZ); OPAQUE_S(lds);
    unsigned char* const WSQ = ld_ws(wsarg);
    const bf16* U = (const bf16*)(WSQ + WS_BIG); bf16* CAT = (bf16*)(WSQ + WS_CAT); const float* w = inp(lds, I_SCW) + (size_t)L * 3 * 1024;
    int tid_o = threadIdx.x; OPAQUE_V(tid_o);
    const size_t gt = (size_t)BID * 512 + tid_o, GT = (size_t)GSZ * 512;
    for (size_t i = gt; i < (size_t)M * 128; i += GT) {
        const int m = (int)(i >> 7), c0 = (int)(i & 127) * 8, t = m % SEQ;
        float acc[8];
#pragma unroll
        for (int e = 0; e < 8; ++e) acc[e] = 0.f;
#pragma unroll
        for (int k = 0; k < 3; ++k) { if (t - 2 + k < 0) continue; const bf16* r = U + (size_t)(m - 2 + k) * NU;
            const u32x4 cw = *(const u32x4*)(r + USC + c0), hw = *(const u32x4*)(r + USH + c0);
#pragma unroll
            for (int q = 0; q < 4; ++q) { acc[2 * q] += w[k * 1024 + c0 + 2 * q] * (__uint_as_float(cw[q] << 16) * __uint_as_float(hw[q] << 16));
                acc[2 * q + 1] += w[k * 1024 + c0 + 2 * q + 1] * (__uint_as_float(cw[q] & 0xffff0000u) * __uint_as_float(hw[q] & 0xffff0000u)); } }
        const u32x4 bw = *(const u32x4*)(U + (size_t)m * NU + USB + c0); u32x4 ow;
#pragma unroll
        for (int q = 0; q < 4; ++q) ow[q] = pk2(acc[2 * q] * __uint_as_float(bw[q] << 16), acc[2 * q + 1] * __uint_as_float(bw[q] & 0xffff0000u));
        *(u32x4*)(CAT + (size_t)m * CAT_PITCH + CAT_SC + c0) = ow;
    }
}

PHASE_FN phase_conv(unsigned char* wsarg, int L, LAS unsigned char* lds) {
    unsigned char* const WSQ = ld_ws(wsarg);
    int BID = blockIdx.x, GSZ = ld_grid(); OPAQUE_S(BID); OPAQUE_S(GSZ);
    int tid_o = threadIdx.x; OPAQUE_V(tid_o);
    const bf16* U = (const bf16*)(WSQ + WS_BIG); bf16* XC = (bf16*)(WSQ + WS_XC);
    const float* cw = inp(lds, I_CW) + (size_t)L * 4 * 2560; const float* cbv = inp(lds, I_CB) + (size_t)L * 2560;
    const size_t gt = (size_t)BID * 512 + tid_o, GT = (size_t)GSZ * 512;
    for (size_t i = gt; i < (size_t)(M / 16) * 320; i += GT) {
        const int rb = (int)(i / 320), c0 = (int)(i % 320) * 8, m0 = rb * 16, t0 = m0 % SEQ;
        float w[4][8], bs[8];
#pragma unroll
        for (int k = 0; k < 4; ++k) { const f32x4 a0 = *(const f32x4*)(cw + k * 2560 + c0), a1 = *(const f32x4*)(cw + k * 2560 + c0 + 4);
#pragma unroll
            for (int e = 0; e < 4; ++e) { w[k][e] = a0[e]; w[k][4 + e] = a1[e]; } }
        { const f32x4 a0 = *(const f32x4*)(cbv + c0), a1 = *(const f32x4*)(cbv + c0 + 4);
#pragma unroll
          for (int e = 0; e < 4; ++e) { bs[e] = a0[e]; bs[4 + e] = a1[e]; } }
        u32x4 raw[19];
#pragma unroll
        for (int r = 0; r < 19; ++r) raw[r] = (r >= 3 || t0 > 0) ? *(const u32x4*)(U + (size_t)(m0 + r - 3) * NU + UX + c0) : (u32x4){0u, 0u, 0u, 0u};
#pragma unroll
        for (int r = 0; r < 16; ++r) { u32x4 o;
#pragma unroll
            for (int e2 = 0; e2 < 4; ++e2) { float lo = bs[2 * e2], hi = bs[2 * e2 + 1];
#pragma unroll
                for (int k = 0; k < 4; ++k) { const unsigned x = raw[r + k][e2]; lo += w[k][2 * e2] * __uint_as_float(x << 16); hi += w[k][2 * e2 + 1] * __uint_as_float(x & 0xffff0000u); }
                o[e2] = pk2(silu_f(lo), silu_f(hi)); }
            *(u32x4*)(XC + (size_t)(m0 + r) * 2560 + c0) = o; }
    }
}
constexpr int BI_STRIDE = 136, XI_STRIDE = 72;
constexpr int SL_DT = 0, SL_ACS = 4096, SL_BI = 8192, SL_CI = SL_BI + 128 * BI_STRIDE * 2, SL_XI = SL_CI + 128 * BI_STRIDE * 2, SL_PV = SL_XI + 128 * XI_STRIDE * 2, SL_END = SL_PV + 64 * 136 * 2;
constexpr int SL_XI2 = SL_CI;
static_assert(SL_END <= RING_BYTES, "SSD LDS");
DI void ssd_dt_scan(int L, const bf16* U, int m0, int g, LAS unsigned char* lds, int wave, int lane) {
    LAS float* DT = (LAS float*)(lds + SL_DT); LAS float* ACS = (LAS float*)(lds + SL_ACS);
    if (wave < 6) { const int h = g * 6 + wave; const float bias = inp(lds, I_DTB)[L * 24 + h], a = -__expf(inp(lds, I_ALOG)[L * 24 + h]);
        const float d0 = softplus_f(bf2f(U[(size_t)(m0 + lane) * NU + UDT + h]) + bias), d1 = softplus_f(bf2f(U[(size_t)(m0 + 64 + lane) * NU + UDT + h]) + bias);
        float c0 = d0 * a, c1 = d1 * a;
#pragma unroll
        for (int o = 1; o < 64; o <<= 1) { const int src = lane >= o ? lane - o : lane; const float u0 = shfl_f(c0, src), u1 = shfl_f(c1, src); if (lane >= o) { c0 += u0; c1 += u1; } }
        c1 += shfl_f(c0, 63);
        DT[lane * 8 + wave] = d0; DT[(64 + lane) * 8 + wave] = d1; ACS[lane * 8 + wave] = c0; ACS[(64 + lane) * 8 + wave] = c1; }
}
PHASE_FN phase_ssd_states(unsigned char* wsarg, int L, LAS unsigned char* lds) {
    unsigned char* const WSQ = ld_ws(wsarg);
    int BID = blockIdx.x, GSZ = ld_grid(); OPAQUE_S(BID); OPAQUE_S(GSZ); OPAQUE_S(lds);
    int tid_o = threadIdx.x; OPAQUE_V(tid_o);
    const int tid = tid_o, lane = tid & 63, wave = tid >> 6, li = lane & 15, q = lane >> 4;
    const bf16* U = (const bf16*)(WSQ + WS_BIG); const bf16* XC = (const bf16*)(WSQ + WS_XC); float* ST = (float*)(WSQ + WS_BIG + BIG_U_BYTES); float* CD = (float*)(WSQ + WS_CD);
    LAS float* DT = (LAS float*)(lds + SL_DT); LAS float* ACS = (LAS float*)(lds + SL_ACS); LAS bf16* BI = (LAS bf16*)(lds + SL_BI);
    for (int it = BID; it < BATCH * NCH * 4; it += GSZ) {
        const int g = it & 3, c = (it >> 2) % NCH, b = (it >> 2) / NCH, m0 = b * SEQ + c * 128;
        ssd_dt_scan(L, U, m0, g, lds, wave, lane);
#pragma unroll
        for (int i = 0; i < 4; ++i) { const int ci = tid + 512 * i, row = ci >> 4, ch = ci & 15; *(LAS u32x4*)(BI + row * BI_STRIDE + 8 * ch) = *(const u32x4*)(XC + (size_t)(m0 + row) * 2560 + 1536 + g * 128 + 8 * ch); }
        __syncthreads();
        bf16x8 bfr[4];
#pragma unroll
        for (int ks = 0; ks < 4; ++ks) { const LAS bf16* p0 = BI + (32 * ks + 8 * q + (li >> 2)) * BI_STRIDE + 16 * wave + 4 * (li & 3); bfr[ks] = tr_read2(p0, p0 + 4 * BI_STRIDE); }
        u32x4 xr[2];
#pragma unroll
        for (int i = 0; i < 2; ++i) { const int ci = tid + 512 * i; xr[i] = *(const u32x4*)(XC + (size_t)(m0 + (ci >> 3)) * 2560 + (g * 6) * 64 + 8 * (ci & 7)); }
#pragma unroll 1
        for (int j = 0; j < 6; ++j) { const int h = g * 6 + j; LAS bf16* XI = (LAS bf16*)(lds + ((j & 1) ? SL_XI2 : SL_XI));
            { const float alast = ACS[127 * 8 + j];
#pragma unroll
              for (int i = 0; i < 2; ++i) { const int ci = tid + 512 * i, row = ci >> 3, ch = ci & 7;
                  const float wgt = DT[row * 8 + j] * __expf(alast - ACS[row * 8 + j]); u32x4 o;
#pragma unroll
                  for (int e = 0; e < 4; ++e) o[e] = pk2(__uint_as_float(xr[i][e] << 16) * wgt, __uint_as_float(xr[i][e] & 0xffff0000u) * wgt);
                  *(LAS u32x4*)(XI + row * XI_STRIDE + 8 * ch) = o; } }
            __syncthreads();
            if (j < 5) {
#pragma unroll
                for (int i = 0; i < 2; ++i) { const int ci = tid + 512 * i; xr[i] = *(const u32x4*)(XC + (size_t)(m0 + (ci >> 3)) * 2560 + (h + 1) * 64 + 8 * (ci & 7)); } }
            f32x4 acc[4];
#pragma unroll
            for (int pb = 0; pb < 4; ++pb) acc[pb] = (f32x4){0.f, 0.f, 0.f, 0.f};
#pragma unroll
            for (int ks = 0; ks < 4; ++ks)
#pragma unroll
                for (int pb = 0; pb < 4; ++pb) { const LAS bf16* p0 = XI + (32 * ks + 8 * q + (li >> 2)) * XI_STRIDE + 16 * pb + 4 * (li & 3); const bf16x8 afr = tr_read2(p0, p0 + 4 * XI_STRIDE);
                    acc[pb] = __builtin_amdgcn_mfma_f32_16x16x32_bf16(afr, bfr[ks], acc[pb], 0, 0, 0); }
            float* st = ST + ((size_t)((b * NCH + c) * 24 + h) * 64) * 128;
#pragma unroll
            for (int pb = 0; pb < 4; ++pb)
#pragma unroll
                for (int r = 0; r < 4; ++r) st[(size_t)(16 * pb + 4 * q + r) * 128 + 16 * wave + li] = acc[pb][r];
            if (tid == 0) CD[(b * NCH + c) * 24 + h] = __expf(ACS[127 * 8 + j]);
        }
        __syncthreads();
    }
}
PHASE_FN phase_ssd_scan(unsigned char* wsarg, bool dry = false) {
    unsigned char* const WSQ = ld_ws(wsarg);
    int BID = blockIdx.x, GSZ = ld_grid(); OPAQUE_S(BID); OPAQUE_S(GSZ);
    const float* ST = (const float*)(WSQ + WS_BIG + BIG_U_BYTES); const float* CD = (const float*)(WSQ + WS_CD); bf16* SO = dry ? (bf16*)(WSQ + WS_XF) : (bf16*)(WSQ + WS_PVB);
    int tid_o = threadIdx.x; OPAQUE_V(tid_o);
    const size_t gt = (size_t)BID * 512 + tid_o, GT = (size_t)GSZ * 512;
    static_assert(NCH % 8 == 0, "scan batch");
    for (size_t e = gt; e < (size_t)BATCH * 24 * 2048; e += GT) {
        const int b = (int)(e / (24 * 2048)), rem4 = (int)(e % (24 * 2048)), h = rem4 >> 11;
        f32x4 hs = {0.f, 0.f, 0.f, 0.f};
#pragma unroll 1
        for (int c0 = 0; c0 < NCH; c0 += 8) { f32x4 v[8]; float cd[8];
#pragma unroll
            for (int k = 0; k < 8; ++k) { v[k] = *(const f32x4*)(ST + ((size_t)(b * NCH + c0 + k) * 24 * 2048 + rem4) * 4); cd[k] = CD[(b * NCH + c0 + k) * 24 + h]; }
#pragma unroll
            for (int k = 0; k < 8; ++k) { u32x2 w; w.x = pk2(hs[0], hs[1]); w.y = pk2(hs[2], hs[3]); *(u32x2*)(SO + ((size_t)(b * NCH + c0 + k) * 24 * 2048 + rem4) * 4) = w; hs = hs * cd[k] + v[k]; } }
    }
}
PHASE_FN phase_ssd_out(unsigned char* wsarg, int L, LAS unsigned char* lds) {
    int BID = blockIdx.x, GSZ = ld_grid(); OPAQUE_S(BID); OPAQUE_S(GSZ); OPAQUE_S(lds);
    unsigned char* const WSQ = ld_ws(wsarg);
    int tid_o = threadIdx.x; OPAQUE_V(tid_o);
    const int tid = tid_o, lane = tid & 63, wave = tid >> 6, li = lane & 15, q = lane >> 4;
    const bf16* U = (const bf16*)(WSQ + WS_BIG); const bf16* XC = (const bf16*)(WSQ + WS_XC); const bf16* PVB = (const bf16*)(WSQ + WS_PVB); bf16* CAT = (bf16*)(WSQ + WS_CAT);
    const float* nw = inp(lds, I_NW) + (size_t)L * 1536;
    LAS float* DT = (LAS float*)(lds + SL_DT); LAS float* ACS = (LAS float*)(lds + SL_ACS); LAS bf16* CC = (LAS bf16*)(lds + SL_CI); LAS bf16* BC = (LAS bf16*)(lds + SL_BI);
    LAS bf16* XI = (LAS bf16*)(lds + SL_XI); LAS bf16* PV = (LAS bf16*)(lds + SL_PV);
    for (int it = BID; it < BATCH * NCH * 4; it += GSZ) {
        const int g = it & 3, c = (it >> 2) % NCH, b = (it >> 2) / NCH, m0 = b * SEQ + c * 128;
        u32x4 xr[2], pr[2];
#pragma unroll
        for (int i = 0; i < 2; ++i) { const int ci = tid + 512 * i; xr[i] = *(const u32x4*)(XC + (size_t)(m0 + (ci >> 3)) * 2560 + (g * 6) * 64 + 8 * (ci & 7)); pr[i] = *(const u32x4*)(PVB + (size_t)((b * NCH + c) * 24 + g * 6) * 8192 + 8 * ci); }
        ssd_dt_scan(L, U, m0, g, lds, wave, lane);
#pragma unroll
        for (int i = 0; i < 4; ++i) { const int ci = tid + 512 * i, row = ci >> 4, ch = ci & 15; const bf16* src = XC + (size_t)(m0 + row) * 2560 + 1536 + g * 128 + 8 * ch;
            *(LAS u32x4*)(BC + row * BI_STRIDE + 8 * ch) = *(const u32x4*)src; *(LAS u32x4*)(CC + row * BI_STRIDE + 8 * ch) = *(const u32x4*)(src + 512); }
        __syncthreads();
        float* YS = (float*)(WSQ + WS_YS) + (size_t)BID * (6 * 16 * 512) + tid; float ssq[4] = {0.f, 0.f, 0.f, 0.f};
#pragma unroll 1
        for (int j = 0; j < 6; ++j) { const int h = g * 6 + j;
#pragma unroll
            for (int i = 0; i < 2; ++i) { const int ci = tid + 512 * i, row = ci >> 3, ch = ci & 7; const float wgt = DT[row * 8 + j]; u32x4 o;
#pragma unroll
                for (int e = 0; e < 4; ++e) o[e] = pk2(__uint_as_float(xr[i][e] << 16) * wgt, __uint_as_float(xr[i][e] & 0xffff0000u) * wgt);
                *(LAS u32x4*)(XI + row * XI_STRIDE + 8 * ch) = o; *(LAS u32x4*)(PV + (ci >> 4) * 136 + 8 * (ci & 15)) = pr[i]; }
            __syncthreads();
            if (j < 5) {
#pragma unroll
                for (int i = 0; i < 2; ++i) { const int ci = tid + 512 * i; xr[i] = *(const u32x4*)(XC + (size_t)(m0 + (ci >> 3)) * 2560 + (h + 1) * 64 + 8 * (ci & 7)); pr[i] = *(const u32x4*)(PVB + (size_t)((b * NCH + c) * 24 + h + 1) * 8192 + 8 * ci); } }
            unsigned short zr[16];
#pragma unroll
            for (int pb = 0; pb < 4; ++pb)
#pragma unroll
                for (int r = 0; r < 4; ++r) zr[pb * 4 + r] = U[(size_t)(m0 + 16 * wave + 4 * q + r) * NU + UZ + h * 64 + 16 * pb + li];
            f32x4 acc[4];
#pragma unroll
            for (int pb = 0; pb < 4; ++pb) acc[pb] = (f32x4){0.f, 0.f, 0.f, 0.f};
#pragma unroll
            for (int ks = 0; ks < 4; ++ks) { const bf16x8 afr = *(const LAS bf16x8*)(CC + (16 * wave + li) * 136 + 32 * ks + 8 * q);
#pragma unroll
                for (int pb = 0; pb < 4; ++pb) { const bf16x8 bfr = *(const LAS bf16x8*)(PV + (16 * pb + li) * 136 + 32 * ks + 8 * q); acc[pb] = __builtin_amdgcn_mfma_f32_16x16x32_bf16(afr, bfr, acc[pb], 0, 0, 0); } }
#pragma unroll
            for (int r = 0; r < 4; ++r) { const float e = __expf(ACS[(16 * wave + 4 * q + r) * 8 + j]);
#pragma unroll
                for (int pb = 0; pb < 4; ++pb) acc[pb][r] *= e; }
            int l_o = 16 * wave + li; OPAQUE_V(l_o); const int l_a = l_o; const float acs_l = ACS[l_a * 8 + j];
            const float ddt = inp(lds, I_SD)[L * 24 + h] * rcp_f(DT[l_a * 8 + j]);
#pragma unroll
            for (int ks2 = 0; ks2 < 4; ++ks2) {
                if (2 * ks2 <= wave) {
                    f32x4 c0 = {0.f, 0.f, 0.f, 0.f}, c1 = {0.f, 0.f, 0.f, 0.f};
#pragma unroll
                    for (int ks = 0; ks < 4; ++ks) { const bf16x8 bfr = *(const LAS bf16x8*)(CC + (16 * wave + li) * 136 + 32 * ks + 8 * q);
                        const bf16x8 a0 = *(const LAS bf16x8*)(BC + (32 * ks2 + li) * 136 + 32 * ks + 8 * q), a1 = *(const LAS bf16x8*)(BC + (32 * ks2 + 16 + li) * 136 + 32 * ks + 8 * q);
                        c0 = __builtin_amdgcn_mfma_f32_16x16x32_bf16(a0, bfr, c0, 0, 0, 0); c1 = __builtin_amdgcn_mfma_f32_16x16x32_bf16(a1, bfr, c1, 0, 0, 0); }
                    bf16x8 afr;
#pragma unroll
                    for (int e = 0; e < 8; ++e) { const int s = 32 * ks2 + (e < 4 ? 4 * q + e : 16 + 4 * q + (e - 4)); const float cbv_ = e < 4 ? c0[e & 3] : c1[e & 3];
                        const float gv = cbv_ * __expf(fminf(acs_l - ACS[s * 8 + j], 0.f)) * (float)min(max(l_a - s + 1, 0), 1) + ddt * (float)(1 - min(abs(l_a - s), 1)); afr[e] = (short)f2bf(gv); }
#pragma unroll
                    for (int pb = 0; pb < 4; ++pb) { const LAS bf16* p0 = XI + (32 * ks2 + 4 * q + (li >> 2)) * XI_STRIDE + 16 * pb + 4 * (li & 3);
                        const bf16x8 bfr = tr_read2(p0, p0 + 16 * XI_STRIDE); acc[pb] = __builtin_amdgcn_mfma_f32_16x16x32_bf16(afr, bfr, acc[pb], 0, 0, 0); } } }
#pragma unroll
            for (int pb = 0; pb < 4; ++pb)
#pragma unroll
                for (int r = 0; r < 4; ++r) { const float y = acc[pb][r] * silu_f(bf2f(zr[pb * 4 + r]));
                    YS[(j * 16 + pb * 4 + r) * 512] = y; ssq[r] += y * y; }
            __syncthreads();
        }
#pragma unroll
        for (int r = 0; r < 4; ++r) { float s = ssq[r]; s += shfl_f(s, lane ^ 1); s += shfl_f(s, lane ^ 2); s += shfl_f(s, lane ^ 4); s += shfl_f(s, lane ^ 8); ssq[r] = __builtin_amdgcn_rsqf(s * (1.f / 384.f) + RMS_EPS); }
#pragma unroll 1
        for (int j = 0; j < 6; ++j)
#pragma unroll
            for (int pb = 0; pb < 4; ++pb)
#pragma unroll
                for (int r = 0; r < 4; ++r) { const int l = 16 * wave + 4 * q + r, ch = (g * 6 + j) * 64 + 16 * pb + li; CAT[(size_t)(m0 + l) * CAT_PITCH + CAT_SSM + ch] = f2bf(YS[(j * 16 + pb * 4 + r) * 512] * ssq[r] * nw[ch]); }
    }
}

static_assert(DM % 1024 == 0, "phase_resln: DM must be a multiple of 1024");
template <bool GATE> PHASE_FN phase_resln(unsigned char* wsarg, float* outarg, int L, int which, LAS unsigned char* lds, bool dry = false) {
    unsigned char* const WSQ = ld_ws(wsarg);
    const float* x32 = (L == 0 && which == 0) ? inp(lds, I_X) : nullptr;
    bf16* xb = (bf16*)(WSQ + WS_XB); const bf16* fb = (const bf16*)(WSQ + WS_XF); const bf16* emb = (const bf16*)(WSQ + WS_EMB);
    float* out32 = (L == DEPTH - 1 && which == 2 && !dry) ? ld_out(outarg) : nullptr; bf16* xo = dry ? (bf16*)(WSQ + WS_CAT) : xb;
    const float* gam = inp(lds, which == 0 ? I_L1G : (which == 1 ? I_L2G : I_L3G)) + (size_t)L * DM; const float* bet = inp(lds, which == 0 ? I_L1B : (which == 1 ? I_L2B : I_L3B)) + (size_t)L * DM;
    int BID = blockIdx.x, GSZ = ld_grid(); OPAQUE_S(BID); OPAQUE_S(GSZ);
    int tid_o = threadIdx.x; OPAQUE_V(tid_o);
    const int lane = tid_o & 63, wave = __builtin_amdgcn_readfirstlane(tid_o >> 6), pair = wave >> 1, half = wave & 1;
    const bool q8 = (((which == 0) && ((UP_INT8 >> L) & 1)) || ((which == 1) && GATE_INT8)) && !dry;
    LAS float* RS = (LAS float*)lds; LAS float* RQ = RS + 8;
    constexpr int NJ = DM / 1024;
    const int niter = (M + 4 * GSZ - 1) / (4 * GSZ);
    for (int itn = 0; itn < niter; ++itn) {
        const int m = (itn * GSZ + BID) * 4 + pair; const bool live = m < M;
        float v[NJ][8]; float s = 0.f;
        if (live) {
#pragma unroll
        for (int j = 0; j < NJ; ++j) { const size_t o = (size_t)m * DM + (size_t)((half * NJ + j) * 64 + lane) * 8;
            float xv[8];
            if (x32) { const f32x4 a = NT_LOAD((const f32x4*)(x32 + o)), b = NT_LOAD((const f32x4*)(x32 + o + 4)); xv[0] = a[0]; xv[1] = a[1]; xv[2] = a[2]; xv[3] = a[3]; xv[4] = b[0]; xv[5] = b[1]; xv[6] = b[2]; xv[7] = b[3]; }
            else { const u32x4 a = NT_LOAD((const u32x4*)(xb + o));
#pragma unroll
                for (int k = 0; k < 4; ++k) { xv[2 * k] = __uint_as_float(a[k] << 16); xv[2 * k + 1] = __uint_as_float(a[k] & 0xffff0000u); } }
            const u32x4 f = NT_LOAD((const u32x4*)(fb + o)); float fv[8];
#pragma unroll
            for (int k = 0; k < 4; ++k) { fv[2 * k] = __uint_as_float(f[k] << 16); fv[2 * k + 1] = __uint_as_float(f[k] & 0xffff0000u); }
            if (GATE) { const u32x4 e = NT_LOAD((const u32x4*)(emb + o));
#pragma unroll
                for (int k = 0; k < 4; ++k) { fv[2 * k] = __uint_as_float(e[k] << 16) * rcp_f(1.f + __expf(-fv[2 * k])); fv[2 * k + 1] = __uint_as_float(e[k] & 0xffff0000u) * rcp_f(1.f + __expf(-fv[2 * k + 1])); } }
#pragma unroll
            for (int k = 0; k < 8; ++k) { v[j][k] = DN_ALPHA * xv[k] + fv[k]; s += v[j][k]; } }
        }
        s = wave_sum(s, lane); if (lane == 0) RS[pair * 2 + half] = s;
        __syncthreads();
        const float mean = (RS[pair * 2] + RS[pair * 2 + 1]) * (1.f / DM); float s2 = 0.f;
        if (live) {
#pragma unroll
        for (int j = 0; j < NJ; ++j)
#pragma unroll
            for (int k = 0; k < 8; ++k) { v[j][k] -= mean; s2 += v[j][k] * v[j][k]; }
        }
        s2 = wave_sum(s2, lane); if (lane == 0) RQ[pair * 2 + half] = s2;
        __syncthreads();
        const float rstd = __builtin_amdgcn_rsqf((RQ[pair * 2] + RQ[pair * 2 + 1]) * (1.f / DM) + LN_EPS);
        float ymax = 0.f;
        if (live) {
#pragma unroll
        for (int j = 0; j < NJ; ++j) { const size_t c = (size_t)((half * NJ + j) * 64 + lane) * 8, o = (size_t)m * DM + c;
            const f32x4 g0 = *(const f32x4*)(gam + c), g1 = *(const f32x4*)(gam + c + 4), b0 = *(const f32x4*)(bet + c), b1 = *(const f32x4*)(bet + c + 4);
            float y[8];
#pragma unroll
            for (int k = 0; k < 4; ++k) { y[k] = v[j][k] * rstd * g0[k] + b0[k]; y[4 + k] = v[j][4 + k] * rstd * g1[k] + b1[k]; }
            if (out32) { *(f32x4*)(out32 + o) = (f32x4){y[0], y[1], y[2], y[3]}; *(f32x4*)(out32 + o + 4) = (f32x4){y[4], y[5], y[6], y[7]}; }
            else { u32x4 w; w.x = pk2(y[0], y[1]); w.y = pk2(y[2], y[3]); w.z = pk2(y[4], y[5]); w.w = pk2(y[6], y[7]); *(u32x4*)(xo + o) = w;
                   if ((GATE_FP8 && !GATE_INT8 && which == 1) || (QKV_FP8 && which == 2)) { u32x2 w8; w8.x = pk4_fp8(y[0], y[1], y[2], y[3]); w8.y = pk4_fp8(y[4], y[5], y[6], y[7]); *(u32x2*)(WSQ + WS_X8 + o) = w8; } }
            if (q8) {
#pragma unroll
                for (int k = 0; k < 8; ++k) { v[j][k] = y[k]; ymax = fmaxf(ymax, fabsf(y[k])); } } }
        }
        if (q8) {
            ymax = wave_max(ymax, lane); if (lane == 0) RS[16 + pair * 2 + half] = ymax;
            __syncthreads();
            const float rmx = fmaxf(fmaxf(RS[16 + pair * 2], RS[16 + pair * 2 + 1]), 1e-30f), iv = 127.f / rmx;
            if (live) {
#pragma unroll
                for (int j = 0; j < NJ; ++j) { const size_t o = (size_t)m * DM + (size_t)((half * NJ + j) * 64 + lane) * 8; u32x2 w8;
                    unsigned a = 0, b = 0;
#pragma unroll
                    for (int k = 0; k < 4; ++k) { a |= ((unsigned)(__float2int_rn(v[j][k] * iv) & 0xff)) << (8 * k); b |= ((unsigned)(__float2int_rn(v[j][4 + k] * iv) & 0xff)) << (8 * k); }
                    w8.x = a; w8.y = b; *(u32x2*)(WSQ + WS_X8 + o) = w8; }
                if (half == 0 && lane == 0) ((float*)(WSQ + WS_SA))[m] = rmx * (1.f / 127.f); }
        }
    }
    __syncthreads();
}

constexpr int PH_PER_LAYER = 13, N_PHASES = DEPTH * PH_PER_LAYER;
#ifndef REP_G3
#define REP_G3 1
#endif
#ifndef REP_G4
#define REP_G4 1
#endif
#ifndef REP_SCAN
#define REP_SCAN 1
#endif
#ifndef REP_MISC
#define REP_MISC 1
#endif
#ifndef REP_BAR
#define REP_BAR 1
#endif
#ifndef GEMM_ALIGN
#define GEMM_ALIGN true
#endif
#ifndef GEMM_SP2
#define GEMM_SP2 true
#endif
#ifndef REP_GEMM
#define REP_GEMM 1
#endif
#ifndef ATTN_NAIVE
#define ATTN_NAIVE 0
#endif
#ifndef REP_W
#define REP_W 1
#endif
#ifndef REP_LN
#define REP_LN 1
#endif
#ifndef REP_ATT
#define REP_ATT 1
#endif
#ifndef REP_SSD1
#define REP_SSD1 1
#endif
#ifndef REP_SSD3
#define REP_SSD3 1
#endif
#ifndef REP_SC
#define REP_SC 1
#endif
#ifndef PHASE_MASK
#define PHASE_MASK 0x1fff
#endif
#if ONE_LAUNCH && !defined(EMU)
#define IN(k) ((PHASE_MASK >> (((k) % PH_PER_LAYER))) & 1)
#define SEAM(k) do { if ((k) + 1 < N_PHASES) { XcdBarrier b_; b_.bar = (unsigned*)(ld_ws(P.ws) + WS_CTL) + 4096; b_.x = xb_xcc_id(); b_.st = (volatile LAS unsigned*)(lds + MISC_OFF) + 8; for (int rb_ = 0; rb_ < REP_BAR; ++rb_) xcd_barrier(b_); } } while (0)
#else
#define IN(k) (((PHASE_MASK >> (((k) % PH_PER_LAYER))) & 1) && P.ph_lo <= (k) && (k) < P.ph_hi)
#define SEAM(k) do { if (IN(k) && IN((k) + 1)) { XcdBarrier b_; b_.bar = (unsigned*)(ld_ws(P.ws) + WS_CTL) + 4096; b_.x = xb_xcc_id(); b_.st = (volatile LAS unsigned*)(lds + MISC_OFF) + 8; xcd_barrier(b_); } } while (0)
#endif
template <int L> DI void layer_program(const Params& P, LAS unsigned char* lds) {
    {
        constexpr int pb = L * PH_PER_LAYER;
#define WSP unsigned char* const ws = ld_ws(P.ws); (void)ws
#define GEMM_PHASE(EPI, A_, B_, N_, K_, ...) GEMM_PHASE_R(0, 0, EPI, A_, B_, N_, K_, __VA_ARGS__)
#define GEMM_PHASE_X(F8_, EPI, A_, B_, N_, K_, ...) GEMM_PHASE_R(F8_, 0, EPI, A_, B_, N_, K_, __VA_ARGS__)
#define GEMM_PHASE_R(F8_, ROT_, EPI, A_, B_, N_, K_, ...) do { pg8::Gemm g{(const bf16*)(A_), (const bf16*)(B_), M, (N_), (K_)}; int bid_ = blockIdx.x, gsz_ = ld_grid(); if (ROT_) bid_ = (bid_ + gsz_ / 2) % gsz_; OPAQUE_S(bid_); OPAQUE_S(gsz_); auto lds_ = lds; OPAQUE_S(lds_); pg8::StaticOrder S; S.init(M, (N_), gsz_, bid_); \
            EPI E{__VA_ARGS__}; for (int rep = 0; rep < REP_GEMM; ++rep) pg8::gemm_phase<EPI, pg8::StaticOrder, GEMM_ALIGN, GEMM_SP2, F8_>(lds_, g, S, E); } while (0)
        if (IN(pb + 0)) for (int rep = 0; rep < REP_W; ++rep) phase_weights(P.ws, L, lds, rep);
        SEAM(pb + 0);
        if (IN(pb + 1)) { WSP;
            if (QKV_FP8) { GEMM_PHASE_X(1, pg8::EpiBf16<2>, ws + WS_X8, ws + WS_WIN, NQKV, DM / 2, (bf16*)(ws + WS_BIG), NU);
                           GEMM_PHASE_R(0, 1, pg8::EpiBf16<0>, ws + WS_XB, ws + WS_WIN + WINB_OFF, NREST, DM, (bf16*)(ws + WS_BIG) + NQKV, NU); }
            else GEMM_PHASE(pg8::EpiBf16<0>, ws + WS_XB, ws + WS_WIN, NU, DM, (bf16*)(ws + WS_BIG), NU); }
        SEAM(pb + 1);
        if (IN(pb + 2)) { phase_rope(P.ws, lds); for (int rm_ = 0; rm_ < REP_MISC; ++rm_) { phase_conv(P.ws, L, lds); WSP; GEMM_PHASE(pg8::EpiBf16<0>, (const bf16*)(ws + WS_PB) + (size_t)L * M * DPLE, ws + WS_WPE, DM, DPLE, (bf16*)(ws + WS_EMB), DM); } }
        SEAM(pb + 2);
        if (IN(pb + 3)) { for (int rep = 0; rep < REP_SSD1; ++rep) phase_ssd_states(P.ws, L, lds); for (int rep = 0; rep < REP_ATT; ++rep) { if (ATTN_NAIVE) phase_attn_naive(P.ws, lds); else phase_attn_mfma(P.ws, lds); } for (int rep = 0; rep < REP_SC; ++rep) phase_shortconv(P.ws, L, lds); }
        SEAM(pb + 3);
        if (IN(pb + 4)) { for (int rs_ = 0; rs_ < REP_SCAN; ++rs_) phase_ssd_scan(P.ws, rs_ + 1 < REP_SCAN); phase_attn_mix(P.ws); }
        SEAM(pb + 4);
        if (IN(pb + 5)) for (int rep = 0; rep < REP_SSD3; ++rep) phase_ssd_out(P.ws, L, lds);
        SEAM(pb + 5);
        if (IN(pb + 6)) { WSP; if (ATT_FP8) GEMM_PHASE_X(3, pg8::EpiBf16<0>, ws + WS_CAT, ws + WS_WOUT, DM, CAT_PITCH, (bf16*)(ws + WS_XF), DM);
            else GEMM_PHASE(pg8::EpiBf16<0>, ws + WS_CAT, ws + WS_WOUT, DM, DMIX, (bf16*)(ws + WS_XF), DM); }
        SEAM(pb + 6);
        if (IN(pb + 7)) for (int rep = 0; rep < REP_LN; ++rep) phase_resln<false>(P.ws, P.out, L, 0, lds, rep + 1 < REP_LN);
        SEAM(pb + 7);
        if (IN(pb + 8)) for (int r3_ = 0; r3_ < REP_G3; ++r3_) { WSP; if constexpr ((UP_INT8 >> L) & 1) GEMM_PHASE_X(2, pg8::EpiI8<1>, ws + WS_X8, ws + WS_WUP, DFF, DM / 2, (bf16*)(ws + WS_BIG), DFF, (const float*)(ws + WS_SA), (const float*)(ws + WS_SW));
            else GEMM_PHASE(pg8::EpiBf16<1>, ws + WS_XB, ws + WS_WUP, DFF, DM, (bf16*)(ws + WS_BIG), DFF); }
        SEAM(pb + 8);
        if (IN(pb + 9)) for (int r4_ = 0; r4_ < REP_G4; ++r4_) { WSP; GEMM_PHASE(pg8::EpiBf16<0>, ws + WS_BIG, ws + WS_WDN, DM, DFF, (bf16*)(ws + WS_XF), DM); }
        SEAM(pb + 9);
        if (IN(pb + 10)) for (int rep = 0; rep < REP_LN; ++rep) phase_resln<false>(P.ws, P.out, L, 1, lds, rep + 1 < REP_LN);
        SEAM(pb + 10);
        if (IN(pb + 11)) { WSP; if (GATE_INT8) GEMM_PHASE_X(2, pg8::EpiI8<0>, ws + WS_X8, ws + WS_WGT, DM, DM / 2, (bf16*)(ws + WS_XF), DM, (const float*)(ws + WS_SA), (const float*)(ws + WS_SWG));
            else if (GATE_FP8) GEMM_PHASE_X(true, pg8::EpiBf16<2>, ws + WS_X8, ws + WS_WGT, DM, DM / 2, (bf16*)(ws + WS_XF), DM);
            else GEMM_PHASE(pg8::EpiBf16<0>, ws + WS_XB, ws + WS_WGT, DM, DM, (bf16*)(ws + WS_XF), DM); }
        SEAM(pb + 11);
        if (IN(pb + 12)) for (int rep = 0; rep < REP_LN; ++rep) phase_resln<true>(P.ws, P.out, L, 2, lds, rep + 1 < REP_LN);
        SEAM(pb + 12);
#undef WSP
#undef GEMM_PHASE
#undef GEMM_PHASE_X
#undef GEMM_PHASE_R
    }
}
#undef IN
#undef SEAM

__global__ void __launch_bounds__(512, 2) hymba_fwd(Params P) {
#ifdef EMU
    unsigned char* lds = emu::lds_base();
#else
    extern __shared__ __attribute__((aligned(16))) unsigned char lds_raw[];
    LAS unsigned char* lds = (LAS unsigned char*)lds_raw;
#endif
    volatile LAS unsigned* MISC = (volatile LAS unsigned*)(lds + MISC_OFF);
    for (int u = threadIdx.x; u < 64; u += 512) MISC[u] = 0u;
    { LAS unsigned long long* pt = (LAS unsigned long long*)(lds + PTAB_OFF);
#pragma unroll
      for (int i = 0; i < 21; ++i) if (threadIdx.x == i) pt[i] = (unsigned long long)(size_t)P.in[i]; }
    __syncthreads();
    if ((P.ph_hi - P.ph_lo) > 1) (void)xcd_barrier_post((unsigned*)(P.ws + WS_CTL) + 4096, MISC + 8);
    layer_program<0>(P, lds);
    layer_program<1>(P, lds);
    static_assert(DEPTH == 2, "layer_program instantiations");

}

extern "C" void kernel_launch(void* const* d_in, const int* in_sizes, int n_in, void* d_out, int out_size, void* d_ws, size_t ws_size, hipStream_t stream) {
    static int grid = 0;
    if (grid == 0) {
        if (n_in != 21 || ws_size < WS_END) { fprintf(stderr, "kernel_launch: expected 21 inputs and >= %zu bytes of workspace; got %d inputs, %zu bytes\n", (size_t)WS_END, n_in, ws_size); grid = -1; return; }
        int dev = 0, cus = 0, per_cu = 0;
        if (hipGetDevice(&dev) != hipSuccess || hipDeviceGetAttribute(&cus, hipDeviceAttributeMultiprocessorCount, dev) != hipSuccess) { grid = -1; return; }
        if (hipFuncSetAttribute((const void*)hymba_fwd, hipFuncAttributeMaxDynamicSharedMemorySize, LDS_BYTES) != hipSuccess) { fprintf(stderr, "kernel_launch: hipFuncSetAttribute failed\n"); grid = -1; return; }
        if (hipOccupancyMaxActiveBlocksPerMultiprocessor(&per_cu, (const void*)hymba_fwd, 512, LDS_BYTES) != hipSuccess || per_cu < 1) fprintf(stderr, "kernel_launch: occupancy query reports %d\n", per_cu);
        (void)hipGetLastError();
        grid = cus;
    }
    if (grid < 0) return;
    (void)in_sizes; (void)out_size;
    hipMemsetAsync((char*)d_ws + WS_CTL, 0, CTL_BYTES, stream);
    Params p{};
    for (int i = 0; i < 21; ++i) p.in[i] = (const float*)d_in[i];
    p.out = (float*)d_out; p.ws = (unsigned char*)d_ws; p.grid = grid; p.pad = 0;
#if ONE_LAUNCH
    p.ph_lo = 0; p.ph_hi = N_PHASES;
    hipLaunchKernelGGL(hymba_fwd, dim3(grid), dim3(512), LDS_BYTES, stream, p);
#else
    for (int k = 0; k < N_PHASES; ++k) { p.ph_lo = k; p.ph_hi = k + 1; hipLaunchKernelGGL(hymba_fwd, dim3(grid), dim3(512), LDS_BYTES, stream, p); }
#endif
}
```

```cpp
#ifndef EMU
#include <hip/hip_runtime.h>
#endif
#include <cstdio>
#include <cstdint>
#include <type_traits>

#ifndef CFG_BATCH
#define CFG_BATCH 2
#endif
#ifndef CFG_SEQ
#define CFG_SEQ 8192
#endif
#ifndef CFG_DM
#define CFG_DM 4096
#endif
#ifndef CFG_DFF
#define CFG_DFF 16384
#endif
#ifndef ONE_LAUNCH
#define ONE_LAUNCH 1
#endif

#ifdef EMU
#define LAS
#define GAS
#define WAIT_VM0() ((void)0)
#define WAIT_LGKM0() ((void)0)
#define WAVE_SYNC() emu::wave_barrier()
#define CFENCE() ((void)0)
#else
#define LAS __attribute__((address_space(3)))
#define GAS __attribute__((address_space(1)))
#define WAIT_VM0() asm volatile("s_waitcnt vmcnt(0)" ::: "memory")
#define WAIT_LGKM0() asm volatile("s_waitcnt lgkmcnt(0)" ::: "memory")
#define WAVE_SYNC() do { asm volatile("s_waitcnt lgkmcnt(0)" ::: "memory"); __builtin_amdgcn_wave_barrier(); asm volatile("" ::: "memory"); } while (0)
#define CFENCE() asm volatile("" ::: "memory")
#endif
#define DI __device__ __forceinline__
#ifndef IN_INT8
#define IN_INT8 2
#endif
#ifndef ATT_FP8
#define ATT_FP8 1
#endif
#ifndef QKV_FP8
#define QKV_FP8 1
#endif
#ifndef UP_INT8
#define UP_INT8 3
#endif
#ifndef GATE_INT8
#define GATE_INT8 1
#endif
#ifndef GATE_FP8
#define GATE_FP8 1
#endif
#ifndef USE_NT
#define USE_NT 1
#endif
#if USE_NT
#define NT_LOAD(p) __builtin_nontemporal_load(p)
#else
#define NT_LOAD(p) (*(p))
#endif
#ifdef EMU
#define F8_PAD() ((void)0)
#else
#define F8_PAD() asm volatile("s_nop 15\n\ts_nop 15" ::: "memory")
#endif
#define PHASE_FN __device__ __forceinline__ void
#ifdef EMU
#define OPAQUE_V(x) ((void)0)
#define OPAQUE_S(x) ((void)0)
#else
#define OPAQUE_V(x) asm volatile("" : "+v"(x))
#define OPAQUE_S(x) asm volatile("" : "+s"(x))
#endif

namespace pg8 {
#define PG8_LAS LAS
typedef unsigned short bf16_t;
typedef short bf16x8 __attribute__((ext_vector_type(8)));
typedef float f32x4 __attribute__((ext_vector_type(4)));
typedef unsigned u32x4 __attribute__((ext_vector_type(4)));
typedef int i32x4_t __attribute__((ext_vector_type(4)));
typedef int v8i_t __attribute__((ext_vector_type(8)));
constexpr int BM = 256, BK = 64, HALF = 128, HTB = HALF * BK * 2  , STAGE_BYTES = 8 * HTB, NXCD = 8, WGM = 8;

__host__ __device__ __forceinline__ int lds_byte(int r, int c) { const int st = (r >> 4) * 2 + (c >> 5), rr = r & 15, cc = c & 31, ob = rr * 64 + cc * 2; return st * 1024 + (ob ^ (((ob >> 9) & 1) << 5)); }
__host__ __device__ __forceinline__ void stage_rc(int b, int& R, int& C) { const int st = b / 1024, sb = b % 1024, swz = sb ^ (((sb >> 9) & 1) << 5); R = (st >> 1) * 16 + swz / 64; C = (st & 1) * 32 + (swz % 64) / 2; }
__host__ __device__ __forceinline__ int perm32(int rho) { const int n = rho >> 4, i = rho & 15; return 8 * (i >> 2) + 4 * n + (i & 3); }

struct Unit { int pm, pn; };
struct Gemm { const bf16_t* A; const bf16_t* Bt; int M, N, K; };

struct StaticOrder {
    int nM, nN, nwg, G, c;
    __host__ __device__ void init(int M, int N, int G_, int c_) { nM = M / BM; nN = N / BM; nwg = nM * nN; G = G_; c = c_; }
    __host__ __device__ bool next(int i, Unit& u) const {
        const long L = (long)i * G + c; if (L >= nwg) return false;
        int wgid = (int)L; { const int q = nwg / NXCD, r = nwg % NXCD, xcd = wgid % NXCD, off = wgid / NXCD; wgid = (xcd < r ? xcd * (q + 1) : r * (q + 1) + (xcd - r) * q) + off; }
        const int nig = WGM * nN, gid = wgid / nig, fm = gid * WGM, gsz = (nM - fm) < WGM ? (nM - fm) : WGM;
        u.pm = fm + ((wgid % nig) % gsz); u.pn = (wgid % nig) / gsz; return true;
    }
    __device__ __forceinline__ void a_ready(const Unit&) const {}
    __device__ __forceinline__ void done(const Unit&) const {}
};


#ifdef EMU
__device__ __forceinline__ unsigned cvt_pk_bf16(float lo, float hi) { unsigned a = __float_as_uint(lo), b = __float_as_uint(hi); a = (a + 0x7fffu + ((a >> 16) & 1u)) >> 16; b = (b + 0x7fffu + ((b >> 16) & 1u)) >> 16; return a | (b << 16); }
#else
__device__ __forceinline__ unsigned cvt_pk_bf16(float lo, float hi) { unsigned r; asm volatile("v_cvt_pk_bf16_f32 %0, %1, %2" : "=v"(r) : "v"(lo), "v"(hi)); return r; }
#endif
typedef unsigned u32x2 __attribute__((ext_vector_type(2)));
template <int ACT> struct EpiBf16 {
    static constexpr bool PERM = true, AFTER_DRAIN = false;
    bf16_t* O; int ldc;
    __device__ __forceinline__ void operator()(const f32x4 (&acc)[2][2][4][2], const Unit& u, int wr, int wc, int fr, int fq) const {
        const int row0 = u.pm * BM + wr * 64 + fr, col0 = u.pn * BM + wc * 32 + 8 * fq;
#pragma unroll
        for (int ai = 0; ai < 2; ++ai)
#pragma unroll
            for (int m = 0; m < 4; ++m) { bf16_t* rowp = O + (size_t)(row0 + ai * HALF + m * 16) * ldc + col0;
#pragma unroll
                for (int bj = 0; bj < 2; ++bj) { f32x4 v0 = acc[ai][bj][m][0], v1 = acc[ai][bj][m][1];
                    if (ACT == 1) {
#pragma unroll
                        for (int j = 0; j < 4; ++j) { const float a = v0[j] > 0.f ? v0[j] : 0.f, b = v1[j] > 0.f ? v1[j] : 0.f; v0[j] = a * a; v1[j] = b * b; } }
                    if (ACT == 2) { v0 = v0 * 0.015625f; v1 = v1 * 0.015625f; }
                    u32x4 w; w.x = cvt_pk_bf16(v0[0], v0[1]); w.y = cvt_pk_bf16(v0[2], v0[3]); w.z = cvt_pk_bf16(v1[0], v1[1]); w.w = cvt_pk_bf16(v1[2], v1[3]);
                    *(u32x4*)(rowp + bj * HALF) = w; } }
    }
};
template <bool I8> struct AccSel { typedef f32x4 type; };
template <> struct AccSel<true> { typedef i32x4_t type; };
template <int ACT  > struct EpiI8 {
    static constexpr bool PERM = true, AFTER_DRAIN = false;
    bf16_t* O; int ldc; const float* sa; const float* sw;
    __device__ __forceinline__ void operator()(const i32x4_t (&acc)[2][2][4][2], const Unit& u, int wr, int wc, int fr, int fq) const {
        const int row0 = u.pm * BM + wr * 64 + fr, col0 = u.pn * BM + wc * 32 + 8 * fq;
        f32x4 cs[2][2];
#pragma unroll
        for (int bj = 0; bj < 2; ++bj) { cs[bj][0] = *(const f32x4*)(sw + col0 + bj * HALF); cs[bj][1] = *(const f32x4*)(sw + col0 + bj * HALF + 4); }
#pragma unroll
        for (int ai = 0; ai < 2; ++ai)
#pragma unroll
            for (int m = 0; m < 4; ++m) { const int row = row0 + ai * HALF + m * 16; const float ra = sa[row]; bf16_t* rowp = O + (size_t)row * ldc + col0;
#pragma unroll
                for (int bj = 0; bj < 2; ++bj) { f32x4 v0, v1;
#pragma unroll
                    for (int j = 0; j < 4; ++j) { const float a = (float)acc[ai][bj][m][0][j] * ra * cs[bj][0][j], b = (float)acc[ai][bj][m][1][j] * ra * cs[bj][1][j];
                        if (ACT == 1) { const float ap = fmaxf(a, 0.f), bp = fmaxf(b, 0.f); v0[j] = ap * ap; v1[j] = bp * bp; } else { v0[j] = a; v1[j] = b; } }
                    u32x4 w; w.x = cvt_pk_bf16(v0[0], v0[1]); w.y = cvt_pk_bf16(v0[2], v0[3]); w.z = cvt_pk_bf16(v1[0], v1[1]); w.w = cvt_pk_bf16(v1[2], v1[3]);
                    *(u32x4*)(rowp + bj * HALF) = w; } }
    }
};
template <bool GATE> struct EpiRes {
    static constexpr bool PERM = false, AFTER_DRAIN = false;
    const float* base; float* out; int ldc; float alpha; const bf16_t* emb;
    __device__ __forceinline__ void operator()(const f32x4 (&acc)[2][2][4][2], const Unit& u, int wr, int wc, int fr, int fq) const {
        const int row0 = u.pm * BM + wr * 64 + fr, col0 = u.pn * BM + wc * 32 + 4 * fq;
#pragma unroll
        for (int ai = 0; ai < 2; ++ai)
#pragma unroll
            for (int m = 0; m < 4; ++m) { const size_t off = (size_t)(row0 + ai * HALF + m * 16) * ldc + col0;
#pragma unroll
                for (int bj = 0; bj < 2; ++bj)
#pragma unroll
                    for (int n = 0; n < 2; ++n) { const size_t o = off + bj * HALF + n * 16; const f32x4 bs = *(const f32x4*)(base + o); f32x4 v = acc[ai][bj][m][n];
                        if (GATE) { const u32x2 e = *(const u32x2*)(emb + o);
                            const float e0 = __uint_as_float(e.x << 16), e1 = __uint_as_float(e.x & 0xffff0000u), e2 = __uint_as_float(e.y << 16), e3 = __uint_as_float(e.y & 0xffff0000u);
                            v[0] = e0 / (1.f + __expf(-v[0])); v[1] = e1 / (1.f + __expf(-v[1])); v[2] = e2 / (1.f + __expf(-v[2])); v[3] = e3 / (1.f + __expf(-v[3])); }
                        *(f32x4*)(out + o) = bs * alpha + v; } }
    }
};

#ifdef EMU
__device__ __forceinline__ void mfma_f8_acc(f32x4& c, v8i_t a, v8i_t b, int) { c = __builtin_amdgcn_mfma_scale_f32_16x16x128_f8f6f4(a, b, c, 0, 0, 0, 0x7f7f7f7f, 0, 0x7f7f7f7f); }
#else
__device__ __forceinline__ void mfma_f8_acc(f32x4& c, v8i_t a, v8i_t b, int sc) { asm volatile("v_mfma_scale_f32_16x16x128_f8f6f4 %0, %1, %2, %0, %3, %3 op_sel_hi:[0,0,0]" : "+v"(c) : "v"(a), "v"(b), "v"(sc)); }
#endif
#ifdef EMU
__device__ __forceinline__ void mfma_f8_acc2(f32x4& c, v8i_t a, v8i_t b, int sa, int sb, int, int) { c = __builtin_amdgcn_mfma_scale_f32_16x16x128_f8f6f4(a, b, c, 0, 0, 0, sa, 0, sb); }
#else
__device__ __forceinline__ void mfma_f8_acc2(f32x4& c, v8i_t a, v8i_t b, int, int, int va, int vb) { asm volatile("v_mfma_scale_f32_16x16x128_f8f6f4 %0, %1, %2, %0, %3, %4 op_sel_hi:[0,0,0]" : "+v"(c) : "v"(a), "v"(b), "v"(va), "v"(vb)); }
#endif
template <class Epi, class Sched, bool ALIGN_EPI = false, bool SP2 = false, int QM = 0>
__device__ __forceinline__ void gemm_phase(PG8_LAS unsigned char* lds, const Gemm g, const Sched& S, const Epi& E) {
    int tid_o = threadIdx.x; OPAQUE_V(tid_o);
    constexpr bool MX = (QM == 3), F8 = (QM == 1) || MX, I8 = (QM == 2); typedef typename AccSel<I8>::type acc_v;
    constexpr int NT8 = 12;
    const int tid = tid_o, wid = __builtin_amdgcn_readfirstlane(tid >> 6), lane = tid & 63, wr = wid >> 2, wc = wid & 3, fr = lane & 15, fq = lane >> 4;
    const int K = g.K, nt = K / BK;
    unsigned voffA[2], voffB[2];
#pragma unroll
    for (int i = 0; i < 2; ++i) { int R, C; stage_rc(tid * 16 + i * 8192, R, C); const int Rb = Epi::PERM ? ((R & ~31) + perm32(R & 31)) : R;
        voffA[i] = (unsigned)(R * K + C) * 2u; voffB[i] = (unsigned)(Rb * K + C) * 2u; }
    const size_t kstep = (size_t)(BK * 2);
    const size_t hstep = (size_t)HALF * K * 2;
    const size_t tstep = 2 * hstep;
    const unsigned ldsw = (unsigned)wid * 1024u;
    const int aoff = lds_byte(wr * 64 + fr, fq * 8), boff = lds_byte(wc * 32 + fr, fq * 8);
#define PG8_SA(b, h) (((b) * 2 + (h)) * HTB)
#define PG8_SB(b, h) ((4 + (b) * 2 + (h)) * HTB)
#define PG8_STAGE(bufoff, gbase, voff) do { _Pragma("unroll") for (int _i = 0; _i < 2; ++_i) \
        __builtin_amdgcn_global_load_lds((const unsigned*)((const char*)(gbase) + (voff)[_i]), (PG8_LAS unsigned*)(lds + (bufoff) + ldsw + _i * 8192), 16, 0, 0); } while (0)
#define PG8_LDA(dst, b, h) do { if constexpr (F8) { _Pragma("unroll") for (int m = 0; m < 4; ++m) dst##8[m] = __builtin_shufflevector(*(const PG8_LAS i32x4_t*)(lds + PG8_SA(b, h) + aoff + m * 2048), *(const PG8_LAS i32x4_t*)(lds + PG8_SA(b, h) + aoff + m * 2048 + 1024), 0, 1, 2, 3, 4, 5, 6, 7); } \
        else { _Pragma("unroll") for (int m = 0; m < 4; ++m) _Pragma("unroll") for (int k = 0; k < 2; ++k) dst[m][k] = *(const PG8_LAS bf16x8*)(lds + PG8_SA(b, h) + aoff + m * 2048 + k * 1024); } } while (0)
#define PG8_LDB(dst, b, h) do { if constexpr (F8) { _Pragma("unroll") for (int n = 0; n < 2; ++n) dst##8[n] = __builtin_shufflevector(*(const PG8_LAS i32x4_t*)(lds + PG8_SB(b, h) + boff + n * 2048), *(const PG8_LAS i32x4_t*)(lds + PG8_SB(b, h) + boff + n * 2048 + 1024), 0, 1, 2, 3, 4, 5, 6, 7); } \
        else { _Pragma("unroll") for (int n = 0; n < 2; ++n) _Pragma("unroll") for (int k = 0; k < 2; ++k) dst[n][k] = *(const PG8_LAS bf16x8*)(lds + PG8_SB(b, h) + boff + n * 2048 + k * 1024); } } while (0)
#ifndef GEMM_PRIO
#define GEMM_PRIO 1
#endif
#define PG8_MMA(ai, bj, At, Bt) do { if (GEMM_PRIO) __builtin_amdgcn_s_setprio(GEMM_PRIO); \
        if constexpr (MX) { if constexpr (mx8) { _Pragma("unroll") for (int m = 0; m < 4; ++m) _Pragma("unroll") for (int n = 0; n < 2; ++n) mfma_f8_acc2(acc[ai][bj][m][n], Bt##8[n], At##8[m], 0x79797979, 0x7b7b7b7b, mx_sw, mx_sa); } \
            else { _Pragma("unroll") for (int m = 0; m < 4; ++m) _Pragma("unroll") for (int n = 0; n < 2; ++n) { \
                acc[ai][bj][m][n] = __builtin_amdgcn_mfma_f32_16x16x32_bf16(__builtin_bit_cast(bf16x8, __builtin_shufflevector(Bt##8[n], Bt##8[n], 0, 1, 2, 3)), __builtin_bit_cast(bf16x8, __builtin_shufflevector(At##8[m], At##8[m], 0, 1, 2, 3)), acc[ai][bj][m][n], 0, 0, 0); \
                acc[ai][bj][m][n] = __builtin_amdgcn_mfma_f32_16x16x32_bf16(__builtin_bit_cast(bf16x8, __builtin_shufflevector(Bt##8[n], Bt##8[n], 4, 5, 6, 7)), __builtin_bit_cast(bf16x8, __builtin_shufflevector(At##8[m], At##8[m], 4, 5, 6, 7)), acc[ai][bj][m][n], 0, 0, 0); } } } \
        else if constexpr (F8) { _Pragma("unroll") for (int m = 0; m < 4; ++m) _Pragma("unroll") for (int n = 0; n < 2; ++n) \
            mfma_f8_acc(acc[ai][bj][m][n], Bt##8[n], At##8[m], f8_scale); } \
        else if constexpr (I8) { _Pragma("unroll") for (int m = 0; m < 4; ++m) _Pragma("unroll") for (int n = 0; n < 2; ++n) _Pragma("unroll") for (int k = 0; k < 2; ++k) \
            acc[ai][bj][m][n] = __builtin_amdgcn_mfma_i32_16x16x64_i8(__builtin_bit_cast(i32x4_t, Bt[n][k]), __builtin_bit_cast(i32x4_t, At[m][k]), acc[ai][bj][m][n], 0, 0, 0); } \
        else { _Pragma("unroll") for (int m = 0; m < 4; ++m) _Pragma("unroll") for (int n = 0; n < 2; ++n) _Pragma("unroll") for (int k = 0; k < 2; ++k) \
            acc[ai][bj][m][n] = __builtin_amdgcn_mfma_f32_16x16x32_bf16(Bt[n][k], At[m][k], acc[ai][bj][m][n], 0, 0, 0); } \
        if (GEMM_PRIO) __builtin_amdgcn_s_setprio(0); } while (0)
#ifdef EMU
#define PG8_WAIT_V(n) ((void)0)
#define PG8_WAIT_L(n) ((void)0)
#else
#define PG8_WAIT_V(n) asm volatile("s_waitcnt vmcnt(" #n ")" ::: "memory")
#define PG8_WAIT_L(n) asm volatile("s_waitcnt lgkmcnt(" #n ")" ::: "memory")
#endif
#define PG8_BAR __builtin_amdgcn_s_barrier()
#define PG8_SCHED __builtin_amdgcn_sched_barrier(0)
    Unit cur, nxt; int ui = 0;
    if (!S.next(0, cur)) return;
    acc_v acc[2][2][4][2];
#pragma unroll
    for (int a = 0; a < 2; ++a)
#pragma unroll
        for (int b = 0; b < 2; ++b)
#pragma unroll
            for (int m = 0; m < 4; ++m)
#pragma unroll
                for (int n = 0; n < 2; ++n) acc[a][b][m][n] = (acc_v){0, 0, 0, 0};
    int f8_scale = 0x7f7f7f7f; OPAQUE_V(f8_scale);
    int mx_sw = 0x79797979, mx_sa = 0x7b7b7b7b; OPAQUE_V(mx_sw); OPAQUE_V(mx_sa);
    bf16x8 At[4][2], B0[2][2], B1[2][2]; v8i_t At8[4], B08[2], B18[2];
    const char* cA = (const char*)g.A + (size_t)cur.pm * tstep; const char* cB = (const char*)g.Bt + (size_t)cur.pn * tstep;
    S.a_ready(cur);
    if constexpr (SP2) {
        PG8_STAGE(PG8_SB(0, 0), cB, voffB); PG8_STAGE(PG8_SB(0, 1), cB + hstep, voffB); PG8_STAGE(PG8_SA(0, 0), cA, voffA); PG8_STAGE(PG8_SA(0, 1), cA + hstep, voffA);
        if (wr == 1) PG8_BAR;
        PG8_WAIT_V(2); PG8_BAR;
        PG8_STAGE(PG8_SB(1, 0), cB + kstep, voffB); PG8_STAGE(PG8_SA(1, 0), cA + kstep, voffA); PG8_STAGE(PG8_SB(1, 1), cB + hstep + kstep, voffB);
        PG8_WAIT_V(6); PG8_BAR;
    } else {
        PG8_STAGE(PG8_SB(0, 0), cB, voffB); PG8_STAGE(PG8_SA(0, 0), cA, voffA); PG8_STAGE(PG8_SB(0, 1), cB + hstep, voffB); PG8_STAGE(PG8_SA(0, 1), cA + hstep, voffA);
        if (wr == 1) PG8_BAR;
        PG8_WAIT_V(4); PG8_BAR;
        PG8_STAGE(PG8_SB(1, 0), cB + kstep, voffB); PG8_STAGE(PG8_SA(1, 0), cA + kstep, voffA); PG8_STAGE(PG8_SB(1, 1), cB + hstep + kstep, voffB);
        PG8_WAIT_V(6); PG8_BAR;
    }
    for (;;) {
        const bool has_next = S.next(ui + 1, nxt);
        const char* nA = has_next ? (const char*)g.A + (size_t)nxt.pm * tstep : cA; const char* nB = has_next ? (const char*)g.Bt + (size_t)nxt.pn * tstep : cB;
        auto kiter = [&](auto mxtag, const int t) __attribute__((always_inline)) {
            constexpr bool mx8 = MX && decltype(mxtag)::value; (void)mx8;
            const bool last = (t == nt - 2);
            const char* a1 = cA + (size_t)(t + 1) * kstep;
            const char* a2 = last ? nA : cA + (size_t)(t + 2) * kstep; const char* b2 = last ? nB : cB + (size_t)(t + 2) * kstep;
            const char* a3 = a2 + kstep; const char* b3 = b2 + kstep;
            if (last && has_next) S.a_ready(nxt);
            if constexpr (SP2) {
            PG8_LDB(B0, 0, 0); PG8_LDB(B1, 0, 1); PG8_SCHED; PG8_LDA(At, 0, 0); PG8_STAGE(PG8_SA(1, 1), a1 + hstep, voffA);
            PG8_WAIT_V(8); PG8_WAIT_L(0); PG8_BAR; PG8_MMA(0, 0, At, B0); PG8_MMA(0, 1, At, B1); PG8_BAR; PG8_SCHED;
            PG8_LDA(At, 0, 1); PG8_STAGE(PG8_SB(0, 0), b2, voffB); PG8_STAGE(PG8_SB(0, 1), b2 + hstep, voffB); PG8_STAGE(PG8_SA(0, 0), a2, voffA);
            PG8_WAIT_V(8); PG8_WAIT_L(0); PG8_BAR; PG8_MMA(1, 0, At, B0); PG8_MMA(1, 1, At, B1); PG8_BAR; PG8_SCHED;
            PG8_LDB(B0, 1, 0); PG8_LDB(B1, 1, 1); PG8_SCHED; PG8_LDA(At, 1, 0); PG8_STAGE(PG8_SA(0, 1), a2 + hstep, voffA);
            PG8_WAIT_V(8); PG8_WAIT_L(0); PG8_BAR; PG8_MMA(0, 0, At, B0); PG8_MMA(0, 1, At, B1); PG8_BAR; PG8_SCHED;
            PG8_LDA(At, 1, 1); PG8_STAGE(PG8_SB(1, 0), b3, voffB); PG8_STAGE(PG8_SB(1, 1), b3 + hstep, voffB); PG8_STAGE(PG8_SA(1, 0), a3, voffA);
            PG8_WAIT_V(8); PG8_WAIT_L(0); PG8_BAR; PG8_MMA(1, 0, At, B0); PG8_MMA(1, 1, At, B1); PG8_BAR; PG8_SCHED;
            } else {
            PG8_LDB(B0, 0, 0); PG8_SCHED; PG8_LDA(At, 0, 0); PG8_STAGE(PG8_SA(1, 1), a1 + hstep, voffA);
            PG8_WAIT_L(8); PG8_BAR; PG8_WAIT_L(0); PG8_MMA(0, 0, At, B0); PG8_BAR; PG8_SCHED;
            PG8_LDB(B1, 0, 1); PG8_STAGE(PG8_SB(0, 0), b2, voffB);
            PG8_BAR; PG8_WAIT_L(0); PG8_MMA(0, 1, At, B1); PG8_BAR;
            PG8_LDA(At, 0, 1); PG8_STAGE(PG8_SA(0, 0), a2, voffA);
            PG8_BAR; PG8_WAIT_L(0); PG8_MMA(1, 0, At, B0); PG8_BAR; PG8_SCHED;
            PG8_STAGE(PG8_SB(0, 1), b2 + hstep, voffB);
            PG8_WAIT_V(6); PG8_BAR; PG8_MMA(1, 1, At, B1); PG8_BAR;
            PG8_LDB(B0, 1, 0); PG8_SCHED; PG8_LDA(At, 1, 0); PG8_STAGE(PG8_SA(0, 1), a2 + hstep, voffA);
            PG8_WAIT_L(8); PG8_BAR; PG8_WAIT_L(0); PG8_MMA(0, 0, At, B0); PG8_BAR; PG8_SCHED;
            PG8_LDB(B1, 1, 1); PG8_STAGE(PG8_SB(1, 0), b3, voffB);
            PG8_BAR; PG8_WAIT_L(0); PG8_MMA(0, 1, At, B1); PG8_BAR;
            PG8_LDA(At, 1, 1); PG8_STAGE(PG8_SA(1, 0), a3, voffA);
            PG8_BAR; PG8_WAIT_L(0); PG8_MMA(1, 0, At, B0); PG8_BAR; PG8_SCHED;
            PG8_STAGE(PG8_SB(1, 1), b3 + hstep, voffB);
            PG8_WAIT_V(6); PG8_BAR; PG8_MMA(1, 1, At, B1); PG8_BAR;
            }
        };
        if constexpr (MX) { for (int t = 0; t < NT8; t += 2) kiter(std::true_type{}, t); for (int t = NT8; t < nt; t += 2) kiter(std::false_type{}, t); }
        else { for (int t = 0; t < nt; t += 2) kiter(std::false_type{}, t); }
        if constexpr (ALIGN_EPI) { if (wr == 0) PG8_BAR; }
        if constexpr (F8) { F8_PAD(); }
        if constexpr (!Epi::AFTER_DRAIN) { E(acc, cur, wr, wc, fr, fq); S.done(cur); }
        if (!has_next) break;
#pragma unroll
        for (int a = 0; a < 2; ++a)
#pragma unroll
            for (int b = 0; b < 2; ++b)
#pragma unroll
                for (int m = 0; m < 4; ++m)
#pragma unroll
                    for (int n = 0; n < 2; ++n) acc[a][b][m][n] = (acc_v){0, 0, 0, 0};
        cur = nxt; cA = nA; cB = nB; ++ui;
        if constexpr (ALIGN_EPI) { if (wr == 1) PG8_BAR; }
    }
    PG8_WAIT_V(0);
    if constexpr (!ALIGN_EPI) { if (wr == 0) PG8_BAR; }
    PG8_BAR;
    if constexpr (Epi::AFTER_DRAIN) { E.fused(acc, cur, wr, wc, fr, fq, lds, wid, lane); S.done(cur); }
#undef PG8_SA
#undef PG8_SB
#undef PG8_STAGE
#undef PG8_LDA
#undef PG8_LDB
#undef PG8_MMA
#undef PG8_WAIT_V
#undef PG8_WAIT_L
#undef PG8_BAR
#undef PG8_SCHED
}
}


constexpr int BATCH = CFG_BATCH, SEQ = CFG_SEQ, DM = CFG_DM, DFF = CFG_DFF, DEPTH = 2;
constexpr int M = BATCH * SEQ, NCH = SEQ / 128;
constexpr int DMIX = 4096, DPLE = 256, D_IN = 11800;
constexpr int NU = 12032;
constexpr int UQ = 0, UK = 1536, UV = 3072, UZ = 4608, UX = 6144, UB = 7680, UC = 8192, USB = 8704, USC = 9728, USH = 10752, UDT = 11776;
constexpr float LN_EPS = 1e-5f, RMS_EPS = 1e-5f, DN_ALPHA = 1.41421356237f, ATT_SCALE = 0.08838834764831845f;
static_assert((IN_INT8 & 1) == 0 && (!IN_INT8 || QKV_FP8), "IN_INT8: layer 1 only, on top of the QKV_FP8 split");
static_assert(SEQ % 2048 == 0 && M % 256 == 0 && DM % 256 == 0 && DFF % 256 == 0 && DM <= DMIX, "shape");
constexpr int NQKV = 4608, NREST = NU - NQKV;
constexpr size_t WINB_OFF = (size_t)NQKV * DM;
DI int remap_u(int n) { return n < 8704 ? n : (n < 8728 ? UDT + (n - 8704) : n - 24); }

constexpr int CAT_PITCH = ATT_FP8 ? 3328 : 4096;
constexpr int CAT_SSM = ATT_FP8 ? 768 : 1536, CAT_SC = CAT_SSM + 1536;
constexpr int ATT_PITCH = ATT_FP8 ? 1536 : CAT_PITCH;
typedef pg8::bf16_t bf16;
typedef pg8::f32x4 f32x4;
typedef pg8::u32x4 u32x4;
typedef pg8::bf16x8 bf16x8;
typedef pg8::u32x2 u32x2;
typedef short s16x4 __attribute__((ext_vector_type(4)));

constexpr size_t al256(size_t x) { return (x + 255) & ~(size_t)255; }
constexpr size_t WS_CTL = 0, CTL_BYTES = 1u << 20;
constexpr size_t WS_WIN = WS_CTL + CTL_BYTES;
constexpr size_t WS_WOUT = WS_WIN + al256((size_t)NU * DM * 2);
constexpr size_t WS_WUP = WS_WOUT + al256((size_t)DM * DMIX * 2);
constexpr size_t WS_WDN = WS_WUP + al256((size_t)DFF * DM * 2);
constexpr size_t WS_WGT = WS_WDN + al256((size_t)DM * DFF * 2);
constexpr size_t WS_WPE = WS_WGT + al256((size_t)DM * DM * 2);
constexpr size_t WS_XB = WS_WPE + al256((size_t)DM * DPLE * 2);
constexpr size_t WS_XF = WS_XB + al256((size_t)M * DM * 2);
constexpr size_t WS_CAT = WS_XF + al256((size_t)M * DM * 2);
constexpr size_t WS_PB = WS_CAT + al256((size_t)M * DMIX * 2);
constexpr size_t WS_LSE = WS_PB + al256((size_t)DEPTH * M * DPLE * 2);
constexpr size_t WS_ROPE = WS_LSE + al256((size_t)M * 12 * 4);
constexpr size_t WS_CD = WS_ROPE + al256((size_t)SEQ * 32 * 4);
constexpr size_t WS_EMB = WS_CD + al256((size_t)BATCH * NCH * 24 * 4);
constexpr size_t WS_YS = WS_EMB + al256((size_t)M * DM * 2);
constexpr size_t WS_XC = WS_YS + al256((size_t)256 * 6 * 16 * 512 * 4);
constexpr size_t WS_PVB = WS_XC + al256((size_t)M * 2560 * 2);
constexpr size_t WS_X8 = WS_PVB + al256((size_t)BATCH * NCH * 24 * 8192 * 2);
constexpr size_t WS_SA = WS_X8 + al256((size_t)M * DM);
constexpr size_t WS_SW = WS_SA + al256((size_t)M * 4);
constexpr size_t WS_SWG = WS_SW + al256((size_t)DFF * 4);
constexpr size_t WS_SWI = WS_SWG + al256((size_t)DM * 4);
constexpr size_t WS_X8I = WS_SWI + al256((size_t)(NU - 4608) * 4);
constexpr size_t WS_ATT = WS_X8I + al256((size_t)M * DM);
constexpr size_t WS_BIG = WS_ATT + al256((size_t)M * 1536 * 2);
constexpr size_t BIG_U_BYTES = al256((size_t)M * NU * 2), BIG_ST_BYTES = al256((size_t)BATCH * NCH * 24 * 64 * 128 * 4), BIG_H_BYTES = al256((size_t)M * DFF * 2);
constexpr size_t BIG_BYTES = (BIG_U_BYTES + BIG_ST_BYTES) > BIG_H_BYTES ? (BIG_U_BYTES + BIG_ST_BYTES) : BIG_H_BYTES;
constexpr size_t WS_END = WS_BIG + BIG_BYTES;

constexpr int RING_BYTES = 139264;
constexpr int MISC_OFF = RING_BYTES;
constexpr int LDS_BYTES = 147456;

DI float bf2f(unsigned short b) { return __uint_as_float(((unsigned)b) << 16); }
DI unsigned short f2bf(float f) { unsigned u = __float_as_uint(f); return (unsigned short)((u + 0x7fffu + ((u >> 16) & 1u)) >> 16); }
DI unsigned pk2(float lo, float hi) { return (unsigned)f2bf(lo) | ((unsigned)f2bf(hi) << 16); }
DI float rcp_f(float x) { return __builtin_amdgcn_rcpf(x); }
DI float silu_f(float x) { return x * rcp_f(1.f + __expf(-x)); }
DI float softplus_f(float x) { return (x > 0.f ? x : 0.f) + log1pf(__expf(-fabsf(x))); }
#ifdef EMU
DI bf16x8 tr_read2(const bf16* p_lo, const bf16* p_hi) { const emu_s16x4 a = emu_tr_read_b64(p_lo), b = emu_tr_read_b64(p_hi); return __builtin_shufflevector(a, b, 0, 1, 2, 3, 4, 5, 6, 7); }
#else
DI bf16x8 tr_read2(const LAS bf16* p_lo, const LAS bf16* p_hi) { s16x4 a, b;
    asm volatile("ds_read_b64_tr_b16 %0, %2\n\tds_read_b64_tr_b16 %1, %3\n\ts_waitcnt lgkmcnt(0)" : "=&v"(a), "=&v"(b) : "v"((unsigned)(size_t)p_lo), "v"((unsigned)(size_t)p_hi) : "memory");
    return __builtin_shufflevector(a, b, 0, 1, 2, 3, 4, 5, 6, 7); }
#endif
#ifdef EMU
DI float shfl_f(float v, int src) { return emu::shfl_idx(v, src); }
#else
DI float shfl_f(float v, int src) { return __int_as_float(__builtin_amdgcn_ds_bpermute(src << 2, __float_as_int(v))); }
#endif
#ifdef EMU
DI int bcast_lane0(int v) { return emu::shfl_idx(v, 0); }
#else
DI int bcast_lane0(int v) { return __builtin_amdgcn_readfirstlane(v); }
#endif
DI float wave_sum(float v, int lane) {
#pragma unroll
    for (int o = 1; o < 64; o <<= 1) v += shfl_f(v, lane ^ o);
    return v; }
DI float wave_max(float v, int lane) {
#pragma unroll
    for (int o = 1; o < 64; o <<= 1) v = fmaxf(v, shfl_f(v, lane ^ o));
    return v; }

#ifdef EMU
DI unsigned char* ld_ws(unsigned char* p) { return p; }
DI float* ld_out(float* p) { return p; }
DI int ld_grid() { return (int)gridDim.x; }
#else
DI int ld_grid() { int v; asm volatile("s_load_dword %0, %1, 0xc0\n\ts_waitcnt lgkmcnt(0)" : "=s"(v) : "s"(__builtin_amdgcn_kernarg_segment_ptr())); return v; }
DI unsigned long long karg_u64_168() { unsigned long long v; asm volatile("s_load_dwordx2 %0, %1, 0xa8\n\ts_waitcnt lgkmcnt(0)" : "=s"(v) : "s"(__builtin_amdgcn_kernarg_segment_ptr())); return v; }
DI unsigned long long karg_u64_176() { unsigned long long v; asm volatile("s_load_dwordx2 %0, %1, 0xb0\n\ts_waitcnt lgkmcnt(0)" : "=s"(v) : "s"(__builtin_amdgcn_kernarg_segment_ptr())); return v; }
DI unsigned char* ld_ws(unsigned char*) { return (unsigned char*)(GAS unsigned char*)karg_u64_176(); }
DI float* ld_out(float*) { return (float*)(GAS float*)karg_u64_168(); }
#endif
#define XB_TMO      128
#define XB_XCNT(j)  (256  + 64 * (j))
#define XB_XSUB(j)  (1280 + 64 * (j))
#define XB_XGEN(j)  (2304 + 64 * (j))
#define XB_TOP      3328
#define XB_TOPGEN   3392
#define XCD_BAR_WORDS 3456
#define XB_SPIN_CAP (1u << 18)

__device__ __forceinline__ unsigned xb_ld(unsigned* p)              { return __hip_atomic_load(p, __ATOMIC_RELAXED, __HIP_MEMORY_SCOPE_AGENT); }
__device__ __forceinline__ unsigned xb_add(unsigned* p, unsigned v) { return __hip_atomic_fetch_add(p, v, __ATOMIC_RELAXED, __HIP_MEMORY_SCOPE_AGENT); }
__device__ __forceinline__ unsigned xb_xcc_id() { return (unsigned)__builtin_amdgcn_s_getreg((3 << 11) | 20) & 0xFu; }
#define XB_SPIN(cond, bar) do { unsigned _sp = 0; while (cond) { __builtin_amdgcn_s_sleep(1); \
    if ((++_sp & 255u) == 0u) { if (xb_ld(&(bar)[XB_TMO])) break; if (_sp > XB_SPIN_CAP) { atomicAdd(&(bar)[XB_TMO], 1u); break; } } } } while (0)

struct XcdBarrier {
    unsigned* bar; unsigned x;
    volatile LAS unsigned* st;
};

__device__ __forceinline__ XcdBarrier xcd_barrier_post(unsigned* bar, volatile LAS unsigned* st) {
    XcdBarrier b; b.bar = bar; b.x = xb_xcc_id(); b.st = st;
    if (threadIdx.x == 0) (void)xb_add(&bar[XB_XCNT(b.x)], 1u);
    return b;
}
__device__ __forceinline__ void xcd_barrier_complete(unsigned* bar, unsigned x, unsigned& nloc, unsigned& nx) {
    const unsigned G = (unsigned)ld_grid();
    unsigned sum, cnt, mine, sp = 0u;
    for (;;) {
        sum = 0u; cnt = 0u; mine = 0u;
#pragma unroll
        for (unsigned j = 0; j < 16; ++j) { const unsigned c = xb_ld(&bar[XB_XCNT(j)]); sum += c; cnt += (c > 0u) ? 1u : 0u; mine = (j == x) ? c : mine; }
        if (sum == G) break;
        __builtin_amdgcn_s_sleep(1);
        if ((++sp & 255u) == 0u) { if (xb_ld(&bar[XB_TMO])) break; if (sp > XB_SPIN_CAP) { atomicAdd(&bar[XB_TMO], 1u); break; } }
    }
    nloc = mine > 0u ? mine : 1u; nx = cnt > 0u ? cnt : 1u;
}

__device__ __forceinline__ void xcd_barrier(const XcdBarrier& b) {
    WAIT_VM0();
    __syncthreads();
    if (threadIdx.x == 0) {
        unsigned* bar = b.bar;
        __builtin_amdgcn_s_waitcnt(0);
        unsigned nloc = b.st[0], nx = b.st[1];
        if (nloc == 0u) { xcd_barrier_complete(bar, b.x, nloc, nx); b.st[0] = nloc; b.st[1] = nx; }
        const unsigned old = xb_add(&bar[XB_XSUB(b.x)], 1u);
        const unsigned gen = old / nloc;
        if (old + 1u == (gen + 1u) * nloc) {
            __builtin_amdgcn_fence(__ATOMIC_RELEASE, "agent");
            WAIT_VM0();
            const unsigned og = xb_add(&bar[XB_TOP], 1u);
            const unsigned tg = og / nx;
            if (og + 1u == (tg + 1u) * nx) xb_add(&bar[XB_TOPGEN], 1u);
            else XB_SPIN(xb_ld(&bar[XB_TOPGEN]) == tg, bar);
            __builtin_amdgcn_fence(__ATOMIC_ACQUIRE, "agent");
            xb_add(&bar[XB_XGEN(b.x)], 1u);
            WAIT_VM0();
        } else {
            XB_SPIN(xb_ld(&bar[XB_XGEN(b.x)]) == gen, bar);
            __builtin_amdgcn_fence(__ATOMIC_ACQUIRE, "agent");
            WAIT_VM0();
        }
    }
    __syncthreads();
}

constexpr int PTAB_OFF = MISC_OFF + 256;
DI const float* inp(LAS unsigned char* lds, int i) { const LAS unsigned* t = (const LAS unsigned*)(lds + PTAB_OFF) + 2 * i;
    const unsigned lo = __builtin_amdgcn_readfirstlane(t[0]), hi = __builtin_amdgcn_readfirstlane(t[1]); return (const float*)(const GAS float*)(((unsigned long long)hi << 32) | (unsigned long long)lo); }
DI unsigned char* opq(unsigned char* p) { unsigned lo = __builtin_amdgcn_readfirstlane((unsigned)(size_t)p), hi = __builtin_amdgcn_readfirstlane((unsigned)((size_t)p >> 32)); OPAQUE_S(lo); OPAQUE_S(hi); return (unsigned char*)(GAS unsigned char*)(((size_t)hi << 32) | (size_t)lo); }
struct Params { const float* in[21]; float* out; unsigned char* ws; int ph_lo, ph_hi; int grid, pad; };
enum { I_X = 0, I_P, I_WIN, I_CW, I_CB, I_DTB, I_ALOG, I_SD, I_NW, I_SCW, I_WOUT, I_L1G, I_L1B, I_WUP, I_WDN, I_L2G, I_L2B, I_WPE, I_WGT, I_L3G, I_L3B };

template <bool REMAP> DI void transpose_item(const float* W, int K, int N, bf16* WT, LAS float* scr, int item, int lane, int row_off = 0, int dpitch = 0, int koff = 0) {
    const int nblk = (N + 63) / 64, kb = item / nblk, nb = item % nblk, k0 = 64 * kb, n0 = 64 * nb;
    const int r4 = lane >> 4, c4 = lane & 15, nl = n0 + 4 * c4;
    f32x4 v[16];
#pragma unroll
    for (int i = 0; i < 16; ++i) v[i] = nl < N ? NT_LOAD((const f32x4*)(W + (size_t)(k0 + 4 * i + r4) * N + nl)) : (f32x4){0.f, 0.f, 0.f, 0.f};
#pragma unroll
    for (int i = 0; i < 16; ++i) { LAS float* d = scr + (4 * i + r4) * 65 + 4 * c4; d[0] = v[i][0]; d[1] = v[i][1]; d[2] = v[i][2]; d[3] = v[i][3]; }
    WAVE_SYNC();
#pragma unroll
    for (int j = 0; j < 8; ++j) { const int chunk = lane + 64 * j, nn = chunk >> 3, kc = chunk & 7, n = n0 + nn; const LAS float* s = scr + (8 * kc) * 65 + nn;
        u32x4 o; o.x = pk2(s[0 * 65], s[1 * 65]); o.y = pk2(s[2 * 65], s[3 * 65]); o.z = pk2(s[4 * 65], s[5 * 65]); o.w = pk2(s[6 * 65], s[7 * 65]);
        if (n < N) { const int row = (REMAP ? remap_u(n) : n) - row_off; *(u32x4*)(WT + (size_t)row * (dpitch ? dpitch : K) + k0 + koff + 8 * kc) = o; } }
    WAVE_SYNC();
}
DI unsigned pk4_fp8(float a, float b, float c, float d) { int w = 0; w = __builtin_amdgcn_cvt_pk_fp8_f32(a, b, w, false); w = __builtin_amdgcn_cvt_pk_fp8_f32(c, d, w, true); return (unsigned)w; }
DI void transpose_item_fp8(const float* W, int K, int N, unsigned char* WT8, LAS float* scr, int item, int lane, int dpitch = 0) {
    const int nblk = (N + 63) / 64, kb = item / nblk, nb = item % nblk, k0 = 64 * kb, n0 = 64 * nb;
    const int r4 = lane >> 4, c4 = lane & 15, nl = n0 + 4 * c4;
    f32x4 v[16];
#pragma unroll
    for (int i = 0; i < 16; ++i) v[i] = nl < N ? NT_LOAD((const f32x4*)(W + (size_t)(k0 + 4 * i + r4) * N + nl)) : (f32x4){0.f, 0.f, 0.f, 0.f};
#pragma unroll
    for (int i = 0; i < 16; ++i) { LAS float* d = scr + (4 * i + r4) * 65 + 4 * c4; d[0] = v[i][0]; d[1] = v[i][1]; d[2] = v[i][2]; d[3] = v[i][3]; }
    WAVE_SYNC();
#pragma unroll
    for (int j = 0; j < 4; ++j) { const int chunk = lane + 64 * j, nn = chunk >> 2, kc = chunk & 3, n = n0 + nn; const LAS float* s = scr + (16 * kc) * 65 + nn;
        u32x4 o;
#pragma unroll
        for (int e = 0; e < 4; ++e) o[e] = pk4_fp8(s[(4 * e) * 65] * 64.f, s[(4 * e + 1) * 65] * 64.f, s[(4 * e + 2) * 65] * 64.f, s[(4 * e + 3) * 65] * 64.f);
        if (n < N) *(u32x4*)(WT8 + (size_t)n * (dpitch ? dpitch : K) + k0 + 16 * kc) = o; }
    WAVE_SYNC();
}
template <bool WIN> DI void upq_strips(const float* W, int K, int N, signed char* WT8, float* sw_out, LAS unsigned char* lds, int BID, int GSZ, int wave, int lane) {
    LAS float* scr = (LAS float*)(lds + wave * 16640); LAS float* cmx = (LAS float*)(lds + 8 * 16640); LAS float* inv = cmx + 8 * 64;
    const int r4 = lane >> 4, c4 = lane & 15, ntile = K / 64;
    const int nstrip = WIN ? (D_IN - NQKV + 63) / 64 : N / 64;
    for (int s = BID; s < nstrip; s += GSZ) { const int n0 = WIN ? NQKV + 64 * s : 64 * s; const bool cok = !WIN || (n0 + 4 * c4 < D_IN);
        f32x4 mx = {0.f, 0.f, 0.f, 0.f};
        for (int kb = wave; kb < ntile; kb += 16) {
            f32x4 v[2][16]; const bool two = kb + 8 < ntile;
#pragma unroll
            for (int i = 0; i < 16; ++i) { v[0][i] = cok ? *(const f32x4*)(W + (size_t)(64 * kb + 4 * i + r4) * N + n0 + 4 * c4) : (f32x4){0.f, 0.f, 0.f, 0.f}; v[1][i] = (two && cok) ? *(const f32x4*)(W + (size_t)(64 * (kb + 8) + 4 * i + r4) * N + n0 + 4 * c4) : (f32x4){0.f, 0.f, 0.f, 0.f}; }
#pragma unroll
            for (int i = 0; i < 16; ++i)
#pragma unroll
                for (int e = 0; e < 4; ++e) mx[e] = fmaxf(mx[e], fmaxf(fabsf(v[0][i][e]), fabsf(v[1][i][e]))); }
#pragma unroll
        for (int e = 0; e < 4; ++e) { mx[e] = fmaxf(mx[e], shfl_f(mx[e], lane ^ 16)); mx[e] = fmaxf(mx[e], shfl_f(mx[e], lane ^ 32)); }
        if (r4 == 0) { cmx[wave * 64 + 4 * c4] = mx[0]; cmx[wave * 64 + 4 * c4 + 1] = mx[1]; cmx[wave * 64 + 4 * c4 + 2] = mx[2]; cmx[wave * 64 + 4 * c4 + 3] = mx[3]; }
        __syncthreads();
        if (wave == 0) { float m = 0.f;
#pragma unroll
            for (int w = 0; w < 8; ++w) m = fmaxf(m, cmx[w * 64 + lane]);
            m = fmaxf(m, 1e-30f); inv[lane] = 127.f / m; if (!WIN) sw_out[n0 + lane] = m * (1.f / 127.f); else if (n0 + lane < D_IN) sw_out[remap_u(n0 + lane) - NQKV] = m * (1.f / 127.f); }
        __syncthreads();
        f32x4 v[16];
#pragma unroll
        for (int i = 0; i < 16; ++i) v[i] = cok ? *(const f32x4*)(W + (size_t)(64 * wave + 4 * i + r4) * N + n0 + 4 * c4) : (f32x4){0.f, 0.f, 0.f, 0.f};
        for (int kb = wave; kb < ntile; kb += 8) { const int k0 = 64 * kb;
#pragma unroll
            for (int i = 0; i < 16; ++i) { LAS float* d = scr + (4 * i + r4) * 65 + 4 * c4; d[0] = v[i][0]; d[1] = v[i][1]; d[2] = v[i][2]; d[3] = v[i][3]; }
            if (kb + 8 < ntile) {
#pragma unroll
                for (int i = 0; i < 16; ++i) v[i] = cok ? *(const f32x4*)(W + (size_t)(k0 + 512 + 4 * i + r4) * N + n0 + 4 * c4) : (f32x4){0.f, 0.f, 0.f, 0.f}; }
            WAVE_SYNC();
#pragma unroll
            for (int j = 0; j < 4; ++j) { const int chunk = lane + 64 * j, nn = chunk >> 2, kc = chunk & 3; const LAS float* sp = scr + (16 * kc) * 65 + nn; const float iv = inv[nn];
                u32x4 o;
#pragma unroll
                for (int e = 0; e < 4; ++e) { unsigned w = 0;
#pragma unroll
                    for (int b = 0; b < 4; ++b) w |= ((unsigned)(__float2int_rn(sp[(4 * e + b) * 65] * iv) & 0xff)) << (8 * b);
                    o[e] = w; }
                if (!WIN) *(u32x4*)(WT8 + (size_t)(n0 + nn) * K + k0 + 16 * kc) = o; else if (n0 + nn < D_IN) *(u32x4*)(WT8 + (size_t)(remap_u(n0 + nn) - NQKV) * K + k0 + 16 * kc) = o; }
            WAVE_SYNC(); }
        __syncthreads();
    }
}
PHASE_FN phase_weights(unsigned char* wsarg, int L, LAS unsigned char* lds, int qsel = 0) {
    int BID = blockIdx.x, GSZ = ld_grid(); OPAQUE_S(BID); OPAQUE_S(GSZ); OPAQUE_S(lds);
    unsigned char* const WSQ = ld_ws(wsarg);
    int tid_o = threadIdx.x; OPAQUE_V(tid_o);
    const int tid = tid_o, lane = tid & 63, wave = __builtin_amdgcn_readfirstlane(tid >> 6);
    LAS float* scr = (LAS float*)(lds + wave * 16640);
    const int gw = BID * 8 + wave, NGW = GSZ * 8;
    unsigned char* ws = WSQ;
    const float* win = inp(lds, I_WIN) + (size_t)L * DM * D_IN; const float* wout = inp(lds, I_WOUT) + (size_t)L * DMIX * DM; const float* wup = inp(lds, I_WUP) + (size_t)L * DM * DFF;
    const float* wdn = inp(lds, I_WDN) + (size_t)L * DFF * DM; const float* wgt = inp(lds, I_WGT) + (size_t)L * DM * DM; const float* wpe = inp(lds, I_WPE) + (size_t)L * DPLE * DM;
    constexpr int I_1 = (DM / 64) * ((D_IN + 63) / 64), I_2 = (DMIX / 64) * (DM / 64), I_3 = (DM / 64) * (DFF / 64), I_4 = (DFF / 64) * (DM / 64), I_5 = (DM / 64) * (DM / 64), I_6 = (DPLE / 64) * (DM / 64);
    static_assert(8 * 16640 + 8 * 64 * 4 + 256 <= RING_BYTES && D_IN % 4 == 0 && DM % 64 == 0 && DFF % 64 == 0, "weights phase tiles");
    constexpr int NIT = I_1 + I_2 + I_3 + I_4 + I_5 + I_6;
    if ((IN_INT8 >> L) & 1) { upq_strips<true>(win, DM, D_IN, (signed char*)(ws + WS_WIN + WINB_OFF), (float*)(ws + WS_SWI), lds, (BID + GSZ / 4) % GSZ, GSZ, wave, lane);
        { u32x4* z = (u32x4*)(ws + WS_WIN + WINB_OFF + (size_t)(D_IN - NQKV) * DM); const size_t n16 = (size_t)(NU - D_IN) * DM / 16; for (size_t i = (size_t)BID * 512 + tid; i < n16; i += (size_t)GSZ * 512) z[i] = (u32x4){0u, 0u, 0u, 0u};
          float* zs = (float*)(ws + WS_SWI) + (D_IN - NQKV); for (int i = BID * 512 + tid; i < NU - D_IN; i += GSZ * 512) zs[i] = 0.f; } }
    if ((UP_INT8 >> L) & 1) upq_strips<false>(wup, DM, DFF, (signed char*)(ws + WS_WUP), (float*)(ws + WS_SW), lds, BID, GSZ, wave, lane);
    if (GATE_INT8) upq_strips<false>(wgt, DM, DM, (signed char*)(ws + WS_WGT), (float*)(ws + WS_SWG), lds, (BID + GSZ / 2) % GSZ, GSZ, wave, lane);
    unsigned* qctr = (unsigned*)(ws + WS_CTL) + 12288 + 64 * (2 * L + (int)(qsel & 1)); (void)gw; (void)NGW;
    for (;;) { unsigned c0 = 0; if (lane == 0) c0 = __hip_atomic_fetch_add(qctr, 16u, __ATOMIC_RELAXED, __HIP_MEMORY_SCOPE_AGENT);
      c0 = (unsigned)bcast_lane0((int)c0); if (c0 >= (unsigned)NIT) break;
      for (int it = (int)c0; it < (int)c0 + 16 && it < NIT; ++it) {
        int r = it;
        if (r < I_1) { if (QKV_FP8) { if (r % ((D_IN + 63) / 64) < NQKV / 64) transpose_item_fp8(win, DM, D_IN, ws + WS_WIN, scr, r, lane); else if (!((IN_INT8 >> L) & 1)) transpose_item<true>(win, DM, D_IN, (bf16*)(ws + WS_WIN + WINB_OFF), scr, r, lane, NQKV); }
                       else transpose_item<true>(win, DM, D_IN, (bf16*)(ws + WS_WIN), scr, r, lane); continue; } r -= I_1;
        if (r < I_2) { if (ATT_FP8) { if (r / (DM / 64) < 1536 / 64) transpose_item_fp8(wout, DMIX, DM, ws + WS_WOUT, scr, r, lane, CAT_PITCH * 2); else transpose_item<false>(wout, DMIX, DM, (bf16*)(ws + WS_WOUT), scr, r, lane, 0, CAT_PITCH, -768); }
                       else transpose_item<false>(wout, DMIX, DM, (bf16*)(ws + WS_WOUT), scr, r, lane); continue; } r -= I_2;
        if (r < I_3) { if (!((UP_INT8 >> L) & 1)) transpose_item<false>(wup, DM, DFF, (bf16*)(ws + WS_WUP), scr, r, lane); continue; } r -= I_3;
        if (r < I_4) { transpose_item<false>(wdn, DFF, DM, (bf16*)(ws + WS_WDN), scr, r, lane); continue; } r -= I_4;
        if (r < I_5) { if (GATE_INT8) {} else if (GATE_FP8) transpose_item_fp8(wgt, DM, DM, ws + WS_WGT, scr, r, lane); else transpose_item<false>(wgt, DM, DM, (bf16*)(ws + WS_WGT), scr, r, lane); continue; } r -= I_5;
        transpose_item<false>(wpe, DPLE, DM, (bf16*)(ws + WS_WPE), scr, r, lane);
      } }
    const size_t gt = (size_t)BID * 512 + tid, GT = (size_t)GSZ * 512;
    if (L == 0) {
        { u32x4* z = QKV_FP8 ? (u32x4*)((bf16*)(ws + WS_WIN + WINB_OFF) + (size_t)(D_IN - NQKV) * DM) : (u32x4*)((bf16*)(ws + WS_WIN) + (size_t)D_IN * DM); const size_t n16 = (size_t)(NU - D_IN) * DM / 8; for (size_t i = gt; i < n16; i += GT) z[i] = (u32x4){0u, 0u, 0u, 0u}; }
        { const f32x4* x4 = (const f32x4*)inp(lds, I_X); u32x2* o = (u32x2*)(ws + WS_XB); unsigned* o8 = (unsigned*)(ws + WS_X8); for (size_t i = gt; i < (size_t)M * DM / 4; i += GT) { const f32x4 v = x4[i]; u32x2 w; w.x = pk2(v[0], v[1]); w.y = pk2(v[2], v[3]); o[i] = w; if (QKV_FP8) o8[i] = pk4_fp8(v[0], v[1], v[2], v[3]); } }
        { const f32x4* p4 = (const f32x4*)inp(lds, I_P); u32x2* o = (u32x2*)(ws + WS_PB); for (size_t i = gt; i < (size_t)DEPTH * M * DPLE / 4; i += GT) { const f32x4 v = p4[i]; u32x2 w; w.x = pk2(v[0], v[1]); w.y = pk2(v[2], v[3]); o[i] = w; } }
        { float* rt = (float*)(ws + WS_ROPE); for (size_t i = gt; i < (size_t)SEQ * 16; i += GT) { const int pos = (int)(i >> 4), k = (int)(i & 15);
            const float inv = exp2f(-(float)k * (18.931568569324174f / 16.0f)); const float ang = (float)pos * inv; rt[pos * 32 + k] = cosf(ang); rt[pos * 32 + 16 + k] = sinf(ang); } }
    }
}

PHASE_FN phase_rope(unsigned char* wsarg, LAS unsigned char* lds) {
    int BID = blockIdx.x, GSZ = ld_grid(); OPAQUE_S(BID); OPAQUE_S(GSZ); OPAQUE_S(lds);
    unsigned char* const WSQ = ld_ws(wsarg);
    bf16* U = (bf16*)(WSQ + WS_BIG); const float* rt = (const float*)(WSQ + WS_ROPE);
    int tid_o = threadIdx.x; OPAQUE_V(tid_o);
    const size_t gt = (size_t)BID * 512 + tid_o, GT = (size_t)GSZ * 512;
    for (size_t i = gt; i < (size_t)M * 24; i += GT) {
        const int m = (int)(i / 24), hh = (int)(i % 24), pos = m % SEQ;
        bf16* p = U + (size_t)m * NU + (hh < 12 ? UQ + hh * 128 : UK + (hh - 12) * 128);
        const float* cs = rt + pos * 32;
#pragma unroll
        for (int h2 = 0; h2 < 2; ++h2) { u32x4 a = *(u32x4*)(p + 8 * h2), bq = *(u32x4*)(p + 16 + 8 * h2);
#pragma unroll
            for (int w = 0; w < 4; ++w) { const int k = h2 * 8 + w * 2; const unsigned xa = a[w], xb = bq[w];
                const float x1l = __uint_as_float(xa << 16), x1h = __uint_as_float(xa & 0xffff0000u), x2l = __uint_as_float(xb << 16), x2h = __uint_as_float(xb & 0xffff0000u);
                const float c0 = cs[k], c1 = cs[k + 1], s0 = cs[16 + k], s1 = cs[16 + k + 1];
                a[w] = pk2(x1l * c0 - x2l * s0, x1h * c1 - x2h * s1); bq[w] = pk2(x2l * c0 + x1l * s0, x2h * c1 + x1h * s1); }
            *(u32x4*)(p + 8 * h2) = a; *(u32x4*)(p + 16 + 8 * h2) = bq; }
    }
}

PHASE_FN phase_attn_naive(unsigned char* wsarg, LAS unsigned char* lds) {
    int BID = blockIdx.x, GSZ = ld_grid(); OPAQUE_S(BID); OPAQUE_S(GSZ); OPAQUE_S(lds);
    unsigned char* const WSQ = ld_ws(wsarg);
    int tid_o = threadIdx.x; OPAQUE_V(tid_o);
    const int tid = tid_o, lane = tid & 63, wave = __builtin_amdgcn_readfirstlane(tid >> 6);
    LAS float* qs = (LAS float*)(lds + wave * 2048); LAS float* ps = qs + 128;
    const bf16* U = (const bf16*)(WSQ + WS_BIG); bf16* AO = (bf16*)(WSQ + (ATT_FP8 ? WS_ATT : WS_CAT)); float* LSE = (float*)(WSQ + WS_LSE);
    const int gw = BID * 8 + wave, NGW = GSZ * 8;
    for (int it = gw; it < M * 12; it += NGW) {
        const int head = it % 12, m = it / 12, t = m % SEQ, g = head >> 2, d = g == 0 ? 1 : (g == 1 ? 4 : 16);
        { const unsigned qq = *(const unsigned*)(U + (size_t)m * NU + UQ + head * 128 + 2 * lane); qs[2 * lane] = __uint_as_float(qq << 16) * ATT_SCALE; qs[2 * lane + 1] = __uint_as_float(qq & 0xffff0000u) * ATT_SCALE; }
        WAVE_SYNC();
        float sc[3];
#pragma unroll
        for (int r = 0; r < 3; ++r) { const int j = lane + 64 * r; const bool ok = (j <= 128) && (t - j * d >= 0); float s = -INFINITY;
            if (ok) { const bf16* kr = U + (size_t)(m - j * d) * NU + UK + head * 128; s = 0.f;
                for (int c = 0; c < 16; ++c) { const u32x4 kv = *(const u32x4*)(kr + 8 * c);
#pragma unroll
                    for (int w = 0; w < 4; ++w) s += qs[8 * c + 2 * w] * __uint_as_float(kv[w] << 16) + qs[8 * c + 2 * w + 1] * __uint_as_float(kv[w] & 0xffff0000u); } }
            sc[r] = s; }
        const float mx = wave_max(fmaxf(fmaxf(sc[0], sc[1]), sc[2]), lane);
        float psum = 0.f;
#pragma unroll
        for (int r = 0; r < 3; ++r) { const int j = lane + 64 * r; const float p = (sc[r] == -INFINITY) ? 0.f : __expf(sc[r] - mx); psum += p; if (j <= 128) ps[j] = p; }
        const float den = wave_sum(psum, lane);
        WAVE_SYNC();
        float a0 = 0.f, a1 = 0.f;
        for (int j = 0; j <= 128; ++j) { if (t - j * d < 0) break; const float pj = ps[j]; const unsigned vv = *(const unsigned*)(U + (size_t)(m - j * d) * NU + UV + head * 128 + 2 * lane);
            a0 += pj * __uint_as_float(vv << 16); a1 += pj * __uint_as_float(vv & 0xffff0000u); }
        const float inv = 1.f / den;
        *(unsigned*)(AO + (size_t)m * ATT_PITCH + head * 128 + 2 * lane) = pk2(a0 * inv, a1 * inv);
        if (lane == 0) LSE[(size_t)m * 12 + head] = mx + __logf(den);
        WAVE_SYNC();
    }
}

constexpr int AK_STRIDE = 136, AV_STRIDE = 264;
constexpr int AL_K = 0, AL_V = 256 * AK_STRIDE * 2, AL_END = AL_V + 128 * AV_STRIDE * 2;
PHASE_FN phase_attn_mfma(unsigned char* wsarg, LAS unsigned char* lds) {
    int BID = blockIdx.x, GSZ = ld_grid(); OPAQUE_S(BID); OPAQUE_S(GSZ); OPAQUE_S(lds);
    unsigned char* const WSQ = ld_ws(wsarg);
    int tid_o = threadIdx.x; OPAQUE_V(tid_o);
    const int tid = tid_o, lane = tid & 63, wave = tid >> 6, li = lane & 15, q = lane >> 4;
    const bf16* U = (const bf16*)(WSQ + WS_BIG); bf16* AO = (bf16*)(WSQ + (ATT_FP8 ? WS_ATT : WS_CAT)); float* LSE = (float*)(WSQ + WS_LSE);
    LAS bf16* KS = (LAS bf16*)(lds + AL_K); LAS bf16* VT = (LAS bf16*)(lds + AL_V);
    constexpr int UPH = SEQ / 128, NUNITS = BATCH * 12 * UPH;
    const int per = (NUNITS + (int)GSZ - 1) / (int)GSZ;
    const int u_lo = (int)BID * per, u_hi = (u_lo + per < NUNITS) ? u_lo + per : NUNITS;
    for (int uid = u_lo; uid < u_hi; ++uid) {
        const int idx = uid % UPH, bh = uid / UPH, head = bh % 12, b = bh / 12, g = head >> 2, dsh = 2 * g, d = 1 << dsh;
        const int nblk = UPH >> dsh, r = idx / nblk, n = idx % nblk, u0 = 128 * n;
        const size_t rowbase = (size_t)b * SEQ + r;
#pragma unroll
        for (int i = 0; i < 4; ++i) { const int pidx = tid + 512 * i, rp = pidx >> 4, ch = pidx & 15, k0 = 2 * rp;
            u32x4 ka = {0u, 0u, 0u, 0u}, kb = ka, va = ka, vb = ka;
            if (n > 0 || k0 >= 128) { const bf16* r0 = U + (rowbase + (size_t)(u0 - 128 + k0) * d) * NU + head * 128 + 8 * ch; const bf16* r1 = r0 + (size_t)d * NU;
                ka = *(const u32x4*)(r0 + UK); kb = *(const u32x4*)(r1 + UK); va = *(const u32x4*)(r0 + UV); vb = *(const u32x4*)(r1 + UV); }
            *(LAS u32x4*)(KS + k0 * AK_STRIDE + 8 * ch) = ka; *(LAS u32x4*)(KS + (k0 + 1) * AK_STRIDE + 8 * ch) = kb;
#pragma unroll
            for (int w = 0; w < 4; ++w) {
                *(LAS unsigned*)(VT + (8 * ch + 2 * w) * AV_STRIDE + k0) = (va[w] & 0xffffu) | (vb[w] << 16);
                *(LAS unsigned*)(VT + (8 * ch + 2 * w + 1) * AV_STRIDE + k0) = (va[w] >> 16) | (vb[w] & 0xffff0000u); } }
        int qi_o = 16 * wave + li; OPAQUE_V(qi_o);
        const int qi = qi_o; const size_t qrow = rowbase + (size_t)(u0 + qi) * d;
        bf16x8 qf[4];
#pragma unroll
        for (int ks = 0; ks < 4; ++ks) qf[ks] = *(const bf16x8*)(U + qrow * NU + UQ + head * 128 + 32 * ks + 8 * q);
        __syncthreads();
        f32x4 st[10]; float mx = -INFINITY; const int lb = (n > 0) ? qi : max(qi, 128);
#pragma unroll
        for (int t = 0; t < 9; ++t) { const int kt = wave + t; f32x4 a = {0.f, 0.f, 0.f, 0.f};
#pragma unroll
            for (int ks = 0; ks < 4; ++ks) { const bf16x8 kf = *(const LAS bf16x8*)(KS + (16 * kt + li) * AK_STRIDE + 32 * ks + 8 * q); a = __builtin_amdgcn_mfma_f32_16x16x32_bf16(kf, qf[ks], a, 0, 0, 0); }
#pragma unroll
            for (int e = 0; e < 4; ++e) { const int ki = 16 * kt + 4 * q + e;
                const int m01 = min(max(ki - lb + 1, 0), 1) * min(max(qi + 129 - ki, 0), 1); a[e] = fmaf(a[e], ATT_SCALE, (float)(m01 - 1) * 1e30f); mx = fmaxf(mx, a[e]); }
            st[t] = a; }
        st[9] = (f32x4){0.f, 0.f, 0.f, 0.f};
        mx = fmaxf(mx, shfl_f(mx, lane ^ 16)); mx = fmaxf(mx, shfl_f(mx, lane ^ 32));
        float den = 0.f;
#pragma unroll
        for (int t = 0; t < 9; ++t)
#pragma unroll
            for (int e = 0; e < 4; ++e) { const float p = __expf(st[t][e] - mx); st[t][e] = p; den += p; }
        den += shfl_f(den, lane ^ 16); den += shfl_f(den, lane ^ 32);
        f32x4 oacc[8];
#pragma unroll
        for (int dt = 0; dt < 8; ++dt) oacc[dt] = (f32x4){0.f, 0.f, 0.f, 0.f};
#pragma unroll
        for (int a = 0; a < 5; ++a) { u32x4 pw; pw.x = pg8::cvt_pk_bf16(st[2 * a][0], st[2 * a][1]); pw.y = pg8::cvt_pk_bf16(st[2 * a][2], st[2 * a][3]); pw.z = pg8::cvt_pk_bf16(st[2 * a + 1][0], st[2 * a + 1][1]); pw.w = pg8::cvt_pk_bf16(st[2 * a + 1][2], st[2 * a + 1][3]);
            const bf16x8 pf = __builtin_bit_cast(bf16x8, pw);
            const int ke = 16 * (wave + 2 * a) + 4 * q, ko = (a < 4) ? ke + 16 : ke;
#pragma unroll
            for (int dt = 0; dt < 8; ++dt) { const s16x4 lo = *(const LAS s16x4*)(VT + (16 * dt + li) * AV_STRIDE + ke), hi = *(const LAS s16x4*)(VT + (16 * dt + li) * AV_STRIDE + ko);
                const bf16x8 vf = __builtin_shufflevector(lo, hi, 0, 1, 2, 3, 4, 5, 6, 7); oacc[dt] = __builtin_amdgcn_mfma_f32_16x16x32_bf16(vf, pf, oacc[dt], 0, 0, 0); } }
        const float inv = rcp_f(den);
        bf16* orow = AO + qrow * ATT_PITCH + head * 128 + 4 * q;
#pragma unroll
        for (int dt = 0; dt < 8; ++dt) { u32x2 w; w.x = pg8::cvt_pk_bf16(oacc[dt][0] * inv, oacc[dt][1] * inv); w.y = pg8::cvt_pk_bf16(oacc[dt][2] * inv, oacc[dt][3] * inv); *(u32x2*)(orow + 16 * dt) = w; }
        if (q == 0) LSE[qrow * 12 + head] = mx + __logf(den);
        __syncthreads();
    }
}
PHASE_FN phase_attn_mix(unsigned char* wsarg) {
    int BID = blockIdx.x, GSZ = ld_grid(); OPAQUE_S(BID); OPAQUE_S(GSZ);
    unsigned char* const WSQ = ld_ws(wsarg);
    bf16* CAT = (bf16*)(WSQ + WS_CAT); const float* LSE = (const float*)(WSQ + WS_LSE);
    int tid_o = threadIdx.x; OPAQUE_V(tid_o);
    const size_t gt = (size_t)BID * 512 + tid_o, GT = (size_t)GSZ * 512;
    for (size_t i = gt; i < (size_t)M * 64; i += GT) {
        const int m = (int)(i >> 6), h = (int)((i >> 4) & 3), ch = (int)(i & 15);
        const float l0 = LSE[(size_t)m * 12 + h], l1 = LSE[(size_t)m * 12 + 4 + h], l2 = LSE[(size_t)m * 12 + 8 + h];
        const float mx = fmaxf(l0, fmaxf(l1, l2)); const float e0 = __expf(l0 - mx), e1 = __expf(l1 - mx), e2 = __expf(l2 - mx); const float inv = rcp_f(e0 + e1 + e2);
#pragma unroll
        for (int g = 0; g < 3; ++g) { const float wg_ = (g == 0 ? e0 : (g == 1 ? e1 : e2)) * inv;
            if (ATT_FP8) { const u32x4 v = *(const u32x4*)((const bf16*)(WSQ + WS_ATT) + (size_t)m * 1536 + (g * 4 + h) * 128 + ch * 8); const float w16 = wg_ * 16.f; u32x2 o8;
                o8.x = pk4_fp8(__uint_as_float(v[0] << 16) * w16, __uint_as_float(v[0] & 0xffff0000u) * w16, __uint_as_float(v[1] << 16) * w16, __uint_as_float(v[1] & 0xffff0000u) * w16);
                o8.y = pk4_fp8(__uint_as_float(v[2] << 16) * w16, __uint_as_float(v[2] & 0xffff0000u) * w16, __uint_as_float(v[3] << 16) * w16, __uint_as_float(v[3] & 0xffff0000u) * w16);
                *(u32x2*)((unsigned char*)CAT + (size_t)m * (CAT_PITCH * 2) + (g * 4 + h) * 128 + ch * 8) = o8; }
            else { u32x4* p = (u32x4*)(CAT + (size_t)m * CAT_PITCH + (g * 4 + h) * 128 + ch * 8); u32x4 v = *p;
#pragma unroll
                for (int k = 0; k < 4; ++k) v[k] = pk2(__uint_as_float(v[k] << 16) * wg_, __uint_as_float(v[k] & 0xffff0000u) * wg_);
                *p = v; } }
    }
}

PHASE_FN phase_shortconv(unsigned char* wsarg, int L, LAS unsigned char* lds) {
    int BID = blockIdx.x, GSZ = ld_grid(); OPAQUE_S(BID); OPAQUE_S(GSZ); OPAQUE_S(lds);
    unsigned char* const WSQ = ld_ws(wsarg);
    const bf16* U = (const bf16*)(WSQ + WS_BIG); bf16* CAT = (bf16*)(WSQ + WS_CAT); const float* w = inp(lds, I_SCW) + (size_t)L * 3 * 1024;
    int tid_o = threadIdx.x; OPAQUE_V(tid_o);
    const size_t gt = (size_t)BID * 512 + tid_o, GT = (size_t)GSZ * 512;
    for (size_t i = gt; i < (size_t)M * 128; i += GT) {
        const int m = (int)(i >> 7), c0 = (int)(i & 127) * 8, t = m % SEQ;
        float acc[8];
#pragma unroll
        for (int e = 0; e < 8; ++e) acc[e] = 0.f;
#pragma unroll
        for (int k = 0; k < 3; ++k) { if (t - 2 + k < 0) continue; const bf16* r = U + (size_t)(m - 2 + k) * NU;
            const u32x4 cw = *(const u32x4*)(r + USC + c0), hw = *(const u32x4*)(r + USH + c0);
#pragma unroll
            for (int q = 0; q < 4; ++q) { acc[2 * q] += w[k * 1024 + c0 + 2 * q] * (__uint_as_float(cw[q] << 16) * __uint_as_float(hw[q] << 16));
                acc[2 * q + 1] += w[k * 1024 + c0 + 2 * q + 1] * (__uint_as_float(cw[q] & 0xffff0000u) * __uint_as_float(hw[q] & 0xffff0000u)); } }
        const u32x4 bw = *(const u32x4*)(U + (size_t)m * NU + USB + c0); u32x4 ow;
#pragma unroll
        for (int q = 0; q < 4; ++q) ow[q] = pk2(acc[2 * q] * __uint_as_float(bw[q] << 16), acc[2 * q + 1] * __uint_as_float(bw[q] & 0xffff0000u));
        *(u32x4*)(CAT + (size_t)m * CAT_PITCH + CAT_SC + c0) = ow;
    }
}

PHASE_FN phase_conv(unsigned char* wsarg, int L, LAS unsigned char* lds) {
    unsigned char* const WSQ = ld_ws(wsarg);
    int BID = blockIdx.x, GSZ = ld_grid(); OPAQUE_S(BID); OPAQUE_S(GSZ);
    int tid_o = threadIdx.x; OPAQUE_V(tid_o);
    const bf16* U = (const bf16*)(WSQ + WS_BIG); bf16* XC = (bf16*)(WSQ + WS_XC);
    const float* cw = inp(lds, I_CW) + (size_t)L * 4 * 2560; const float* cbv = inp(lds, I_CB) + (size_t)L * 2560;
    const size_t gt = (size_t)BID * 512 + tid_o, GT = (size_t)GSZ * 512;
    for (size_t i = gt; i < (size_t)(M / 16) * 320; i += GT) {
        const int rb = (int)(i / 320), c0 = (int)(i % 320) * 8, m0 = rb * 16, t0 = m0 % SEQ;
        float w[4][8], bs[8];
#pragma unroll
        for (int k = 0; k < 4; ++k) { const f32x4 a0 = *(const f32x4*)(cw + k * 2560 + c0), a1 = *(const f32x4*)(cw + k * 2560 + c0 + 4);
#pragma unroll
            for (int e = 0; e < 4; ++e) { w[k][e] = a0[e]; w[k][4 + e] = a1[e]; } }
        { const f32x4 a0 = *(const f32x4*)(cbv + c0), a1 = *(const f32x4*)(cbv + c0 + 4);
#pragma unroll
          for (int e = 0; e < 4; ++e) { bs[e] = a0[e]; bs[4 + e] = a1[e]; } }
        u32x4 raw[19];
#pragma unroll
        for (int r = 0; r < 19; ++r) raw[r] = (r >= 3 || t0 > 0) ? *(const u32x4*)(U + (size_t)(m0 + r - 3) * NU + UX + c0) : (u32x4){0u, 0u, 0u, 0u};
#pragma unroll
        for (int r = 0; r < 16; ++r) { u32x4 o;
#pragma unroll
            for (int e2 = 0; e2 < 4; ++e2) { float lo = bs[2 * e2], hi = bs[2 * e2 + 1];
#pragma unroll
                for (int k = 0; k < 4; ++k) { const unsigned x = raw[r + k][e2]; lo += w[k][2 * e2] * __uint_as_float(x << 16); hi += w[k][2 * e2 + 1] * __uint_as_float(x & 0xffff0000u); }
                o[e2] = pk2(silu_f(lo), silu_f(hi)); }
            *(u32x4*)(XC + (size_t)(m0 + r) * 2560 + c0) = o; }
    }
}
constexpr int BI_STRIDE = 136, XI_STRIDE = 72;
constexpr int SL_DT = 0, SL_ACS = 4096, SL_BI = 8192, SL_CI = SL_BI + 128 * BI_STRIDE * 2, SL_XI = SL_CI + 128 * BI_STRIDE * 2, SL_PV = SL_XI + 128 * XI_STRIDE * 2, SL_END = SL_PV + 64 * 136 * 2;
constexpr int SL_XI2 = SL_CI;
static_assert(SL_END <= RING_BYTES, "SSD LDS");
DI void ssd_dt_scan(int L, const bf16* U, int m0, int g, LAS unsigned char* lds, int wave, int lane) {
    LAS float* DT = (LAS float*)(lds + SL_DT); LAS float* ACS = (LAS float*)(lds + SL_ACS);
    if (wave < 6) { const int h = g * 6 + wave; const float bias = inp(lds, I_DTB)[L * 24 + h], a = -__expf(inp(lds, I_ALOG)[L * 24 + h]);
        const float d0 = softplus_f(bf2f(U[(size_t)(m0 + lane) * NU + UDT + h]) + bias), d1 = softplus_f(bf2f(U[(size_t)(m0 + 64 + lane) * NU + UDT + h]) + bias);
        float c0 = d0 * a, c1 = d1 * a;
#pragma unroll
        for (int o = 1; o < 64; o <<= 1) { const int src = lane >= o ? lane - o : lane; const float u0 = shfl_f(c0, src), u1 = shfl_f(c1, src); if (lane >= o) { c0 += u0; c1 += u1; } }
        c1 += shfl_f(c0, 63);
        DT[lane * 8 + wave] = d0; DT[(64 + lane) * 8 + wave] = d1; ACS[lane * 8 + wave] = c0; ACS[(64 + lane) * 8 + wave] = c1; }
}
PHASE_FN phase_ssd_states(unsigned char* wsarg, int L, LAS unsigned char* lds) {
    unsigned char* const WSQ = ld_ws(wsarg);
    int BID = blockIdx.x, GSZ = ld_grid(); OPAQUE_S(BID); OPAQUE_S(GSZ); OPAQUE_S(lds);
    int tid_o = threadIdx.x; OPAQUE_V(tid_o);
    const int tid = tid_o, lane = tid & 63, wave = tid >> 6, li = lane & 15, q = lane >> 4;
    const bf16* U = (const bf16*)(WSQ + WS_BIG); const bf16* XC = (const bf16*)(WSQ + WS_XC); float* ST = (float*)(WSQ + WS_BIG + BIG_U_BYTES); float* CD = (float*)(WSQ + WS_CD);
    LAS float* DT = (LAS float*)(lds + SL_DT); LAS float* ACS = (LAS float*)(lds + SL_ACS); LAS bf16* BI = (LAS bf16*)(lds + SL_BI);
    for (int it = BID; it < BATCH * NCH * 4; it += GSZ) {
        const int g = it & 3, c = (it >> 2) % NCH, b = (it >> 2) / NCH, m0 = b * SEQ + c * 128;
        ssd_dt_scan(L, U, m0, g, lds, wave, lane);
#pragma unroll
        for (int i = 0; i < 4; ++i) { const int ci = tid + 512 * i, row = ci >> 4, ch = ci & 15; *(LAS u32x4*)(BI + row * BI_STRIDE + 8 * ch) = *(const u32x4*)(XC + (size_t)(m0 + row) * 2560 + 1536 + g * 128 + 8 * ch); }
        __syncthreads();
        bf16x8 bfr[4];
#pragma unroll
        for (int ks = 0; ks < 4; ++ks) { const LAS bf16* p0 = BI + (32 * ks + 8 * q + (li >> 2)) * BI_STRIDE + 16 * wave + 4 * (li & 3); bfr[ks] = tr_read2(p0, p0 + 4 * BI_STRIDE); }
        u32x4 xr[2];
#pragma unroll
        for (int i = 0; i < 2; ++i) { const int ci = tid + 512 * i; xr[i] = *(const u32x4*)(XC + (size_t)(m0 + (ci >> 3)) * 2560 + (g * 6) * 64 + 8 * (ci & 7)); }
#pragma unroll 1
        for (int j = 0; j < 6; ++j) { const int h = g * 6 + j; LAS bf16* XI = (LAS bf16*)(lds + ((j & 1) ? SL_XI2 : SL_XI));
            { const float alast = ACS[127 * 8 + j];
#pragma unroll
              for (int i = 0; i < 2; ++i) { const int ci = tid + 512 * i, row = ci >> 3, ch = ci & 7;
                  const float wgt = DT[row * 8 + j] * __expf(alast - ACS[row * 8 + j]); u32x4 o;
#pragma unroll
                  for (int e = 0; e < 4; ++e) o[e] = pk2(__uint_as_float(xr[i][e] << 16) * wgt, __uint_as_float(xr[i][e] & 0xffff0000u) * wgt);
                  *(LAS u32x4*)(XI + row * XI_STRIDE + 8 * ch) = o; } }
            __syncthreads();
            if (j < 5) {
#pragma unroll
                for (int i = 0; i < 2; ++i) { const int ci = tid + 512 * i; xr[i] = *(const u32x4*)(XC + (size_t)(m0 + (ci >> 3)) * 2560 + (h + 1) * 64 + 8 * (ci & 7)); } }
            f32x4 acc[4];
#pragma unroll
            for (int pb = 0; pb < 4; ++pb) acc[pb] = (f32x4){0.f, 0.f, 0.f, 0.f};
#pragma unroll
            for (int ks = 0; ks < 4; ++ks)
#pragma unroll
                for (int pb = 0; pb < 4; ++pb) { const LAS bf16* p0 = XI + (32 * ks + 8 * q + (li >> 2)) * XI_STRIDE + 16 * pb + 4 * (li & 3); const bf16x8 afr = tr_read2(p0, p0 + 4 * XI_STRIDE);
                    acc[pb] = __builtin_amdgcn_mfma_f32_16x16x32_bf16(afr, bfr[ks], acc[pb], 0, 0, 0); }
            float* st = ST + ((size_t)((b * NCH + c) * 24 + h) * 64) * 128;
#pragma unroll
            for (int pb = 0; pb < 4; ++pb)
#pragma unroll
                for (int r = 0; r < 4; ++r) st[(size_t)(16 * pb + 4 * q + r) * 128 + 16 * wave + li] = acc[pb][r];
            if (tid == 0) CD[(b * NCH + c) * 24 + h] = __expf(ACS[127 * 8 + j]);
        }
        __syncthreads();
    }
}
PHASE_FN phase_ssd_scan(unsigned char* wsarg, bool dry = false) {
    unsigned char* const WSQ = ld_ws(wsarg);
    int BID = blockIdx.x, GSZ = ld_grid(); OPAQUE_S(BID); OPAQUE_S(GSZ);
    const float* ST = (const float*)(WSQ + WS_BIG + BIG_U_BYTES); const float* CD = (const float*)(WSQ + WS_CD); bf16* SO = dry ? (bf16*)(WSQ + WS_XF) : (bf16*)(WSQ + WS_PVB);
    int tid_o = threadIdx.x; OPAQUE_V(tid_o);
    const size_t gt = (size_t)BID * 512 + tid_o, GT = (size_t)GSZ * 512;
    static_assert(NCH % 8 == 0, "scan batch");
    for (size_t e = gt; e < (size_t)BATCH * 24 * 2048; e += GT) {
        const int b = (int)(e / (24 * 2048)), rem4 = (int)(e % (24 * 2048)), h = rem4 >> 11;
        f32x4 hs = {0.f, 0.f, 0.f, 0.f};
#pragma unroll 1
        for (int c0 = 0; c0 < NCH; c0 += 8) { f32x4 v[8]; float cd[8];
#pragma unroll
            for (int k = 0; k < 8; ++k) { v[k] = *(const f32x4*)(ST + ((size_t)(b * NCH + c0 + k) * 24 * 2048 + rem4) * 4); cd[k] = CD[(b * NCH + c0 + k) * 24 + h]; }
#pragma unroll
            for (int k = 0; k < 8; ++k) { u32x2 w; w.x = pk2(hs[0], hs[1]); w.y = pk2(hs[2], hs[3]); *(u32x2*)(SO + ((size_t)(b * NCH + c0 + k) * 24 * 2048 + rem4) * 4) = w; hs = hs * cd[k] + v[k]; } }
    }
}
PHASE_FN phase_ssd_out(unsigned char* wsarg, int L, LAS unsigned char* lds) {
    int BID = blockIdx.x, GSZ = ld_grid(); OPAQUE_S(BID); OPAQUE_S(GSZ); OPAQUE_S(lds);
    unsigned char* const WSQ = ld_ws(wsarg);
    int tid_o = threadIdx.x; OPAQUE_V(tid_o);
    const int tid = tid_o, lane = tid & 63, wave = tid >> 6, li = lane & 15, q = lane >> 4;
    const bf16* U = (const bf16*)(WSQ + WS_BIG); const bf16* XC = (const bf16*)(WSQ + WS_XC); const bf16* PVB = (const bf16*)(WSQ + WS_PVB); bf16* CAT = (bf16*)(WSQ + WS_CAT);
    const float* nw = inp(lds, I_NW) + (size_t)L * 1536;
    LAS float* DT = (LAS float*)(lds + SL_DT); LAS float* ACS = (LAS float*)(lds + SL_ACS); LAS bf16* CC = (LAS bf16*)(lds + SL_CI); LAS bf16* BC = (LAS bf16*)(lds + SL_BI);
    LAS bf16* XI = (LAS bf16*)(lds + SL_XI); LAS bf16* PV = (LAS bf16*)(lds + SL_PV);
    for (int it = BID; it < BATCH * NCH * 4; it += GSZ) {
        const int g = it & 3, c = (it >> 2) % NCH, b = (it >> 2) / NCH, m0 = b * SEQ + c * 128;
        u32x4 xr[2], pr[2];
#pragma unroll
        for (int i = 0; i < 2; ++i) { const int ci = tid + 512 * i; xr[i] = *(const u32x4*)(XC + (size_t)(m0 + (ci >> 3)) * 2560 + (g * 6) * 64 + 8 * (ci & 7)); pr[i] = *(const u32x4*)(PVB + (size_t)((b * NCH + c) * 24 + g * 6) * 8192 + 8 * ci); }
        ssd_dt_scan(L, U, m0, g, lds, wave, lane);
#pragma unroll
        for (int i = 0; i < 4; ++i) { const int ci = tid + 512 * i, row = ci >> 4, ch = ci & 15; const bf16* src = XC + (size_t)(m0 + row) * 2560 + 1536 + g * 128 + 8 * ch;
            *(LAS u32x4*)(BC + row * BI_STRIDE + 8 * ch) = *(const u32x4*)src; *(LAS u32x4*)(CC + row * BI_STRIDE + 8 * ch) = *(const u32x4*)(src + 512); }
        __syncthreads();
        float* YS = (float*)(WSQ + WS_YS) + (size_t)BID * (6 * 16 * 512) + tid; float ssq[4] = {0.f, 0.f, 0.f, 0.f};
#pragma unroll 1
        for (int j = 0; j < 6; ++j) { const int h = g * 6 + j;
#pragma unroll
            for (int i = 0; i < 2; ++i) { const int ci = tid + 512 * i, row = ci >> 3, ch = ci & 7; const float wgt = DT[row * 8 + j]; u32x4 o;
#pragma unroll
                for (int e = 0; e < 4; ++e) o[e] = pk2(__uint_as_float(xr[i][e] << 16) * wgt, __uint_as_float(xr[i][e] & 0xffff0000u) * wgt);
                *(LAS u32x4*)(XI + row * XI_STRIDE + 8 * ch) = o; *(LAS u32x4*)(PV + (ci >> 4) * 136 + 8 * (ci & 15)) = pr[i]; }
            __syncthreads();
            if (j < 5) {
#pragma unroll
                for (int i = 0; i < 2; ++i) { const int ci = tid + 512 * i; xr[i] = *(const u32x4*)(XC + (size_t)(m0 + (ci >> 3)) * 2560 + (h + 1) * 64 + 8 * (ci & 7)); pr[i] = *(const u32x4*)(PVB + (size_t)((b * NCH + c) * 24 + h + 1) * 8192 + 8 * ci); } }
            unsigned short zr[16];
#pragma unroll
            for (int pb = 0; pb < 4; ++pb)
#pragma unroll
                for (int r = 0; r < 4; ++r) zr[pb * 4 + r] = U[(size_t)(m0 + 16 * wave + 4 * q + r) * NU + UZ + h * 64 + 16 * pb + li];
            f32x4 acc[4];
#pragma unroll
            for (int pb = 0; pb < 4; ++pb) acc[pb] = (f32x4){0.f, 0.f, 0.f, 0.f};
#pragma unroll
            for (int ks = 0; ks < 4; ++ks) { const bf16x8 afr = *(const LAS bf16x8*)(CC + (16 * wave + li) * 136 + 32 * ks + 8 * q);
#pragma unroll
                for (int pb = 0; pb < 4; ++pb) { const bf16x8 bfr = *(const LAS bf16x8*)(PV + (16 * pb + li) * 136 + 32 * ks + 8 * q); acc[pb] = __builtin_amdgcn_mfma_f32_16x16x32_bf16(afr, bfr, acc[pb], 0, 0, 0); } }
#pragma unroll
            for (int r = 0; r < 4; ++r) { const float e = __expf(ACS[(16 * wave + 4 * q + r) * 8 + j]);
#pragma unroll
                for (int pb = 0; pb < 4; ++pb) acc[pb][r] *= e; }
            int l_o = 16 * wave + li; OPAQUE_V(l_o); const int l_a = l_o; const float acs_l = ACS[l_a * 8 + j];
            const float ddt = inp(lds, I_SD)[L * 24 + h] * rcp_f(DT[l_a * 8 + j]);
#pragma unroll
            for (int ks2 = 0; ks2 < 4; ++ks2) {
                if (2 * ks2 <= wave) {
                    f32x4 c0 = {0.f, 0.f, 0.f, 0.f}, c1 = {0.f, 0.f, 0.f, 0.f};
#pragma unroll
                    for (int ks = 0; ks < 4; ++ks) { const bf16x8 bfr = *(const LAS bf16x8*)(CC + (16 * wave + li) * 136 + 32 * ks + 8 * q);
                        const bf16x8 a0 = *(const LAS bf16x8*)(BC + (32 * ks2 + li) * 136 + 32 * ks + 8 * q), a1 = *(const LAS bf16x8*)(BC + (32 * ks2 + 16 + li) * 136 + 32 * ks + 8 * q);
                        c0 = __builtin_amdgcn_mfma_f32_16x16x32_bf16(a0, bfr, c0, 0, 0, 0); c1 = __builtin_amdgcn_mfma_f32_16x16x32_bf16(a1, bfr, c1, 0, 0, 0); }
                    bf16x8 afr;
#pragma unroll
                    for (int e = 0; e < 8; ++e) { const int s = 32 * ks2 + (e < 4 ? 4 * q + e : 16 + 4 * q + (e - 4)); const float cbv_ = e < 4 ? c0[e & 3] : c1[e & 3];
                        const float gv = cbv_ * __expf(fminf(acs_l - ACS[s * 8 + j], 0.f)) * (float)min(max(l_a - s + 1, 0), 1) + ddt * (float)(1 - min(abs(l_a - s), 1)); afr[e] = (short)f2bf(gv); }
#pragma unroll
                    for (int pb = 0; pb < 4; ++pb) { const LAS bf16* p0 = XI + (32 * ks2 + 4 * q + (li >> 2)) * XI_STRIDE + 16 * pb + 4 * (li & 3);
                        const bf16x8 bfr = tr_read2(p0, p0 + 16 * XI_STRIDE); acc[pb] = __builtin_amdgcn_mfma_f32_16x16x32_bf16(afr, bfr, acc[pb], 0, 0, 0); } } }
#pragma unroll
            for (int pb = 0; pb < 4; ++pb)
#pragma unroll
                for (int r = 0; r < 4; ++r) { const float y = acc[pb][r] * silu_f(bf2f(zr[pb * 4 + r]));
                    YS[(j * 16 + pb * 4 + r) * 512] = y; ssq[r] += y * y; }
            __syncthreads();
        }
#pragma unroll
        for (int r = 0; r < 4; ++r) { float s = ssq[r]; s += shfl_f(s, lane ^ 1); s += shfl_f(s, lane ^ 2); s += shfl_f(s, lane ^ 4); s += shfl_f(s, lane ^ 8); ssq[r] = __builtin_amdgcn_rsqf(s * (1.f / 384.f) + RMS_EPS); }
#pragma unroll 1
        for (int j = 0; j < 6; ++j)
#pragma unroll
            for (int pb = 0; pb < 4; ++pb)
#pragma unroll
                for (int r = 0; r < 4; ++r) { const int l = 16 * wave + 4 * q + r, ch = (g * 6 + j) * 64 + 16 * pb + li; CAT[(size_t)(m0 + l) * CAT_PITCH + CAT_SSM + ch] = f2bf(YS[(j * 16 + pb * 4 + r) * 512] * ssq[r] * nw[ch]); }
    }
}

static_assert(DM % 1024 == 0, "phase_resln: DM must be a multiple of 1024");
template <bool GATE> PHASE_FN phase_resln(unsigned char* wsarg, float* outarg, int L, int which, LAS unsigned char* lds, bool dry = false) {
    unsigned char* const WSQ = ld_ws(wsarg);
    const float* x32 = (L == 0 && which == 0) ? inp(lds, I_X) : nullptr;
    bf16* xb = (bf16*)(WSQ + WS_XB); const bf16* fb = (const bf16*)(WSQ + WS_XF); const bf16* emb = (const bf16*)(WSQ + WS_EMB);
    float* out32 = (L == DEPTH - 1 && which == 2 && !dry) ? ld_out(outarg) : nullptr; bf16* xo = dry ? (bf16*)(WSQ + WS_CAT) : xb;
    const float* gam = inp(lds, which == 0 ? I_L1G : (which == 1 ? I_L2G : I_L3G)) + (size_t)L * DM; const float* bet = inp(lds, which == 0 ? I_L1B : (which == 1 ? I_L2B : I_L3B)) + (size_t)L * DM;
    int BID = blockIdx.x, GSZ = ld_grid(); OPAQUE_S(BID); OPAQUE_S(GSZ);
    int tid_o = threadIdx.x; OPAQUE_V(tid_o);
    const int lane = tid_o & 63, wave = __builtin_amdgcn_readfirstlane(tid_o >> 6), pair = wave >> 1, half = wave & 1;
    const bool q8 = (((which == 0) && ((UP_INT8 >> L) & 1)) || ((which == 1) && GATE_INT8) || ((which == 2) && L + 1 < DEPTH && ((IN_INT8 >> (L + 1)) & 1))) && !dry;
    unsigned char* const q8dst = WSQ + (which == 2 ? WS_X8I : WS_X8);
    LAS float* RS = (LAS float*)lds; LAS float* RQ = RS + 8;
    constexpr int NJ = DM / 1024;
    const int niter = (M + 4 * GSZ - 1) / (4 * GSZ);
    for (int itn = 0; itn < niter; ++itn) {
        const int m = (itn * GSZ + BID) * 4 + pair; const bool live = m < M;
        float v[NJ][8]; float s = 0.f;
        if (live) {
#pragma unroll
        for (int j = 0; j < NJ; ++j) { const size_t o = (size_t)m * DM + (size_t)((half * NJ + j) * 64 + lane) * 8;
            float xv[8];
            if (x32) { const f32x4 a = NT_LOAD((const f32x4*)(x32 + o)), b = NT_LOAD((const f32x4*)(x32 + o + 4)); xv[0] = a[0]; xv[1] = a[1]; xv[2] = a[2]; xv[3] = a[3]; xv[4] = b[0]; xv[5] = b[1]; xv[6] = b[2]; xv[7] = b[3]; }
            else { const u32x4 a = NT_LOAD((const u32x4*)(xb + o));
#pragma unroll
                for (int k = 0; k < 4; ++k) { xv[2 * k] = __uint_as_float(a[k] << 16); xv[2 * k + 1] = __uint_as_float(a[k] & 0xffff0000u); } }
            const u32x4 f = NT_LOAD((const u32x4*)(fb + o)); float fv[8];
#pragma unroll
            for (int k = 0; k < 4; ++k) { fv[2 * k] = __uint_as_float(f[k] << 16); fv[2 * k + 1] = __uint_as_float(f[k] & 0xffff0000u); }
            if (GATE) { const u32x4 e = NT_LOAD((const u32x4*)(emb + o));
#pragma unroll
                for (int k = 0; k < 4; ++k) { fv[2 * k] = __uint_as_float(e[k] << 16) * rcp_f(1.f + __expf(-fv[2 * k])); fv[2 * k + 1] = __uint_as_float(e[k] & 0xffff0000u) * rcp_f(1.f + __expf(-fv[2 * k + 1])); } }
#pragma unroll
            for (int k = 0; k < 8; ++k) { v[j][k] = DN_ALPHA * xv[k] + fv[k]; s += v[j][k]; } }
        }
        s = wave_sum(s, lane); if (lane == 0) RS[pair * 2 + half] = s;
        __syncthreads();
        const float mean = (RS[pair * 2] + RS[pair * 2 + 1]) * (1.f / DM); float s2 = 0.f;
        if (live) {
#pragma unroll
        for (int j = 0; j < NJ; ++j)
#pragma unroll
            for (int k = 0; k < 8; ++k) { v[j][k] -= mean; s2 += v[j][k] * v[j][k]; }
        }
        s2 = wave_sum(s2, lane); if (lane == 0) RQ[pair * 2 + half] = s2;
        __syncthreads();
        const float rstd = __builtin_amdgcn_rsqf((RQ[pair * 2] + RQ[pair * 2 + 1]) * (1.f / DM) + LN_EPS);
        float ymax = 0.f;
        if (live) {
#pragma unroll
        for (int j = 0; j < NJ; ++j) { const size_t c = (size_t)((half * NJ + j) * 64 + lane) * 8, o = (size_t)m * DM + c;
            const f32x4 g0 = *(const f32x4*)(gam + c), g1 = *(const f32x4*)(gam + c + 4), b0 = *(const f32x4*)(bet + c), b1 = *(const f32x4*)(bet + c + 4);
            float y[8];
#pragma unroll
            for (int k = 0; k < 4; ++k) { y[k] = v[j][k] * rstd * g0[k] + b0[k]; y[4 + k] = v[j][4 + k] * rstd * g1[k] + b1[k]; }
            if (out32) { *(f32x4*)(out32 + o) = (f32x4){y[0], y[1], y[2], y[3]}; *(f32x4*)(out32 + o + 4) = (f32x4){y[4], y[5], y[6], y[7]}; }
            else { u32x4 w; w.x = pk2(y[0], y[1]); w.y = pk2(y[2], y[3]); w.z = pk2(y[4], y[5]); w.w = pk2(y[6], y[7]); *(u32x4*)(xo + o) = w;
                   if ((GATE_FP8 && !GATE_INT8 && which == 1) || (QKV_FP8 && which == 2)) { u32x2 w8; w8.x = pk4_fp8(y[0], y[1], y[2], y[3]); w8.y = pk4_fp8(y[4], y[5], y[6], y[7]); *(u32x2*)(WSQ + WS_X8 + o) = w8; } }
            if (q8) {
#pragma unroll
                for (int k = 0; k < 8; ++k) { v[j][k] = y[k]; ymax = fmaxf(ymax, fabsf(y[k])); } } }
        }
        if (q8) {
            ymax = wave_max(ymax, lane); if (lane == 0) RS[16 + pair * 2 + half] = ymax;
            __syncthreads();
            const float rmx = fmaxf(fmaxf(RS[16 + pair * 2], RS[16 + pair * 2 + 1]), 1e-30f), iv = 127.f / rmx;
            if (live) {
#pragma unroll
                for (int j = 0; j < NJ; ++j) { const size_t o = (size_t)m * DM + (size_t)((half * NJ + j) * 64 + lane) * 8; u32x2 w8;
                    unsigned a = 0, b = 0;
#pragma unroll
                    for (int k = 0; k < 4; ++k) { a |= ((unsigned)(__float2int_rn(v[j][k] * iv) & 0xff)) << (8 * k); b |= ((unsigned)(__float2int_rn(v[j][4 + k] * iv) & 0xff)) << (8 * k); }
                    w8.x = a; w8.y = b; *(u32x2*)(q8dst + o) = w8; }
                if (half == 0 && lane == 0) ((float*)(WSQ + WS_SA))[m] = rmx * (1.f / 127.f); }
        }
    }
    __syncthreads();
}

constexpr int PH_PER_LAYER = 13, N_PHASES = DEPTH * PH_PER_LAYER;
#ifndef REP_G3
#define REP_G3 1
#endif
#ifndef REP_G4
#define REP_G4 1
#endif
#ifndef REP_SCAN
#define REP_SCAN 1
#endif
#ifndef REP_MISC
#define REP_MISC 1
#endif
#ifndef REP_BAR
#define REP_BAR 1
#endif
#ifndef GEMM_ALIGN
#define GEMM_ALIGN true
#endif
#ifndef GEMM_SP2
#define GEMM_SP2 true
#endif
#ifndef REP_GEMM
#define REP_GEMM 1
#endif
#ifndef ATTN_NAIVE
#define ATTN_NAIVE 0
#endif
#ifndef REP_W
#define REP_W 1
#endif
#ifndef REP_LN
#define REP_LN 1
#endif
#ifndef REP_ATT
#define REP_ATT 1
#endif
#ifndef REP_SSD1
#define REP_SSD1 1
#endif
#ifndef REP_SSD3
#define REP_SSD3 1
#endif
#ifndef REP_SC
#define REP_SC 1
#endif
#ifndef PHASE_MASK
#define PHASE_MASK 0x1fff
#endif
#if ONE_LAUNCH && !defined(EMU)
#define IN(k) ((PHASE_MASK >> (((k) % PH_PER_LAYER))) & 1)
#define SEAM(k) do { if ((k) + 1 < N_PHASES) { XcdBarrier b_; b_.bar = (unsigned*)(ld_ws(P.ws) + WS_CTL) + 4096; b_.x = xb_xcc_id(); b_.st = (volatile LAS unsigned*)(lds + MISC_OFF) + 8; for (int rb_ = 0; rb_ < REP_BAR; ++rb_) xcd_barrier(b_); } } while (0)
#else
#define IN(k) (((PHASE_MASK >> (((k) % PH_PER_LAYER))) & 1) && P.ph_lo <= (k) && (k) < P.ph_hi)
#define SEAM(k) do { if (IN(k) && IN((k) + 1)) { XcdBarrier b_; b_.bar = (unsigned*)(ld_ws(P.ws) + WS_CTL) + 4096; b_.x = xb_xcc_id(); b_.st = (volatile LAS unsigned*)(lds + MISC_OFF) + 8; xcd_barrier(b_); } } while (0)
#endif
template <int L> DI void layer_program(const Params& P, LAS unsigned char* lds) {
    {
        constexpr int pb = L * PH_PER_LAYER;
#define WSP unsigned char* const ws = ld_ws(P.ws); (void)ws
#define GEMM_PHASE(EPI, A_, B_, N_, K_, ...) GEMM_PHASE_R(0, 0, EPI, A_, B_, N_, K_, __VA_ARGS__)
#define GEMM_PHASE_X(F8_, EPI, A_, B_, N_, K_, ...) GEMM_PHASE_R(F8_, 0, EPI, A_, B_, N_, K_, __VA_ARGS__)
#define GEMM_PHASE_R(F8_, ROT_, EPI, A_, B_, N_, K_, ...) do { pg8::Gemm g{(const bf16*)(A_), (const bf16*)(B_), M, (N_), (K_)}; int bid_ = blockIdx.x, gsz_ = ld_grid(); if (ROT_) bid_ = (bid_ + gsz_ / 2) % gsz_; OPAQUE_S(bid_); OPAQUE_S(gsz_); auto lds_ = lds; OPAQUE_S(lds_); pg8::StaticOrder S; S.init(M, (N_), gsz_, bid_); \
            EPI E{__VA_ARGS__}; for (int rep = 0; rep < REP_GEMM; ++rep) pg8::gemm_phase<EPI, pg8::StaticOrder, GEMM_ALIGN, GEMM_SP2, F8_>(lds_, g, S, E); } while (0)
        if (IN(pb + 0)) for (int rep = 0; rep < REP_W; ++rep) phase_weights(P.ws, L, lds, rep);
        SEAM(pb + 0);
        if (IN(pb + 1)) { WSP;
            if (QKV_FP8) { GEMM_PHASE_X(1, pg8::EpiBf16<2>, ws + WS_X8, ws + WS_WIN, NQKV, DM / 2, (bf16*)(ws + WS_BIG), NU);
                           if constexpr ((IN_INT8 >> L) & 1) GEMM_PHASE_R(2, 1, pg8::EpiI8<0>, ws + WS_X8I, ws + WS_WIN + WINB_OFF, NREST, DM / 2, (bf16*)(ws + WS_BIG) + NQKV, NU, (const float*)(ws + WS_SA), (const float*)(ws + WS_SWI));
                           else GEMM_PHASE_R(0, 1, pg8::EpiBf16<0>, ws + WS_XB, ws + WS_WIN + WINB_OFF, NREST, DM, (bf16*)(ws + WS_BIG) + NQKV, NU); }
            else GEMM_PHASE(pg8::EpiBf16<0>, ws + WS_XB, ws + WS_WIN, NU, DM, (bf16*)(ws + WS_BIG), NU); }
        SEAM(pb + 1);
        if (IN(pb + 2)) { phase_rope(P.ws, lds); for (int rm_ = 0; rm_ < REP_MISC; ++rm_) { phase_conv(P.ws, L, lds); WSP; GEMM_PHASE(pg8::EpiBf16<0>, (const bf16*)(ws + WS_PB) + (size_t)L * M * DPLE, ws + WS_WPE, DM, DPLE, (bf16*)(ws + WS_EMB), DM); } }
        SEAM(pb + 2);
        if (IN(pb + 3)) { for (int rep = 0; rep < REP_SSD1; ++rep) phase_ssd_states(P.ws, L, lds); for (int rep = 0; rep < REP_ATT; ++rep) { if (ATTN_NAIVE) phase_attn_naive(P.ws, lds); else phase_attn_mfma(P.ws, lds); } for (int rep = 0; rep < REP_SC; ++rep) phase_shortconv(P.ws, L, lds); }
        SEAM(pb + 3);
        if (IN(pb + 4)) { for (int rs_ = 0; rs_ < REP_SCAN; ++rs_) phase_ssd_scan(P.ws, rs_ + 1 < REP_SCAN); phase_attn_mix(P.ws); }
        SEAM(pb + 4);
        if (IN(pb + 5)) for (int rep = 0; rep < REP_SSD3; ++rep) phase_ssd_out(P.ws, L, lds);
        SEAM(pb + 5);
        if (IN(pb + 6)) { WSP; if (ATT_FP8) GEMM_PHASE_X(3, pg8::EpiBf16<0>, ws + WS_CAT, ws + WS_WOUT, DM, CAT_PITCH, (bf16*)(ws + WS_XF), DM);
            else GEMM_PHASE(pg8::EpiBf16<0>, ws + WS_CAT, ws + WS_WOUT, DM, DMIX, (bf16*)(ws + WS_XF), DM); }
        SEAM(pb + 6);
        if (IN(pb + 7)) for (int rep = 0; rep < REP_LN; ++rep) phase_resln<false>(P.ws, P.out, L, 0, lds, rep + 1 < REP_LN);
        SEAM(pb + 7);
        if (IN(pb + 8)) for (int r3_ = 0; r3_ < REP_G3; ++r3_) { WSP; if constexpr ((UP_INT8 >> L) & 1) GEMM_PHASE_X(2, pg8::EpiI8<1>, ws + WS_X8, ws + WS_WUP, DFF, DM / 2, (bf16*)(ws + WS_BIG), DFF, (const float*)(ws + WS_SA), (const float*)(ws + WS_SW));
            else GEMM_PHASE(pg8::EpiBf16<1>, ws + WS_XB, ws + WS_WUP, DFF, DM, (bf16*)(ws + WS_BIG), DFF); }
        SEAM(pb + 8);
        if (IN(pb + 9)) for (int r4_ = 0; r4_ < REP_G4; ++r4_) { WSP; GEMM_PHASE(pg8::EpiBf16<0>, ws + WS_BIG, ws + WS_WDN, DM, DFF, (bf16*)(ws + WS_XF), DM); }
        SEAM(pb + 9);
        if (IN(pb + 10)) for (int rep = 0; rep < REP_LN; ++rep) phase_resln<false>(P.ws, P.out, L, 1, lds, rep + 1 < REP_LN);
        SEAM(pb + 10);
        if (IN(pb + 11)) { WSP; if (GATE_INT8) GEMM_PHASE_X(2, pg8::EpiI8<0>, ws + WS_X8, ws + WS_WGT, DM, DM / 2, (bf16*)(ws + WS_XF), DM, (const float*)(ws + WS_SA), (const float*)(ws + WS_SWG));
            else if (GATE_FP8) GEMM_PHASE_X(true, pg8::EpiBf16<2>, ws + WS_X8, ws + WS_WGT, DM, DM / 2, (bf16*)(ws + WS_XF), DM);
            else GEMM_PHASE(pg8::EpiBf16<0>, ws + WS_XB, ws + WS_WGT, DM, DM, (bf16*)(ws + WS_XF), DM); }
        SEAM(pb + 11);
        if (IN(pb + 12)) for (int rep = 0; rep < REP_LN; ++rep) phase_resln<true>(P.ws, P.out, L, 2, lds, rep + 1 < REP_LN);
        SEAM(pb + 12);
#undef WSP
#undef GEMM_PHASE
#undef GEMM_PHASE_X
#undef GEMM_PHASE_R
    }
}
#undef IN
#undef SEAM

__global__ void __launch_bounds__(512, 2) hymba_fwd(Params P) {
#ifdef EMU
    unsigned char* lds = emu::lds_base();
#else
    extern __shared__ __attribute__((aligned(16))) unsigned char lds_raw[];
    LAS unsigned char* lds = (LAS unsigned char*)lds_raw;
#endif
    volatile LAS unsigned* MISC = (volatile LAS unsigned*)(lds + MISC_OFF);
    for (int u = threadIdx.x; u < 64; u += 512) MISC[u] = 0u;
    { LAS unsigned long long* pt = (LAS unsigned long long*)(lds + PTAB_OFF);
#pragma unroll
      for (int i = 0; i < 21; ++i) if (threadIdx.x == i) pt[i] = (unsigned long long)(size_t)P.in[i]; }
    __syncthreads();
    if ((P.ph_hi - P.ph_lo) > 1) (void)xcd_barrier_post((unsigned*)(P.ws + WS_CTL) + 4096, MISC + 8);
    layer_program<0>(P, lds);
    layer_program<1>(P, lds);
    static_assert(DEPTH == 2, "layer_program instantiations");

}

extern "C" void kernel_launch(void* const* d_in, const int* in_sizes, int n_in, void* d_out, int out_size, void* d_ws, size_t ws_size, hipStream_t stream) {
    static int grid = 0;
    if (grid == 0) {
        if (n_in != 21 || ws_size < WS_END) { fprintf(stderr, "kernel_launch: expected 21 inputs and >= %zu bytes of workspace; got %d inputs, %zu bytes\n", (size_t)WS_END, n_in, ws_size); grid = -1; return; }
        int dev = 0, cus = 0, per_cu = 0;
        if (hipGetDevice(&dev) != hipSuccess || hipDeviceGetAttribute(&cus, hipDeviceAttributeMultiprocessorCount, dev) != hipSuccess) { grid = -1; return; }
        if (hipFuncSetAttribute((const void*)hymba_fwd, hipFuncAttributeMaxDynamicSharedMemorySize, LDS_BYTES) != hipSuccess) { fprintf(stderr, "kernel_launch: hipFuncSetAttribute failed\n"); grid = -1; return; }
        if (hipOccupancyMaxActiveBlocksPerMultiprocessor(&per_cu, (const void*)hymba_fwd, 512, LDS_BYTES) != hipSuccess || per_cu < 1) fprintf(stderr, "kernel_launch: occupancy query reports %d\n", per_cu);
        (void)hipGetLastError();
        grid = cus;
    }
    if (grid < 0) return;
    (void)in_sizes; (void)out_size;
    hipMemsetAsync((char*)d_ws + WS_CTL, 0, CTL_BYTES, stream);
    Params p{};
    for (int i = 0; i < 21; ++i) p.in[i] = (const float*)d_in[i];
    p.out = (float*)d_out; p.ws = (unsigned char*)d_ws; p.grid = grid; p.pad = 0;
#if ONE_LAUNCH
    p.ph_lo = 0; p.ph_hi = N_PHASES;
    hipLaunchKernelGGL(hymba_fwd, dim3(grid), dim3(512), LDS_BYTES, stream, p);
#else
    for (int k = 0; k < N_PHASES; ++k) { p.ph_lo = k; p.ph_hi = k + 1; hipLaunchKernelGGL(hymba_fwd, dim3(grid), dim3(512), LDS_BYTES, stream, p); }
#endif
}
```

```cpp
#ifndef EMU
#include <hip/hip_runtime.h>
#endif
#include <cstdio>
#include <cstdint>
#include <type_traits>

#ifndef CFG_BATCH
#define CFG_BATCH 2
#endif
#ifndef CFG_SEQ
#define CFG_SEQ 8192
#endif
#ifndef CFG_DM
#define CFG_DM 4096
#endif
#ifndef CFG_DFF
#define CFG_DFF 16384
#endif
#ifndef ONE_LAUNCH
#define ONE_LAUNCH 1
#endif

#ifdef EMU
#define LAS
#define GAS
#define WAIT_VM0() ((void)0)
#define WAIT_LGKM0() ((void)0)
#define WAVE_SYNC() emu::wave_barrier()
#define CFENCE() ((void)0)
#else
#define LAS __attribute__((address_space(3)))
#define GAS __attribute__((address_space(1)))
#define WAIT_VM0() asm volatile("s_waitcnt vmcnt(0)" ::: "memory")
#define WAIT_LGKM0() asm volatile("s_waitcnt lgkmcnt(0)" ::: "memory")
#define WAVE_SYNC() do { asm volatile("s_waitcnt lgkmcnt(0)" ::: "memory"); __builtin_amdgcn_wave_barrier(); asm volatile("" ::: "memory"); } while (0)
#define CFENCE() asm volatile("" ::: "memory")
#endif
#define DI __device__ __forceinline__
#ifndef IN_INT8
#define IN_INT8 2
#endif
#ifndef ATT_FP8
#define ATT_FP8 1
#endif
#ifndef QKV_FP8
#define QKV_FP8 1
#endif
#ifndef UP_INT8
#define UP_INT8 3
#endif
#ifndef GATE_INT8
#define GATE_INT8 1
#endif
#ifndef GATE_FP8
#define GATE_FP8 1
#endif
#ifndef USE_NT
#define USE_NT 1
#endif
#if USE_NT
#define NT_LOAD(p) __builtin_nontemporal_load(p)
#else
#define NT_LOAD(p) (*(p))
#endif
#ifdef EMU
#define F8_PAD() ((void)0)
#else
#define F8_PAD() asm volatile("s_nop 15\n\ts_nop 15" ::: "memory")
#endif
#define PHASE_FN __device__ __forceinline__ void
#ifdef EMU
#define OPAQUE_V(x) ((void)0)
#define OPAQUE_S(x) ((void)0)
#else
#define OPAQUE_V(x) asm volatile("" : "+v"(x))
#define OPAQUE_S(x) asm volatile("" : "+s"(x))
#endif

namespace pg8 {
#define PG8_LAS LAS
typedef unsigned short bf16_t;
typedef short bf16x8 __attribute__((ext_vector_type(8)));
typedef float f32x4 __attribute__((ext_vector_type(4)));
typedef unsigned u32x4 __attribute__((ext_vector_type(4)));
typedef int i32x4_t __attribute__((ext_vector_type(4)));
typedef int v8i_t __attribute__((ext_vector_type(8)));
constexpr int BM = 256, BK = 64, HALF = 128, HTB = HALF * BK * 2  , STAGE_BYTES = 8 * HTB, NXCD = 8, WGM = 8;

__host__ __device__ __forceinline__ int lds_byte(int r, int c) { const int st = (r >> 4) * 2 + (c >> 5), rr = r & 15, cc = c & 31, ob = rr * 64 + cc * 2; return st * 1024 + (ob ^ (((ob >> 9) & 1) << 5)); }
__host__ __device__ __forceinline__ void stage_rc(int b, int& R, int& C) { const int st = b / 1024, sb = b % 1024, swz = sb ^ (((sb >> 9) & 1) << 5); R = (st >> 1) * 16 + swz / 64; C = (st & 1) * 32 + (swz % 64) / 2; }
__host__ __device__ __forceinline__ int perm32(int rho) { const int n = rho >> 4, i = rho & 15; return 8 * (i >> 2) + 4 * n + (i & 3); }

struct Unit { int pm, pn; };
struct Gemm { const bf16_t* A; const bf16_t* Bt; int M, N, K; };

struct StaticOrder {
    int nM, nN, nwg, G, c;
    __host__ __device__ void init(int M, int N, int G_, int c_) { nM = M / BM; nN = N / BM; nwg = nM * nN; G = G_; c = c_; }
    __host__ __device__ bool next(int i, Unit& u) const {
        const long L = (long)i * G + c; if (L >= nwg) return false;
        int wgid = (int)L; { const int q = nwg / NXCD, r = nwg % NXCD, xcd = wgid % NXCD, off = wgid / NXCD; wgid = (xcd < r ? xcd * (q + 1) : r * (q + 1) + (xcd - r) * q) + off; }
        const int nig = WGM * nN, gid = wgid / nig, fm = gid * WGM, gsz = (nM - fm) < WGM ? (nM - fm) : WGM;
        u.pm = fm + ((wgid % nig) % gsz); u.pn = (wgid % nig) / gsz; return true;
    }
    __device__ __forceinline__ void a_ready(const Unit&) const {}
    __device__ __forceinline__ void done(const Unit&) const {}
};


#ifdef EMU
__device__ __forceinline__ unsigned cvt_pk_bf16(float lo, float hi) { unsigned a = __float_as_uint(lo), b = __float_as_uint(hi); a = (a + 0x7fffu + ((a >> 16) & 1u)) >> 16; b = (b + 0x7fffu + ((b >> 16) & 1u)) >> 16; return a | (b << 16); }
#else
__device__ __forceinline__ unsigned cvt_pk_bf16(float lo, float hi) { unsigned r; asm volatile("v_cvt_pk_bf16_f32 %0, %1, %2" : "=v"(r) : "v"(lo), "v"(hi)); return r; }
#endif
typedef unsigned u32x2 __attribute__((ext_vector_type(2)));
template <int ACT> struct EpiBf16 {
    static constexpr bool PERM = true, AFTER_DRAIN = false;
    bf16_t* O; int ldc;
    __device__ __forceinline__ void operator()(const f32x4 (&acc)[2][2][4][2], const Unit& u, int wr, int wc, int fr, int fq) const {
        const int row0 = u.pm * BM + wr * 64 + fr, col0 = u.pn * BM + wc * 32 + 8 * fq;
#pragma unroll
        for (int ai = 0; ai < 2; ++ai)
#pragma unroll
            for (int m = 0; m < 4; ++m) { bf16_t* rowp = O + (size_t)(row0 + ai * HALF + m * 16) * ldc + col0;
#pragma unroll
                for (int bj = 0; bj < 2; ++bj) { f32x4 v0 = acc[ai][bj][m][0], v1 = acc[ai][bj][m][1];
                    if (ACT == 1) {
#pragma unroll
                        for (int j = 0; j < 4; ++j) { const float a = v0[j] > 0.f ? v0[j] : 0.f, b = v1[j] > 0.f ? v1[j] : 0.f; v0[j] = a * a; v1[j] = b * b; } }
                    if (ACT == 2) { v0 = v0 * 0.015625f; v1 = v1 * 0.015625f; }
                    u32x4 w; w.x = cvt_pk_bf16(v0[0], v0[1]); w.y = cvt_pk_bf16(v0[2], v0[3]); w.z = cvt_pk_bf16(v1[0], v1[1]); w.w = cvt_pk_bf16(v1[2], v1[3]);
                    *(u32x4*)(rowp + bj * HALF) = w; } }
    }
};
template <bool I8> struct AccSel { typedef f32x4 type; };
template <> struct AccSel<true> { typedef i32x4_t type; };
template <int ACT  > struct EpiI8 {
    static constexpr bool PERM = true, AFTER_DRAIN = false;
    bf16_t* O; int ldc; const float* sa; const float* sw;
    __device__ __forceinline__ void operator()(const i32x4_t (&acc)[2][2][4][2], const Unit& u, int wr, int wc, int fr, int fq) const {
        const int row0 = u.pm * BM + wr * 64 + fr, col0 = u.pn * BM + wc * 32 + 8 * fq;
        f32x4 cs[2][2]; float ra[2][4];
#pragma unroll
        for (int bj = 0; bj < 2; ++bj) { cs[bj][0] = *(const f32x4*)(sw + col0 + bj * HALF); cs[bj][1] = *(const f32x4*)(sw + col0 + bj * HALF + 4); }
#pragma unroll
        for (int ai = 0; ai < 2; ++ai)
#pragma unroll
            for (int m = 0; m < 4; ++m) ra[ai][m] = sa[row0 + ai * HALF + m * 16];
#pragma unroll
        for (int ai = 0; ai < 2; ++ai)
#pragma unroll
            for (int m = 0; m < 4; ++m) { const int row = row0 + ai * HALF + m * 16; bf16_t* rowp = O + (size_t)row * ldc + col0;
#pragma unroll
                for (int bj = 0; bj < 2; ++bj) { const f32x4 s0 = cs[bj][0] * ra[ai][m], s1 = cs[bj][1] * ra[ai][m]; f32x4 v0, v1;
#pragma unroll
                    for (int j = 0; j < 4; ++j) { const float a = (float)acc[ai][bj][m][0][j] * s0[j], b = (float)acc[ai][bj][m][1][j] * s1[j];
                        if (ACT == 1) { const float ap = fmaxf(a, 0.f), bp = fmaxf(b, 0.f); v0[j] = ap * ap; v1[j] = bp * bp; } else { v0[j] = a; v1[j] = b; } }
                    u32x4 w; w.x = cvt_pk_bf16(v0[0], v0[1]); w.y = cvt_pk_bf16(v0[2], v0[3]); w.z = cvt_pk_bf16(v1[0], v1[1]); w.w = cvt_pk_bf16(v1[2], v1[3]);
                    *(u32x4*)(rowp + bj * HALF) = w; } }
    }
};
template <bool GATE> struct EpiRes {
    static constexpr bool PERM = false, AFTER_DRAIN = false;
    const float* base; float* out; int ldc; float alpha; const bf16_t* emb;
    __device__ __forceinline__ void operator()(const f32x4 (&acc)[2][2][4][2], const Unit& u, int wr, int wc, int fr, int fq) const {
        const int row0 = u.pm * BM + wr * 64 + fr, col0 = u.pn * BM + wc * 32 + 4 * fq;
#pragma unroll
        for (int ai = 0; ai < 2; ++ai)
#pragma unroll
            for (int m = 0; m < 4; ++m) { const size_t off = (size_t)(row0 + ai * HALF + m * 16) * ldc + col0;
#pragma unroll
                for (int bj = 0; bj < 2; ++bj)
#pragma unroll
                    for (int n = 0; n < 2; ++n) { const size_t o = off + bj * HALF + n * 16; const f32x4 bs = *(const f32x4*)(base + o); f32x4 v = acc[ai][bj][m][n];
                        if (GATE) { const u32x2 e = *(const u32x2*)(emb + o);
                            const float e0 = __uint_as_float(e.x << 16), e1 = __uint_as_float(e.x & 0xffff0000u), e2 = __uint_as_float(e.y << 16), e3 = __uint_as_float(e.y & 0xffff0000u);
                            v[0] = e0 / (1.f + __expf(-v[0])); v[1] = e1 / (1.f + __expf(-v[1])); v[2] = e2 / (1.f + __expf(-v[2])); v[3] = e3 / (1.f + __expf(-v[3])); }
                        *(f32x4*)(out + o) = bs * alpha + v; } }
    }
};

#ifdef EMU
__device__ __forceinline__ void mfma_f8_acc(f32x4& c, v8i_t a, v8i_t b, int) { c = __builtin_amdgcn_mfma_scale_f32_16x16x128_f8f6f4(a, b, c, 0, 0, 0, 0x7f7f7f7f, 0, 0x7f7f7f7f); }
#else
__device__ __forceinline__ void mfma_f8_acc(f32x4& c, v8i_t a, v8i_t b, int sc) { asm volatile("v_mfma_scale_f32_16x16x128_f8f6f4 %0, %1, %2, %0, %3, %3 op_sel_hi:[0,0,0]" : "+v"(c) : "v"(a), "v"(b), "v"(sc)); }
#endif
#ifdef EMU
__device__ __forceinline__ void mfma_f8_acc2(f32x4& c, v8i_t a, v8i_t b, int sa, int sb, int, int) { c = __builtin_amdgcn_mfma_scale_f32_16x16x128_f8f6f4(a, b, c, 0, 0, 0, sa, 0, sb); }
#else
__device__ __forceinline__ void mfma_f8_acc2(f32x4& c, v8i_t a, v8i_t b, int, int, int va, int vb) { asm volatile("v_mfma_scale_f32_16x16x128_f8f6f4 %0, %1, %2, %0, %3, %4 op_sel_hi:[0,0,0]" : "+v"(c) : "v"(a), "v"(b), "v"(va), "v"(vb)); }
#endif
template <class Epi, class Sched, bool ALIGN_EPI = false, bool SP2 = false, int QM = 0>
__device__ __forceinline__ void gemm_phase(PG8_LAS unsigned char* lds, const Gemm g, const Sched& S, const Epi& E) {
    int tid_o = threadIdx.x; OPAQUE_V(tid_o);
    constexpr bool MX = (QM == 3), F8 = (QM == 1) || MX, I8 = (QM == 2); typedef typename AccSel<I8>::type acc_v;
    constexpr int NT8 = 12;
    const int tid = tid_o, wid = __builtin_amdgcn_readfirstlane(tid >> 6), lane = tid & 63, wr = wid >> 2, wc = wid & 3, fr = lane & 15, fq = lane >> 4;
    const int K = g.K, nt = K / BK;
    unsigned voffA[2], voffB[2];
#pragma unroll
    for (int i = 0; i < 2; ++i) { int R, C; stage_rc(tid * 16 + i * 8192, R, C); const int Rb = Epi::PERM ? ((R & ~31) + perm32(R & 31)) : R;
        voffA[i] = (unsigned)(R * K + C) * 2u; voffB[i] = (unsigned)(Rb * K + C) * 2u; }
    const size_t kstep = (size_t)(BK * 2);
    const size_t hstep = (size_t)HALF * K * 2;
    const size_t tstep = 2 * hstep;
    const unsigned ldsw = (unsigned)wid * 1024u;
    const int aoff = lds_byte(wr * 64 + fr, fq * 8), boff = lds_byte(wc * 32 + fr, fq * 8);
#define PG8_SA(b, h) (((b) * 2 + (h)) * HTB)
#define PG8_SB(b, h) ((4 + (b) * 2 + (h)) * HTB)
#define PG8_STAGE(bufoff, gbase, voff) do { _Pragma("unroll") for (int _i = 0; _i < 2; ++_i) \
        __builtin_amdgcn_global_load_lds((const unsigned*)((const char*)(gbase) + (voff)[_i]), (PG8_LAS unsigned*)(lds + (bufoff) + ldsw + _i * 8192), 16, 0, 0); } while (0)
#define PG8_LDA(dst, b, h) do { if constexpr (F8) { _Pragma("unroll") for (int m = 0; m < 4; ++m) dst##8[m] = __builtin_shufflevector(*(const PG8_LAS i32x4_t*)(lds + PG8_SA(b, h) + aoff + m * 2048), *(const PG8_LAS i32x4_t*)(lds + PG8_SA(b, h) + aoff + m * 2048 + 1024), 0, 1, 2, 3, 4, 5, 6, 7); } \
        else { _Pragma("unroll") for (int m = 0; m < 4; ++m) _Pragma("unroll") for (int k = 0; k < 2; ++k) dst[m][k] = *(const PG8_LAS bf16x8*)(lds + PG8_SA(b, h) + aoff + m * 2048 + k * 1024); } } while (0)
#define PG8_LDB(dst, b, h) do { if constexpr (F8) { _Pragma("unroll") for (int n = 0; n < 2; ++n) dst##8[n] = __builtin_shufflevector(*(const PG8_LAS i32x4_t*)(lds + PG8_SB(b, h) + boff + n * 2048), *(const PG8_LAS i32x4_t*)(lds + PG8_SB(b, h) + boff + n * 2048 + 1024), 0, 1, 2, 3, 4, 5, 6, 7); } \
        else { _Pragma("unroll") for (int n = 0; n < 2; ++n) _Pragma("unroll") for (int k = 0; k < 2; ++k) dst[n][k] = *(const PG8_LAS bf16x8*)(lds + PG8_SB(b, h) + boff + n * 2048 + k * 1024); } } while (0)
#ifndef GEMM_PRIO
#define GEMM_PRIO 1
#endif
#define PG8_MMA(ai, bj, At, Bt) do { if (GEMM_PRIO) __builtin_amdgcn_s_setprio(GEMM_PRIO); \
        if constexpr (MX) { if constexpr (mx8) { _Pragma("unroll") for (int m = 0; m < 4; ++m) _Pragma("unroll") for (int n = 0; n < 2; ++n) mfma_f8_acc2(acc[ai][bj][m][n], Bt##8[n], At##8[m], 0x79797979, 0x7b7b7b7b, mx_sw, mx_sa); } \
            else { _Pragma("unroll") for (int m = 0; m < 4; ++m) _Pragma("unroll") for (int n = 0; n < 2; ++n) { \
                acc[ai][bj][m][n] = __builtin_amdgcn_mfma_f32_16x16x32_bf16(__builtin_bit_cast(bf16x8, __builtin_shufflevector(Bt##8[n], Bt##8[n], 0, 1, 2, 3)), __builtin_bit_cast(bf16x8, __builtin_shufflevector(At##8[m], At##8[m], 0, 1, 2, 3)), acc[ai][bj][m][n], 0, 0, 0); \
                acc[ai][bj][m][n] = __builtin_amdgcn_mfma_f32_16x16x32_bf16(__builtin_bit_cast(bf16x8, __builtin_shufflevector(Bt##8[n], Bt##8[n], 4, 5, 6, 7)), __builtin_bit_cast(bf16x8, __builtin_shufflevector(At##8[m], At##8[m], 4, 5, 6, 7)), acc[ai][bj][m][n], 0, 0, 0); } } } \
        else if constexpr (F8) { _Pragma("unroll") for (int m = 0; m < 4; ++m) _Pragma("unroll") for (int n = 0; n < 2; ++n) \
            mfma_f8_acc(acc[ai][bj][m][n], Bt##8[n], At##8[m], f8_scale); } \
        else if constexpr (I8) { _Pragma("unroll") for (int m = 0; m < 4; ++m) _Pragma("unroll") for (int n = 0; n < 2; ++n) _Pragma("unroll") for (int k = 0; k < 2; ++k) \
            acc[ai][bj][m][n] = __builtin_amdgcn_mfma_i32_16x16x64_i8(__builtin_bit_cast(i32x4_t, Bt[n][k]), __builtin_bit_cast(i32x4_t, At[m][k]), acc[ai][bj][m][n], 0, 0, 0); } \
        else { _Pragma("unroll") for (int m = 0; m < 4; ++m) _Pragma("unroll") for (int n = 0; n < 2; ++n) _Pragma("unroll") for (int k = 0; k < 2; ++k) \
            acc[ai][bj][m][n] = __builtin_amdgcn_mfma_f32_16x16x32_bf16(Bt[n][k], At[m][k], acc[ai][bj][m][n], 0, 0, 0); } \
        if (GEMM_PRIO) __builtin_amdgcn_s_setprio(0); } while (0)
#ifdef EMU
#define PG8_WAIT_V(n) ((void)0)
#define PG8_WAIT_L(n) ((void)0)
#else
#define PG8_WAIT_V(n) asm volatile("s_waitcnt vmcnt(" #n ")" ::: "memory")
#define PG8_WAIT_L(n) asm volatile("s_waitcnt lgkmcnt(" #n ")" ::: "memory")
#endif
#define PG8_BAR __builtin_amdgcn_s_barrier()
#define PG8_SCHED __builtin_amdgcn_sched_barrier(0)
    Unit cur, nxt; int ui = 0;
    if (!S.next(0, cur)) return;
    acc_v acc[2][2][4][2];
#pragma unroll
    for (int a = 0; a < 2; ++a)
#pragma unroll
        for (int b = 0; b < 2; ++b)
#pragma unroll
            for (int m = 0; m < 4; ++m)
#pragma unroll
                for (int n = 0; n < 2; ++n) acc[a][b][m][n] = (acc_v){0, 0, 0, 0};
    int f8_scale = 0x7f7f7f7f; OPAQUE_V(f8_scale);
    int mx_sw = 0x79797979, mx_sa = 0x7b7b7b7b; OPAQUE_V(mx_sw); OPAQUE_V(mx_sa);
    bf16x8 At[4][2], B0[2][2], B1[2][2]; v8i_t At8[4], B08[2], B18[2];
    const char* cA = (const char*)g.A + (size_t)cur.pm * tstep; const char* cB = (const char*)g.Bt + (size_t)cur.pn * tstep;
    S.a_ready(cur);
    if constexpr (SP2) {
        PG8_STAGE(PG8_SB(0, 0), cB, voffB); PG8_STAGE(PG8_SB(0, 1), cB + hstep, voffB); PG8_STAGE(PG8_SA(0, 0), cA, voffA); PG8_STAGE(PG8_SA(0, 1), cA + hstep, voffA);
        if (wr == 1) PG8_BAR;
        PG8_WAIT_V(2); PG8_BAR;
        PG8_STAGE(PG8_SB(1, 0), cB + kstep, voffB); PG8_STAGE(PG8_SA(1, 0), cA + kstep, voffA); PG8_STAGE(PG8_SB(1, 1), cB + hstep + kstep, voffB);
        PG8_WAIT_V(6); PG8_BAR;
    } else {
        PG8_STAGE(PG8_SB(0, 0), cB, voffB); PG8_STAGE(PG8_SA(0, 0), cA, voffA); PG8_STAGE(PG8_SB(0, 1), cB + hstep, voffB); PG8_STAGE(PG8_SA(0, 1), cA + hstep, voffA);
        if (wr == 1) PG8_BAR;
        PG8_WAIT_V(4); PG8_BAR;
        PG8_STAGE(PG8_SB(1, 0), cB + kstep, voffB); PG8_STAGE(PG8_SA(1, 0), cA + kstep, voffA); PG8_STAGE(PG8_SB(1, 1), cB + hstep + kstep, voffB);
        PG8_WAIT_V(6); PG8_BAR;
    }
    for (;;) {
        const bool has_next = S.next(ui + 1, nxt);
        const char* nA = has_next ? (const char*)g.A + (size_t)nxt.pm * tstep : cA; const char* nB = has_next ? (const char*)g.Bt + (size_t)nxt.pn * tstep : cB;
        auto kiter = [&](auto mxtag, const int t) __attribute__((always_inline)) {
            constexpr bool mx8 = MX && decltype(mxtag)::value; (void)mx8;
            const bool last = (t == nt - 2);
            const char* a1 = cA + (size_t)(t + 1) * kstep;
            const char* a2 = last ? nA : cA + (size_t)(t + 2) * kstep; const char* b2 = last ? nB : cB + (size_t)(t + 2) * kstep;
            const char* a3 = a2 + kstep; const char* b3 = b2 + kstep;
            if (last && has_next) S.a_ready(nxt);
            if constexpr (SP2) {
            PG8_LDB(B0, 0, 0); PG8_LDB(B1, 0, 1); PG8_SCHED; PG8_LDA(At, 0, 0); PG8_STAGE(PG8_SA(1, 1), a1 + hstep, voffA);
            PG8_WAIT_V(8); PG8_WAIT_L(0); PG8_BAR; PG8_MMA(0, 0, At, B0); PG8_MMA(0, 1, At, B1); PG8_BAR; PG8_SCHED;
            PG8_LDA(At, 0, 1); PG8_STAGE(PG8_SB(0, 0), b2, voffB); PG8_STAGE(PG8_SB(0, 1), b2 + hstep, voffB); PG8_STAGE(PG8_SA(0, 0), a2, voffA);
            PG8_WAIT_V(8); PG8_WAIT_L(0); PG8_BAR; PG8_MMA(1, 0, At, B0); PG8_MMA(1, 1, At, B1); PG8_BAR; PG8_SCHED;
            PG8_LDB(B0, 1, 0); PG8_LDB(B1, 1, 1); PG8_SCHED; PG8_LDA(At, 1, 0); PG8_STAGE(PG8_SA(0, 1), a2 + hstep, voffA);
            PG8_WAIT_V(8); PG8_WAIT_L(0); PG8_BAR; PG8_MMA(0, 0, At, B0); PG8_MMA(0, 1, At, B1); PG8_BAR; PG8_SCHED;
            PG8_LDA(At, 1, 1); PG8_STAGE(PG8_SB(1, 0), b3, voffB); PG8_STAGE(PG8_SB(1, 1), b3 + hstep, voffB); PG8_STAGE(PG8_SA(1, 0), a3, voffA);
            PG8_WAIT_V(8); PG8_WAIT_L(0); PG8_BAR; PG8_MMA(1, 0, At, B0); PG8_MMA(1, 1, At, B1); PG8_BAR; PG8_SCHED;
            } else {
            PG8_LDB(B0, 0, 0); PG8_SCHED; PG8_LDA(At, 0, 0); PG8_STAGE(PG8_SA(1, 1), a1 + hstep, voffA);
            PG8_WAIT_L(8); PG8_BAR; PG8_WAIT_L(0); PG8_MMA(0, 0, At, B0); PG8_BAR; PG8_SCHED;
            PG8_LDB(B1, 0, 1); PG8_STAGE(PG8_SB(0, 0), b2, voffB);
            PG8_BAR; PG8_WAIT_L(0); PG8_MMA(0, 1, At, B1); PG8_BAR;
            PG8_LDA(At, 0, 1); PG8_STAGE(PG8_SA(0, 0), a2, voffA);
            PG8_BAR; PG8_WAIT_L(0); PG8_MMA(1, 0, At, B0); PG8_BAR; PG8_SCHED;
            PG8_STAGE(PG8_SB(0, 1), b2 + hstep, voffB);
            PG8_WAIT_V(6); PG8_BAR; PG8_MMA(1, 1, At, B1); PG8_BAR;
            PG8_LDB(B0, 1, 0); PG8_SCHED; PG8_LDA(At, 1, 0); PG8_STAGE(PG8_SA(0, 1), a2 + hstep, voffA);
            PG8_WAIT_L(8); PG8_BAR; PG8_WAIT_L(0); PG8_MMA(0, 0, At, B0); PG8_BAR; PG8_SCHED;
            PG8_LDB(B1, 1, 1); PG8_STAGE(PG8_SB(1, 0), b3, voffB);
            PG8_BAR; PG8_WAIT_L(0); PG8_MMA(0, 1, At, B1); PG8_BAR;
            PG8_LDA(At, 1, 1); PG8_STAGE(PG8_SA(1, 0), a3, voffA);
            PG8_BAR; PG8_WAIT_L(0); PG8_MMA(1, 0, At, B0); PG8_BAR; PG8_SCHED;
            PG8_STAGE(PG8_SB(1, 1), b3 + hstep, voffB);
            PG8_WAIT_V(6); PG8_BAR; PG8_MMA(1, 1, At, B1); PG8_BAR;
            }
        };
        if constexpr (MX) { for (int t = 0; t < NT8; t += 2) kiter(std::true_type{}, t); for (int t = NT8; t < nt; t += 2) kiter(std::false_type{}, t); }
        else { for (int t = 0; t < nt; t += 2) kiter(std::false_type{}, t); }
        if constexpr (ALIGN_EPI) { if (wr == 0) PG8_BAR; }
        if constexpr (F8) { F8_PAD(); }
        if constexpr (!Epi::AFTER_DRAIN) { E(acc, cur, wr, wc, fr, fq); S.done(cur); }
        if (!has_next) break;
#pragma unroll
        for (int a = 0; a < 2; ++a)
#pragma unroll
            for (int b = 0; b < 2; ++b)
#pragma unroll
                for (int m = 0; m < 4; ++m)
#pragma unroll
                    for (int n = 0; n < 2; ++n) acc[a][b][m][n] = (acc_v){0, 0, 0, 0};
        cur = nxt; cA = nA; cB = nB; ++ui;
        if constexpr (ALIGN_EPI) { if (wr == 1) PG8_BAR; }
    }
    PG8_WAIT_V(0);
    if constexpr (!ALIGN_EPI) { if (wr == 0) PG8_BAR; }
    PG8_BAR;
    if constexpr (Epi::AFTER_DRAIN) { E.fused(acc, cur, wr, wc, fr, fq, lds, wid, lane); S.done(cur); }
#undef PG8_SA
#undef PG8_SB
#undef PG8_STAGE
#undef PG8_LDA
#undef PG8_LDB
#undef PG8_MMA
#undef PG8_WAIT_V
#undef PG8_WAIT_L
#undef PG8_BAR
#undef PG8_SCHED
}
}


constexpr int BATCH = CFG_BATCH, SEQ = CFG_SEQ, DM = CFG_DM, DFF = CFG_DFF, DEPTH = 2;
constexpr int M = BATCH * SEQ, NCH = SEQ / 128;
constexpr int DMIX = 4096, DPLE = 256, D_IN = 11800;
constexpr int NU = 12032;
constexpr int UQ = 0, UK = 1536, UV = 3072, UZ = 4608, UX = 6144, UB = 7680, UC = 8192, USB = 8704, USC = 9728, USH = 10752, UDT = 11776;
constexpr float LN_EPS = 1e-5f, RMS_EPS = 1e-5f, DN_ALPHA = 1.41421356237f, ATT_SCALE = 0.08838834764831845f;
static_assert((IN_INT8 & 1) == 0 && (!IN_INT8 || QKV_FP8), "IN_INT8: layer 1 only, on top of the QKV_FP8 split");
static_assert(SEQ % 2048 == 0 && M % 256 == 0 && DM % 256 == 0 && DFF % 256 == 0 && DM <= DMIX, "shape");
constexpr int NQKV = 4608, NREST = NU - NQKV;
constexpr size_t WINB_OFF = (size_t)NQKV * DM;
DI int remap_u(int n) { return n < 8704 ? n : (n < 8728 ? UDT + (n - 8704) : n - 24); }

constexpr int CAT_PITCH = ATT_FP8 ? 3328 : 4096;
constexpr int CAT_SSM = ATT_FP8 ? 768 : 1536, CAT_SC = CAT_SSM + 1536;
constexpr int ATT_PITCH = ATT_FP8 ? 1536 : CAT_PITCH;
typedef pg8::bf16_t bf16;
typedef pg8::f32x4 f32x4;
typedef pg8::u32x4 u32x4;
typedef pg8::bf16x8 bf16x8;
typedef pg8::u32x2 u32x2;
typedef short s16x4 __attribute__((ext_vector_type(4)));

constexpr size_t al256(size_t x) { return (x + 255) & ~(size_t)255; }
constexpr size_t WS_CTL = 0, CTL_BYTES = 1u << 20;
constexpr size_t WS_WIN = WS_CTL + CTL_BYTES;
constexpr size_t WS_WOUT = WS_WIN + al256((size_t)NU * DM * 2);
constexpr size_t WS_WUP = WS_WOUT + al256((size_t)DM * DMIX * 2);
constexpr size_t WS_WDN = WS_WUP + al256((size_t)DFF * DM * 2);
constexpr size_t WS_WGT = WS_WDN + al256((size_t)DM * DFF * 2);
constexpr size_t WS_WPE = WS_WGT + al256((size_t)DM * DM * 2);
constexpr size_t WS_XB = WS_WPE + al256((size_t)DM * DPLE * 2);
constexpr size_t WS_XF = WS_XB + al256((size_t)M * DM * 2);
constexpr size_t WS_CAT = WS_XF + al256((size_t)M * DM * 2);
constexpr size_t WS_PB = WS_CAT + al256((size_t)M * DMIX * 2);
constexpr size_t WS_LSE = WS_PB + al256((size_t)DEPTH * M * DPLE * 2);
constexpr size_t WS_ROPE = WS_LSE + al256((size_t)M * 12 * 4);
constexpr size_t WS_CD = WS_ROPE + al256((size_t)SEQ * 32 * 4);
constexpr size_t WS_EMB = WS_CD + al256((size_t)BATCH * NCH * 24 * 4);
constexpr size_t WS_YS = WS_EMB + al256((size_t)M * DM * 2);
constexpr size_t WS_XC = WS_YS + al256((size_t)256 * 6 * 16 * 512 * 4);
constexpr size_t WS_PVB = WS_XC + al256((size_t)M * 2560 * 2);
constexpr size_t WS_X8 = WS_PVB + al256((size_t)BATCH * NCH * 24 * 8192 * 2);
constexpr size_t WS_SA = WS_X8 + al256((size_t)M * DM);
constexpr size_t WS_SW = WS_SA + al256((size_t)M * 4);
constexpr size_t WS_SWG = WS_SW + al256((size_t)DFF * 4);
constexpr size_t WS_SWI = WS_SWG + al256((size_t)DM * 4);
constexpr size_t WS_X8I = WS_SWI + al256((size_t)(NU - 4608) * 4);
constexpr size_t WS_ATT = WS_X8I + al256((size_t)M * DM);
constexpr size_t WS_BIG = WS_ATT + al256((size_t)M * 1536 * 2);
constexpr size_t BIG_U_BYTES = al256((size_t)M * NU * 2), BIG_ST_BYTES = al256((size_t)BATCH * NCH * 24 * 64 * 128 * 4), BIG_H_BYTES = al256((size_t)M * DFF * 2);
constexpr size_t BIG_BYTES = (BIG_U_BYTES + BIG_ST_BYTES) > BIG_H_BYTES ? (BIG_U_BYTES + BIG_ST_BYTES) : BIG_H_BYTES;
constexpr size_t WS_END = WS_BIG + BIG_BYTES;

constexpr int RING_BYTES = 139264;
constexpr int MISC_OFF = RING_BYTES;
constexpr int LDS_BYTES = 147456;

DI float bf2f(unsigned short b) { return __uint_as_float(((unsigned)b) << 16); }
DI unsigned short f2bf(float f) { unsigned u = __float_as_uint(f); return (unsigned short)((u + 0x7fffu + ((u >> 16) & 1u)) >> 16); }
DI unsigned pk2(float lo, float hi) { return (unsigned)f2bf(lo) | ((unsigned)f2bf(hi) << 16); }
DI float rcp_f(float x) { return __builtin_amdgcn_rcpf(x); }
DI float silu_f(float x) { return x * rcp_f(1.f + __expf(-x)); }
DI float softplus_f(float x) { return (x > 0.f ? x : 0.f) + log1pf(__expf(-fabsf(x))); }
#ifdef EMU
DI bf16x8 tr_read2(const bf16* p_lo, const bf16* p_hi) { const emu_s16x4 a = emu_tr_read_b64(p_lo), b = emu_tr_read_b64(p_hi); return __builtin_shufflevector(a, b, 0, 1, 2, 3, 4, 5, 6, 7); }
#else
DI bf16x8 tr_read2(const LAS bf16* p_lo, const LAS bf16* p_hi) { s16x4 a, b;
    asm volatile("ds_read_b64_tr_b16 %0, %2\n\tds_read_b64_tr_b16 %1, %3\n\ts_waitcnt lgkmcnt(0)" : "=&v"(a), "=&v"(b) : "v"((unsigned)(size_t)p_lo), "v"((unsigned)(size_t)p_hi) : "memory");
    return __builtin_shufflevector(a, b, 0, 1, 2, 3, 4, 5, 6, 7); }
#endif
#ifdef EMU
DI float shfl_f(float v, int src) { return emu::shfl_idx(v, src); }
#else
DI float shfl_f(float v, int src) { return __int_as_float(__builtin_amdgcn_ds_bpermute(src << 2, __float_as_int(v))); }
#endif
#ifdef EMU
DI int bcast_lane0(int v) { return emu::shfl_idx(v, 0); }
#else
DI int bcast_lane0(int v) { return __builtin_amdgcn_readfirstlane(v); }
#endif
DI float wave_sum(float v, int lane) {
#pragma unroll
    for (int o = 1; o < 64; o <<= 1) v += shfl_f(v, lane ^ o);
    return v; }
DI float wave_max(float v, int lane) {
#pragma unroll
    for (int o = 1; o < 64; o <<= 1) v = fmaxf(v, shfl_f(v, lane ^ o));
    return v; }

#ifdef EMU
DI unsigned char* ld_ws(unsigned char* p) { return p; }
DI float* ld_out(float* p) { return p; }
DI int ld_grid() { return (int)gridDim.x; }
#else
DI int ld_grid() { int v; asm volatile("s_load_dword %0, %1, 0xc0\n\ts_waitcnt lgkmcnt(0)" : "=s"(v) : "s"(__builtin_amdgcn_kernarg_segment_ptr())); return v; }
DI unsigned long long karg_u64_168() { unsigned long long v; asm volatile("s_load_dwordx2 %0, %1, 0xa8\n\ts_waitcnt lgkmcnt(0)" : "=s"(v) : "s"(__builtin_amdgcn_kernarg_segment_ptr())); return v; }
DI unsigned long long karg_u64_176() { unsigned long long v; asm volatile("s_load_dwordx2 %0, %1, 0xb0\n\ts_waitcnt lgkmcnt(0)" : "=s"(v) : "s"(__builtin_amdgcn_kernarg_segment_ptr())); return v; }
DI unsigned char* ld_ws(unsigned char*) { return (unsigned char*)(GAS unsigned char*)karg_u64_176(); }
DI float* ld_out(float*) { return (float*)(GAS float*)karg_u64_168(); }
#endif
#define XB_TMO      128
#define XB_XCNT(j)  (256  + 64 * (j))
#define XB_XSUB(j)  (1280 + 64 * (j))
#define XB_XGEN(j)  (2304 + 64 * (j))
#define XB_TOP      3328
#define XB_TOPGEN   3392
#define XCD_BAR_WORDS 3456
#define XB_SPIN_CAP (1u << 18)

__device__ __forceinline__ unsigned xb_ld(unsigned* p)              { return __hip_atomic_load(p, __ATOMIC_RELAXED, __HIP_MEMORY_SCOPE_AGENT); }
__device__ __forceinline__ unsigned xb_add(unsigned* p, unsigned v) { return __hip_atomic_fetch_add(p, v, __ATOMIC_RELAXED, __HIP_MEMORY_SCOPE_AGENT); }
__device__ __forceinline__ unsigned xb_xcc_id() { return (unsigned)__builtin_amdgcn_s_getreg((3 << 11) | 20) & 0xFu; }
#define XB_SPIN(cond, bar) do { unsigned _sp = 0; while (cond) { __builtin_amdgcn_s_sleep(1); \
    if ((++_sp & 255u) == 0u) { if (xb_ld(&(bar)[XB_TMO])) break; if (_sp > XB_SPIN_CAP) { atomicAdd(&(bar)[XB_TMO], 1u); break; } } } } while (0)

struct XcdBarrier {
    unsigned* bar; unsigned x;
    volatile LAS unsigned* st;
};

__device__ __forceinline__ XcdBarrier xcd_barrier_post(unsigned* bar, volatile LAS unsigned* st) {
    XcdBarrier b; b.bar = bar; b.x = xb_xcc_id(); b.st = st;
    if (threadIdx.x == 0) (void)xb_add(&bar[XB_XCNT(b.x)], 1u);
    return b;
}
__device__ __forceinline__ void xcd_barrier_complete(unsigned* bar, unsigned x, unsigned& nloc, unsigned& nx) {
    const unsigned G = (unsigned)ld_grid();
    unsigned sum, cnt, mine, sp = 0u;
    for (;;) {
        sum = 0u; cnt = 0u; mine = 0u;
#pragma unroll
        for (unsigned j = 0; j < 16; ++j) { const unsigned c = xb_ld(&bar[XB_XCNT(j)]); sum += c; cnt += (c > 0u) ? 1u : 0u; mine = (j == x) ? c : mine; }
        if (sum == G) break;
        __builtin_amdgcn_s_sleep(1);
        if ((++sp & 255u) == 0u) { if (xb_ld(&bar[XB_TMO])) break; if (sp > XB_SPIN_CAP) { atomicAdd(&bar[XB_TMO], 1u); break; } }
    }
    nloc = mine > 0u ? mine : 1u; nx = cnt > 0u ? cnt : 1u;
}

__device__ __forceinline__ void xcd_barrier(const XcdBarrier& b) {
    WAIT_VM0();
    __syncthreads();
    if (threadIdx.x == 0) {
        unsigned* bar = b.bar;
        __builtin_amdgcn_s_waitcnt(0);
        unsigned nloc = b.st[0], nx = b.st[1];
        if (nloc == 0u) { xcd_barrier_complete(bar, b.x, nloc, nx); b.st[0] = nloc; b.st[1] = nx; }
        const unsigned old = xb_add(&bar[XB_XSUB(b.x)], 1u);
        const unsigned gen = old / nloc;
        if (old + 1u == (gen + 1u) * nloc) {
            __builtin_amdgcn_fence(__ATOMIC_RELEASE, "agent");
            WAIT_VM0();
            const unsigned og = xb_add(&bar[XB_TOP], 1u);
            const unsigned tg = og / nx;
            if (og + 1u == (tg + 1u) * nx) xb_add(&bar[XB_TOPGEN], 1u);
            else XB_SPIN(xb_ld(&bar[XB_TOPGEN]) == tg, bar);
            __builtin_amdgcn_fence(__ATOMIC_ACQUIRE, "agent");
            xb_add(&bar[XB_XGEN(b.x)], 1u);
            WAIT_VM0();
        } else {
            XB_SPIN(xb_ld(&bar[XB_XGEN(b.x)]) == gen, bar);
            __builtin_amdgcn_fence(__ATOMIC_ACQUIRE, "agent");
            WAIT_VM0();
        }
    }
    __syncthreads();
}

constexpr int PTAB_OFF = MISC_OFF + 256;
DI const float* inp(LAS unsigned char* lds, int i) { const LAS unsigned* t = (const LAS unsigned*)(lds + PTAB_OFF) + 2 * i;
    const unsigned lo = __builtin_amdgcn_readfirstlane(t[0]), hi = __builtin_amdgcn_readfirstlane(t[1]); return (const float*)(const GAS float*)(((unsigned long long)hi << 32) | (unsigned long long)lo); }
DI unsigned char* opq(unsigned char* p) { unsigned lo = __builtin_amdgcn_readfirstlane((unsigned)(size_t)p), hi = __builtin_amdgcn_readfirstlane((unsigned)((size_t)p >> 32)); OPAQUE_S(lo); OPAQUE_S(hi); return (unsigned char*)(GAS unsigned char*)(((size_t)hi << 32) | (size_t)lo); }
struct Params { const float* in[21]; float* out; unsigned char* ws; int ph_lo, ph_hi; int grid, pad; };
enum { I_X = 0, I_P, I_WIN, I_CW, I_CB, I_DTB, I_ALOG, I_SD, I_NW, I_SCW, I_WOUT, I_L1G, I_L1B, I_WUP, I_WDN, I_L2G, I_L2B, I_WPE, I_WGT, I_L3G, I_L3B };

template <bool REMAP> DI void transpose_item(const float* W, int K, int N, bf16* WT, LAS float* scr, int item, int lane, int row_off = 0, int dpitch = 0, int koff = 0) {
    const int nblk = (N + 63) / 64, kb = item / nblk, nb = item % nblk, k0 = 64 * kb, n0 = 64 * nb;
    const int r4 = lane >> 4, c4 = lane & 15, nl = n0 + 4 * c4;
    f32x4 v[16];
#pragma unroll
    for (int i = 0; i < 16; ++i) v[i] = nl < N ? NT_LOAD((const f32x4*)(W + (size_t)(k0 + 4 * i + r4) * N + nl)) : (f32x4){0.f, 0.f, 0.f, 0.f};
#pragma unroll
    for (int i = 0; i < 16; ++i) { LAS float* d = scr + (4 * i + r4) * 65 + 4 * c4; d[0] = v[i][0]; d[1] = v[i][1]; d[2] = v[i][2]; d[3] = v[i][3]; }
    WAVE_SYNC();
#pragma unroll
    for (int j = 0; j < 8; ++j) { const int chunk = lane + 64 * j, nn = chunk >> 3, kc = chunk & 7, n = n0 + nn; const LAS float* s = scr + (8 * kc) * 65 + nn;
        u32x4 o; o.x = pk2(s[0 * 65], s[1 * 65]); o.y = pk2(s[2 * 65], s[3 * 65]); o.z = pk2(s[4 * 65], s[5 * 65]); o.w = pk2(s[6 * 65], s[7 * 65]);
        if (n < N) { const int row = (REMAP ? remap_u(n) : n) - row_off; *(u32x4*)(WT + (size_t)row * (dpitch ? dpitch : K) + k0 + koff + 8 * kc) = o; } }
    WAVE_SYNC();
}
DI unsigned pk4_fp8(float a, float b, float c, float d) { int w = 0; w = __builtin_amdgcn_cvt_pk_fp8_f32(a, b, w, false); w = __builtin_amdgcn_cvt_pk_fp8_f32(c, d, w, true); return (unsigned)w; }
DI void transpose_item_fp8(const float* W, int K, int N, unsigned char* WT8, LAS float* scr, int item, int lane, int dpitch = 0) {
    const int nblk = (N + 63) / 64, kb = item / nblk, nb = item % nblk, k0 = 64 * kb, n0 = 64 * nb;
    const int r4 = lane >> 4, c4 = lane & 15, nl = n0 + 4 * c4;
    f32x4 v[16];
#pragma unroll
    for (int i = 0; i < 16; ++i) v[i] = nl < N ? NT_LOAD((const f32x4*)(W + (size_t)(k0 + 4 * i + r4) * N + nl)) : (f32x4){0.f, 0.f, 0.f, 0.f};
#pragma unroll
    for (int i = 0; i < 16; ++i) { LAS float* d = scr + (4 * i + r4) * 65 + 4 * c4; d[0] = v[i][0]; d[1] = v[i][1]; d[2] = v[i][2]; d[3] = v[i][3]; }
    WAVE_SYNC();
#pragma unroll
    for (int j = 0; j < 4; ++j) { const int chunk = lane + 64 * j, nn = chunk >> 2, kc = chunk & 3, n = n0 + nn; const LAS float* s = scr + (16 * kc) * 65 + nn;
        u32x4 o;
#pragma unroll
        for (int e = 0; e < 4; ++e) o[e] = pk4_fp8(s[(4 * e) * 65] * 64.f, s[(4 * e + 1) * 65] * 64.f, s[(4 * e + 2) * 65] * 64.f, s[(4 * e + 3) * 65] * 64.f);
        if (n < N) *(u32x4*)(WT8 + (size_t)n * (dpitch ? dpitch : K) + k0 + 16 * kc) = o; }
    WAVE_SYNC();
}
template <bool WIN> DI void upq_strips(const float* W, int K, int N, signed char* WT8, float* sw_out, LAS unsigned char* lds, int BID, int GSZ, int wave, int lane) {
    LAS float* scr = (LAS float*)(lds + wave * 16640); LAS float* cmx = (LAS float*)(lds + 8 * 16640); LAS float* inv = cmx + 8 * 64;
    const int r4 = lane >> 4, c4 = lane & 15, ntile = K / 64;
    const int nstrip = WIN ? (D_IN - NQKV + 63) / 64 : N / 64;
    for (int s = BID; s < nstrip; s += GSZ) { const int n0 = WIN ? NQKV + 64 * s : 64 * s; const bool cok = !WIN || (n0 + 4 * c4 < D_IN);
        f32x4 mx = {0.f, 0.f, 0.f, 0.f};
        for (int kb = wave; kb < ntile; kb += 16) {
            f32x4 v[2][16]; const bool two = kb + 8 < ntile;
#pragma unroll
            for (int i = 0; i < 16; ++i) { v[0][i] = cok ? *(const f32x4*)(W + (size_t)(64 * kb + 4 * i + r4) * N + n0 + 4 * c4) : (f32x4){0.f, 0.f, 0.f, 0.f}; v[1][i] = (two && cok) ? *(const f32x4*)(W + (size_t)(64 * (kb + 8) + 4 * i + r4) * N + n0 + 4 * c4) : (f32x4){0.f, 0.f, 0.f, 0.f}; }
#pragma unroll
            for (int i = 0; i < 16; ++i)
#pragma unroll
                for (int e = 0; e < 4; ++e) mx[e] = fmaxf(mx[e], fmaxf(fabsf(v[0][i][e]), fabsf(v[1][i][e]))); }
#pragma unroll
        for (int e = 0; e < 4; ++e) { mx[e] = fmaxf(mx[e], shfl_f(mx[e], lane ^ 16)); mx[e] = fmaxf(mx[e], shfl_f(mx[e], lane ^ 32)); }
        if (r4 == 0) { cmx[wave * 64 + 4 * c4] = mx[0]; cmx[wave * 64 + 4 * c4 + 1] = mx[1]; cmx[wave * 64 + 4 * c4 + 2] = mx[2]; cmx[wave * 64 + 4 * c4 + 3] = mx[3]; }
        __syncthreads();
        if (wave == 0) { float m = 0.f;
#pragma unroll
            for (int w = 0; w < 8; ++w) m = fmaxf(m, cmx[w * 64 + lane]);
            m = fmaxf(m, 1e-30f); inv[lane] = 127.f / m; if (!WIN) sw_out[n0 + lane] = m * (1.f / 127.f); else if (n0 + lane < D_IN) sw_out[remap_u(n0 + lane) - NQKV] = m * (1.f / 127.f); }
        __syncthreads();
        f32x4 v[16];
#pragma unroll
        for (int i = 0; i < 16; ++i) v[i] = cok ? *(const f32x4*)(W + (size_t)(64 * wave + 4 * i + r4) * N + n0 + 4 * c4) : (f32x4){0.f, 0.f, 0.f, 0.f};
        for (int kb = wave; kb < ntile; kb += 8) { const int k0 = 64 * kb;
#pragma unroll
            for (int i = 0; i < 16; ++i) { LAS float* d = scr + (4 * i + r4) * 65 + 4 * c4; d[0] = v[i][0]; d[1] = v[i][1]; d[2] = v[i][2]; d[3] = v[i][3]; }
            if (kb + 8 < ntile) {
#pragma unroll
                for (int i = 0; i < 16; ++i) v[i] = cok ? *(const f32x4*)(W + (size_t)(k0 + 512 + 4 * i + r4) * N + n0 + 4 * c4) : (f32x4){0.f, 0.f, 0.f, 0.f}; }
            WAVE_SYNC();
#pragma unroll
            for (int j = 0; j < 4; ++j) { const int chunk = lane + 64 * j, nn = chunk >> 2, kc = chunk & 3; const LAS float* sp = scr + (16 * kc) * 65 + nn; const float iv = inv[nn];
                u32x4 o;
#pragma unroll
                for (int e = 0; e < 4; ++e) { unsigned w = 0;
#pragma unroll
                    for (int b = 0; b < 4; ++b) w |= ((unsigned)(__float2int_rn(sp[(4 * e + b) * 65] * iv) & 0xff)) << (8 * b);
                    o[e] = w; }
                if (!WIN) *(u32x4*)(WT8 + (size_t)(n0 + nn) * K + k0 + 16 * kc) = o; else if (n0 + nn < D_IN) *(u32x4*)(WT8 + (size_t)(remap_u(n0 + nn) - NQKV) * K + k0 + 16 * kc) = o; }
            WAVE_SYNC(); }
        __syncthreads();
    }
}
PHASE_FN phase_weights(unsigned char* wsarg, int L, LAS unsigned char* lds, int qsel = 0) {
    int BID = blockIdx.x, GSZ = ld_grid(); OPAQUE_S(BID); OPAQUE_S(GSZ); OPAQUE_S(lds);
    unsigned char* const WSQ = ld_ws(wsarg);
    int tid_o = threadIdx.x; OPAQUE_V(tid_o);
    const int tid = tid_o, lane = tid & 63, wave = __builtin_amdgcn_readfirstlane(tid >> 6);
    LAS float* scr = (LAS float*)(lds + wave * 16640);
    const int gw = BID * 8 + wave, NGW = GSZ * 8;
    unsigned char* ws = WSQ;
    const float* win = inp(lds, I_WIN) + (size_t)L * DM * D_IN; const float* wout = inp(lds, I_WOUT) + (size_t)L * DMIX * DM; const float* wup = inp(lds, I_WUP) + (size_t)L * DM * DFF;
    const float* wdn = inp(lds, I_WDN) + (size_t)L * DFF * DM; const float* wgt = inp(lds, I_WGT) + (size_t)L * DM * DM; const float* wpe = inp(lds, I_WPE) + (size_t)L * DPLE * DM;
    constexpr int I_1 = (DM / 64) * ((D_IN + 63) / 64), I_2 = (DMIX / 64) * (DM / 64), I_3 = (DM / 64) * (DFF / 64), I_4 = (DFF / 64) * (DM / 64), I_5 = (DM / 64) * (DM / 64), I_6 = (DPLE / 64) * (DM / 64);
    static_assert(8 * 16640 + 8 * 64 * 4 + 256 <= RING_BYTES && D_IN % 4 == 0 && DM % 64 == 0 && DFF % 64 == 0, "weights phase tiles");
    constexpr int NIT = I_1 + I_2 + I_3 + I_4 + I_5 + I_6;
    if ((IN_INT8 >> L) & 1) { upq_strips<true>(win, DM, D_IN, (signed char*)(ws + WS_WIN + WINB_OFF), (float*)(ws + WS_SWI), lds, (BID + GSZ / 4) % GSZ, GSZ, wave, lane);
        { u32x4* z = (u32x4*)(ws + WS_WIN + WINB_OFF + (size_t)(D_IN - NQKV) * DM); const size_t n16 = (size_t)(NU - D_IN) * DM / 16; for (size_t i = (size_t)BID * 512 + tid; i < n16; i += (size_t)GSZ * 512) z[i] = (u32x4){0u, 0u, 0u, 0u};
          float* zs = (float*)(ws + WS_SWI) + (D_IN - NQKV); for (int i = BID * 512 + tid; i < NU - D_IN; i += GSZ * 512) zs[i] = 0.f; } }
    if ((UP_INT8 >> L) & 1) upq_strips<false>(wup, DM, DFF, (signed char*)(ws + WS_WUP), (float*)(ws + WS_SW), lds, BID, GSZ, wave, lane);
    if (GATE_INT8) upq_strips<false>(wgt, DM, DM, (signed char*)(ws + WS_WGT), (float*)(ws + WS_SWG), lds, (BID + GSZ / 2) % GSZ, GSZ, wave, lane);
    unsigned* qctr = (unsigned*)(ws + WS_CTL) + 12288 + 64 * (2 * L + (int)(qsel & 1)); (void)gw; (void)NGW;
    for (;;) { unsigned c0 = 0; if (lane == 0) c0 = __hip_atomic_fetch_add(qctr, 16u, __ATOMIC_RELAXED, __HIP_MEMORY_SCOPE_AGENT);
      c0 = (unsigned)bcast_lane0((int)c0); if (c0 >= (unsigned)NIT) break;
      for (int it = (int)c0; it < (int)c0 + 16 && it < NIT; ++it) {
        int r = it;
        if (r < I_1) { if (QKV_FP8) { if (r % ((D_IN + 63) / 64) < NQKV / 64) transpose_item_fp8(win, DM, D_IN, ws + WS_WIN, scr, r, lane); else if (!((IN_INT8 >> L) & 1)) transpose_item<true>(win, DM, D_IN, (bf16*)(ws + WS_WIN + WINB_OFF), scr, r, lane, NQKV); }
                       else transpose_item<true>(win, DM, D_IN, (bf16*)(ws + WS_WIN), scr, r, lane); continue; } r -= I_1;
        if (r < I_2) { if (ATT_FP8) { if (r / (DM / 64) < 1536 / 64) transpose_item_fp8(wout, DMIX, DM, ws + WS_WOUT, scr, r, lane, CAT_PITCH * 2); else transpose_item<false>(wout, DMIX, DM, (bf16*)(ws + WS_WOUT), scr, r, lane, 0, CAT_PITCH, -768); }
                       else transpose_item<false>(wout, DMIX, DM, (bf16*)(ws + WS_WOUT), scr, r, lane); continue; } r -= I_2;
        if (r < I_3) { if (!((UP_INT8 >> L) & 1)) transpose_item<false>(wup, DM, DFF, (bf16*)(ws + WS_WUP), scr, r, lane); continue; } r -= I_3;
        if (r < I_4) { transpose_item<false>(wdn, DFF, DM, (bf16*)(ws + WS_WDN), scr, r, lane); continue; } r -= I_4;
        if (r < I_5) { if (GATE_INT8) {} else if (GATE_FP8) transpose_item_fp8(wgt, DM, DM, ws + WS_WGT, scr, r, lane); else transpose_item<false>(wgt, DM, DM, (bf16*)(ws + WS_WGT), scr, r, lane); continue; } r -= I_5;
        transpose_item<false>(wpe, DPLE, DM, (bf16*)(ws + WS_WPE), scr, r, lane);
      } }
    const size_t gt = (size_t)BID * 512 + tid, GT = (size_t)GSZ * 512;
    if (L == 0) {
        { u32x4* z = QKV_FP8 ? (u32x4*)((bf16*)(ws + WS_WIN + WINB_OFF) + (size_t)(D_IN - NQKV) * DM) : (u32x4*)((bf16*)(ws + WS_WIN) + (size_t)D_IN * DM); const size_t n16 = (size_t)(NU - D_IN) * DM / 8; for (size_t i = gt; i < n16; i += GT) z[i] = (u32x4){0u, 0u, 0u, 0u}; }
        { const f32x4* x4 = (const f32x4*)inp(lds, I_X); u32x2* o = (u32x2*)(ws + WS_XB); unsigned* o8 = (unsigned*)(ws + WS_X8); for (size_t i = gt; i < (size_t)M * DM / 4; i += GT) { const f32x4 v = x4[i]; u32x2 w; w.x = pk2(v[0], v[1]); w.y = pk2(v[2], v[3]); o[i] = w; if (QKV_FP8) o8[i] = pk4_fp8(v[0], v[1], v[2], v[3]); } }
        { const f32x4* p4 = (const f32x4*)inp(lds, I_P); u32x2* o = (u32x2*)(ws + WS_PB); for (size_t i = gt; i < (size_t)DEPTH * M * DPLE / 4; i += GT) { const f32x4 v = p4[i]; u32x2 w; w.x = pk2(v[0], v[1]); w.y = pk2(v[2], v[3]); o[i] = w; } }
        { float* rt = (float*)(ws + WS_ROPE); for (size_t i = gt; i < (size_t)SEQ * 16; i += GT) { const int pos = (int)(i >> 4), k = (int)(i & 15);
            const float inv = exp2f(-(float)k * (18.931568569324174f / 16.0f)); const float ang = (float)pos * inv; rt[pos * 32 + k] = cosf(ang); rt[pos * 32 + 16 + k] = sinf(ang); } }
    }
}

PHASE_FN phase_rope(unsigned char* wsarg, LAS unsigned char* lds) {
    int BID = blockIdx.x, GSZ = ld_grid(); OPAQUE_S(BID); OPAQUE_S(GSZ); OPAQUE_S(lds);
    unsigned char* const WSQ = ld_ws(wsarg);
    bf16* U = (bf16*)(WSQ + WS_BIG); const float* rt = (const float*)(WSQ + WS_ROPE);
    int tid_o = threadIdx.x; OPAQUE_V(tid_o);
    const size_t gt = (size_t)BID * 512 + tid_o, GT = (size_t)GSZ * 512;
    for (size_t i = gt; i < (size_t)M * 24; i += GT) {
        const int m = (int)(i / 24), hh = (int)(i % 24), pos = m % SEQ;
        bf16* p = U + (size_t)m * NU + (hh < 12 ? UQ + hh * 128 : UK + (hh - 12) * 128);
        const float* cs = rt + pos * 32;
#pragma unroll
        for (int h2 = 0; h2 < 2; ++h2) { u32x4 a = *(u32x4*)(p + 8 * h2), bq = *(u32x4*)(p + 16 + 8 * h2);
#pragma unroll
            for (int w = 0; w < 4; ++w) { const int k = h2 * 8 + w * 2; const unsigned xa = a[w], xb = bq[w];
                const float x1l = __uint_as_float(xa << 16), x1h = __uint_as_float(xa & 0xffff0000u), x2l = __uint_as_float(xb << 16), x2h = __uint_as_float(xb & 0xffff0000u);
                const float c0 = cs[k], c1 = cs[k + 1], s0 = cs[16 + k], s1 = cs[16 + k + 1];
                a[w] = pk2(x1l * c0 - x2l * s0, x1h * c1 - x2h * s1); bq[w] = pk2(x2l * c0 + x1l * s0, x2h * c1 + x1h * s1); }
            *(u32x4*)(p + 8 * h2) = a; *(u32x4*)(p + 16 + 8 * h2) = bq; }
    }
}

PHASE_FN phase_attn_naive(unsigned char* wsarg, LAS unsigned char* lds) {
    int BID = blockIdx.x, GSZ = ld_grid(); OPAQUE_S(BID); OPAQUE_S(GSZ); OPAQUE_S(lds);
    unsigned char* const WSQ = ld_ws(wsarg);
    int tid_o = threadIdx.x; OPAQUE_V(tid_o);
    const int tid = tid_o, lane = tid & 63, wave = __builtin_amdgcn_readfirstlane(tid >> 6);
    LAS float* qs = (LAS float*)(lds + wave * 2048); LAS float* ps = qs + 128;
    const bf16* U = (const bf16*)(WSQ + WS_BIG); bf16* AO = (bf16*)(WSQ + (ATT_FP8 ? WS_ATT : WS_CAT)); float* LSE = (float*)(WSQ + WS_LSE);
    const int gw = BID * 8 + wave, NGW = GSZ * 8;
    for (int it = gw; it < M * 12; it += NGW) {
        const int head = it % 12, m = it / 12, t = m % SEQ, g = head >> 2, d = g == 0 ? 1 : (g == 1 ? 4 : 16);
        { const unsigned qq = *(const unsigned*)(U + (size_t)m * NU + UQ + head * 128 + 2 * lane); qs[2 * lane] = __uint_as_float(qq << 16) * ATT_SCALE; qs[2 * lane + 1] = __uint_as_float(qq & 0xffff0000u) * ATT_SCALE; }
        WAVE_SYNC();
        float sc[3];
#pragma unroll
        for (int r = 0; r < 3; ++r) { const int j = lane + 64 * r; const bool ok = (j <= 128) && (t - j * d >= 0); float s = -INFINITY;
            if (ok) { const bf16* kr = U + (size_t)(m - j * d) * NU + UK + head * 128; s = 0.f;
                for (int c = 0; c < 16; ++c) { const u32x4 kv = *(const u32x4*)(kr + 8 * c);
#pragma unroll
                    for (int w = 0; w < 4; ++w) s += qs[8 * c + 2 * w] * __uint_as_float(kv[w] << 16) + qs[8 * c + 2 * w + 1] * __uint_as_float(kv[w] & 0xffff0000u); } }
            sc[r] = s; }
        const float mx = wave_max(fmaxf(fmaxf(sc[0], sc[1]), sc[2]), lane);
        float psum = 0.f;
#pragma unroll
        for (int r = 0; r < 3; ++r) { const int j = lane + 64 * r; const float p = (sc[r] == -INFINITY) ? 0.f : __expf(sc[r] - mx); psum += p; if (j <= 128) ps[j] = p; }
        const float den = wave_sum(psum, lane);
        WAVE_SYNC();
        float a0 = 0.f, a1 = 0.f;
        for (int j = 0; j <= 128; ++j) { if (t - j * d < 0) break; const float pj = ps[j]; const unsigned vv = *(const unsigned*)(U + (size_t)(m - j * d) * NU + UV + head * 128 + 2 * lane);
            a0 += pj * __uint_as_float(vv << 16); a1 += pj * __uint_as_float(vv & 0xffff0000u); }
        const float inv = 1.f / den;
        *(unsigned*)(AO + (size_t)m * ATT_PITCH + head * 128 + 2 * lane) = pk2(a0 * inv, a1 * inv);
        if (lane == 0) LSE[(size_t)m * 12 + head] = mx + __logf(den);
        WAVE_SYNC();
    }
}

constexpr int AK_STRIDE = 136, AV_STRIDE = 264;
constexpr int AL_K = 0, AL_V = 256 * AK_STRIDE * 2, AL_END = AL_V + 128 * AV_STRIDE * 2;
PHASE_FN phase_attn_mfma(unsigned char* wsarg, LAS unsigned char* lds) {
    int BID = blockIdx.x, GSZ = ld_grid(); OPAQUE_S(BID); OPAQUE_S(GSZ); OPAQUE_S(lds);
    unsigned char* const WSQ = ld_ws(wsarg);
    int tid_o = threadIdx.x; OPAQUE_V(tid_o);
    const int tid = tid_o, lane = tid & 63, wave = tid >> 6, li = lane & 15, q = lane >> 4;
    const bf16* U = (const bf16*)(WSQ + WS_BIG); bf16* AO = (bf16*)(WSQ + (ATT_FP8 ? WS_ATT : WS_CAT)); float* LSE = (float*)(WSQ + WS_LSE);
    LAS bf16* KS = (LAS bf16*)(lds + AL_K); LAS bf16* VT = (LAS bf16*)(lds + AL_V);
    constexpr int UPH = SEQ / 128, NUNITS = BATCH * 12 * UPH;
    const int per = (NUNITS + (int)GSZ - 1) / (int)GSZ;
    const int u_lo = (int)BID * per, u_hi = (u_lo + per < NUNITS) ? u_lo + per : NUNITS;
    for (int uid = u_lo; uid < u_hi; ++uid) {
        const int idx = uid % UPH, bh = uid / UPH, head = bh % 12, b = bh / 12, g = head >> 2, dsh = 2 * g, d = 1 << dsh;
        const int nblk = UPH >> dsh, r = idx / nblk, n = idx % nblk, u0 = 128 * n;
        const size_t rowbase = (size_t)b * SEQ + r;
#pragma unroll
        for (int i = 0; i < 4; ++i) { const int pidx = tid + 512 * i, rp = pidx >> 4, ch = pidx & 15, k0 = 2 * rp;
            u32x4 ka = {0u, 0u, 0u, 0u}, kb = ka, va = ka, vb = ka;
            if (n > 0 || k0 >= 128) { const bf16* r0 = U + (rowbase + (size_t)(u0 - 128 + k0) * d) * NU + head * 128 + 8 * ch; const bf16* r1 = r0 + (size_t)d * NU;
                ka = *(const u32x4*)(r0 + UK); kb = *(const u32x4*)(r1 + UK); va = *(const u32x4*)(r0 + UV); vb = *(const u32x4*)(r1 + UV); }
            *(LAS u32x4*)(KS + k0 * AK_STRIDE + 8 * ch) = ka; *(LAS u32x4*)(KS + (k0 + 1) * AK_STRIDE + 8 * ch) = kb;
#pragma unroll
            for (int w = 0; w < 4; ++w) {
                *(LAS unsigned*)(VT + (8 * ch + 2 * w) * AV_STRIDE + k0) = (va[w] & 0xffffu) | (vb[w] << 16);
                *(LAS unsigned*)(VT + (8 * ch + 2 * w + 1) * AV_STRIDE + k0) = (va[w] >> 16) | (vb[w] & 0xffff0000u); } }
        int qi_o = 16 * wave + li; OPAQUE_V(qi_o);
        const int qi = qi_o; const size_t qrow = rowbase + (size_t)(u0 + qi) * d;
        bf16x8 qf[4];
#pragma unroll
        for (int ks = 0; ks < 4; ++ks) qf[ks] = *(const bf16x8*)(U + qrow * NU + UQ + head * 128 + 32 * ks + 8 * q);
        __syncthreads();
        f32x4 st[10]; float mx = -INFINITY; const int lb = (n > 0) ? qi : max(qi, 128);
#pragma unroll
        for (int t = 0; t < 9; ++t) { const int kt = wave + t; f32x4 a = {0.f, 0.f, 0.f, 0.f};
#pragma unroll
            for (int ks = 0; ks < 4; ++ks) { const bf16x8 kf = *(const LAS bf16x8*)(KS + (16 * kt + li) * AK_STRIDE + 32 * ks + 8 * q); a = __builtin_amdgcn_mfma_f32_16x16x32_bf16(kf, qf[ks], a, 0, 0, 0); }
#pragma unroll
            for (int e = 0; e < 4; ++e) { const int ki = 16 * kt + 4 * q + e;
                const int m01 = min(max(ki - lb + 1, 0), 1) * min(max(qi + 129 - ki, 0), 1); a[e] = fmaf(a[e], ATT_SCALE, (float)(m01 - 1) * 1e30f); mx = fmaxf(mx, a[e]); }
            st[t] = a; }
        st[9] = (f32x4){0.f, 0.f, 0.f, 0.f};
        mx = fmaxf(mx, shfl_f(mx, lane ^ 16)); mx = fmaxf(mx, shfl_f(mx, lane ^ 32));
        float den = 0.f;
#pragma unroll
        for (int t = 0; t < 9; ++t)
#pragma unroll
            for (int e = 0; e < 4; ++e) { const float p = __expf(st[t][e] - mx); st[t][e] = p; den += p; }
        den += shfl_f(den, lane ^ 16); den += shfl_f(den, lane ^ 32);
        f32x4 oacc[8];
#pragma unroll
        for (int dt = 0; dt < 8; ++dt) oacc[dt] = (f32x4){0.f, 0.f, 0.f, 0.f};
#pragma unroll
        for (int a = 0; a < 5; ++a) { u32x4 pw; pw.x = pg8::cvt_pk_bf16(st[2 * a][0], st[2 * a][1]); pw.y = pg8::cvt_pk_bf16(st[2 * a][2], st[2 * a][3]); pw.z = pg8::cvt_pk_bf16(st[2 * a + 1][0], st[2 * a + 1][1]); pw.w = pg8::cvt_pk_bf16(st[2 * a + 1][2], st[2 * a + 1][3]);
            const bf16x8 pf = __builtin_bit_cast(bf16x8, pw);
            const int ke = 16 * (wave + 2 * a) + 4 * q, ko = (a < 4) ? ke + 16 : ke;
#pragma unroll
            for (int dt = 0; dt < 8; ++dt) { const s16x4 lo = *(const LAS s16x4*)(VT + (16 * dt + li) * AV_STRIDE + ke), hi = *(const LAS s16x4*)(VT + (16 * dt + li) * AV_STRIDE + ko);
                const bf16x8 vf = __builtin_shufflevector(lo, hi, 0, 1, 2, 3, 4, 5, 6, 7); oacc[dt] = __builtin_amdgcn_mfma_f32_16x16x32_bf16(vf, pf, oacc[dt], 0, 0, 0); } }
        const float inv = rcp_f(den);
        bf16* orow = AO + qrow * ATT_PITCH + head * 128 + 4 * q;
#pragma unroll
        for (int dt = 0; dt < 8; ++dt) { u32x2 w; w.x = pg8::cvt_pk_bf16(oacc[dt][0] * inv, oacc[dt][1] * inv); w.y = pg8::cvt_pk_bf16(oacc[dt][2] * inv, oacc[dt][3] * inv); *(u32x2*)(orow + 16 * dt) = w; }
        if (q == 0) LSE[qrow * 12 + head] = mx + __logf(den);
        __syncthreads();
    }
}
PHASE_FN phase_attn_mix(unsigned char* wsarg) {
    int BID = blockIdx.x, GSZ = ld_grid(); OPAQUE_S(BID); OPAQUE_S(GSZ);
    unsigned char* const WSQ = ld_ws(wsarg);
    bf16* CAT = (bf16*)(WSQ + WS_CAT); const float* LSE = (const float*)(WSQ + WS_LSE);
    int tid_o = threadIdx.x; OPAQUE_V(tid_o);
    const size_t gt = (size_t)BID * 512 + tid_o, GT = (size_t)GSZ * 512;
    for (size_t i = gt; i < (size_t)M * 64; i += GT) {
        const int m = (int)(i >> 6), h = (int)((i >> 4) & 3), ch = (int)(i & 15);
        const float l0 = LSE[(size_t)m * 12 + h], l1 = LSE[(size_t)m * 12 + 4 + h], l2 = LSE[(size_t)m * 12 + 8 + h];
        const float mx = fmaxf(l0, fmaxf(l1, l2)); const float e0 = __expf(l0 - mx), e1 = __expf(l1 - mx), e2 = __expf(l2 - mx); const float inv = rcp_f(e0 + e1 + e2);
#pragma unroll
        for (int g = 0; g < 3; ++g) { const float wg_ = (g == 0 ? e0 : (g == 1 ? e1 : e2)) * inv;
            if (ATT_FP8) { const u32x4 v = *(const u32x4*)((const bf16*)(WSQ + WS_ATT) + (size_t)m * 1536 + (g * 4 + h) * 128 + ch * 8); const float w16 = wg_ * 16.f; u32x2 o8;
                o8.x = pk4_fp8(__uint_as_float(v[0] << 16) * w16, __uint_as_float(v[0] & 0xffff0000u) * w16, __uint_as_float(v[1] << 16) * w16, __uint_as_float(v[1] & 0xffff0000u) * w16);
                o8.y = pk4_fp8(__uint_as_float(v[2] << 16) * w16, __uint_as_float(v[2] & 0xffff0000u) * w16, __uint_as_float(v[3] << 16) * w16, __uint_as_float(v[3] & 0xffff0000u) * w16);
                *(u32x2*)((unsigned char*)CAT + (size_t)m * (CAT_PITCH * 2) + (g * 4 + h) * 128 + ch * 8) = o8; }
            else { u32x4* p = (u32x4*)(CAT + (size_t)m * CAT_PITCH + (g * 4 + h) * 128 + ch * 8); u32x4 v = *p;
#pragma unroll
                for (int k = 0; k < 4; ++k) v[k] = pk2(__uint_as_float(v[k] << 16) * wg_, __uint_as_float(v[k] & 0xffff0000u) * wg_);
                *p = v; } }
    }
}

PHASE_FN phase_shortconv(unsigned char* wsarg, int L, LAS unsigned char* lds) {
    int BID = blockIdx.x, GSZ = ld_grid(); OPAQUE_S(BID); OPAQUE_S(GSZ); OPAQUE_S(lds);
    unsigned char* const WSQ = ld_ws(wsarg);
    const bf16* U = (const bf16*)(WSQ + WS_BIG); bf16* CAT = (bf16*)(WSQ + WS_CAT); const float* w = inp(lds, I_SCW) + (size_t)L * 3 * 1024;
    int tid_o = threadIdx.x; OPAQUE_V(tid_o);
    const size_t gt = (size_t)BID * 512 + tid_o, GT = (size_t)GSZ * 512;
    for (size_t i = gt; i < (size_t)M * 128; i += GT) {
        const int m = (int)(i >> 7), c0 = (int)(i & 127) * 8, t = m % SEQ;
        float acc[8];
#pragma unroll
        for (int e = 0; e < 8; ++e) acc[e] = 0.f;
#pragma unroll
        for (int k = 0; k < 3; ++k) { if (t - 2 + k < 0) continue; const bf16* r = U + (size_t)(m - 2 + k) * NU;
            const u32x4 cw = *(const u32x4*)(r + USC + c0), hw = *(const u32x4*)(r + USH + c0);
#pragma unroll
            for (int q = 0; q < 4; ++q) { acc[2 * q] += w[k * 1024 + c0 + 2 * q] * (__uint_as_float(cw[q] << 16) * __uint_as_float(hw[q] << 16));
                acc[2 * q + 1] += w[k * 1024 + c0 + 2 * q + 1] * (__uint_as_float(cw[q] & 0xffff0000u) * __uint_as_float(hw[q] & 0xffff0000u)); } }
        const u32x4 bw = *(const u32x4*)(U + (size_t)m * NU + USB + c0); u32x4 ow;
#pragma unroll
        for (int q = 0; q < 4; ++q) ow[q] = pk2(acc[2 * q] * __uint_as_float(bw[q] << 16), acc[2 * q + 1] * __uint_as_float(bw[q] & 0xffff0000u));
        *(u32x4*)(CAT + (size_t)m * CAT_PITCH + CAT_SC + c0) = ow;
    }
}

PHASE_FN phase_conv(unsigned char* wsarg, int L, LAS unsigned char* lds) {
    unsigned char* const WSQ = ld_ws(wsarg);
    int BID = blockIdx.x, GSZ = ld_grid(); OPAQUE_S(BID); OPAQUE_S(GSZ);
    int tid_o = threadIdx.x; OPAQUE_V(tid_o);
    const bf16* U = (const bf16*)(WSQ + WS_BIG); bf16* XC = (bf16*)(WSQ + WS_XC);
    const float* cw = inp(lds, I_CW) + (size_t)L * 4 * 2560; const float* cbv = inp(lds, I_CB) + (size_t)L * 2560;
    const size_t gt = (size_t)BID * 512 + tid_o, GT = (size_t)GSZ * 512;
    for (size_t i = gt; i < (size_t)(M / 16) * 320; i += GT) {
        const int rb = (int)(i / 320), c0 = (int)(i % 320) * 8, m0 = rb * 16, t0 = m0 % SEQ;
        float w[4][8], bs[8];
#pragma unroll
        for (int k = 0; k < 4; ++k) { const f32x4 a0 = *(const f32x4*)(cw + k * 2560 + c0), a1 = *(const f32x4*)(cw + k * 2560 + c0 + 4);
#pragma unroll
            for (int e = 0; e < 4; ++e) { w[k][e] = a0[e]; w[k][4 + e] = a1[e]; } }
        { const f32x4 a0 = *(const f32x4*)(cbv + c0), a1 = *(const f32x4*)(cbv + c0 + 4);
#pragma unroll
          for (int e = 0; e < 4; ++e) { bs[e] = a0[e]; bs[4 + e] = a1[e]; } }
        u32x4 raw[19];
#pragma unroll
        for (int r = 0; r < 19; ++r) raw[r] = (r >= 3 || t0 > 0) ? *(const u32x4*)(U + (size_t)(m0 + r - 3) * NU + UX + c0) : (u32x4){0u, 0u, 0u, 0u};
#pragma unroll
        for (int r = 0; r < 16; ++r) { u32x4 o;
#pragma unroll
            for (int e2 = 0; e2 < 4; ++e2) { float lo = bs[2 * e2], hi = bs[2 * e2 + 1];
#pragma unroll
                for (int k = 0; k < 4; ++k) { const unsigned x = raw[r + k][e2]; lo += w[k][2 * e2] * __uint_as_float(x << 16); hi += w[k][2 * e2 + 1] * __uint_as_float(x & 0xffff0000u); }
                o[e2] = pk2(silu_f(lo), silu_f(hi)); }
            *(u32x4*)(XC + (size_t)(m0 + r) * 2560 + c0) = o; }
    }
}
constexpr int BI_STRIDE = 136, XI_STRIDE = 72;
constexpr int SL_DT = 0, SL_ACS = 4096, SL_BI = 8192, SL_CI = SL_BI + 128 * BI_STRIDE * 2, SL_XI = SL_CI + 128 * BI_STRIDE * 2, SL_PV = SL_XI + 128 * XI_STRIDE * 2, SL_END = SL_PV + 64 * 136 * 2;
constexpr int SL_XI2 = SL_CI;
static_assert(SL_END <= RING_BYTES, "SSD LDS");
DI void ssd_dt_scan(int L, const bf16* U, int m0, int g, LAS unsigned char* lds, int wave, int lane) {
    LAS float* DT = (LAS float*)(lds + SL_DT); LAS float* ACS = (LAS float*)(lds + SL_ACS);
    if (wave < 6) { const int h = g * 6 + wave; const float bias = inp(lds, I_DTB)[L * 24 + h], a = -__expf(inp(lds, I_ALOG)[L * 24 + h]);
        const float d0 = softplus_f(bf2f(U[(size_t)(m0 + lane) * NU + UDT + h]) + bias), d1 = softplus_f(bf2f(U[(size_t)(m0 + 64 + lane) * NU + UDT + h]) + bias);
        float c0 = d0 * a, c1 = d1 * a;
#pragma unroll
        for (int o = 1; o < 64; o <<= 1) { const int src = lane >= o ? lane - o : lane; const float u0 = shfl_f(c0, src), u1 = shfl_f(c1, src); if (lane >= o) { c0 += u0; c1 += u1; } }
        c1 += shfl_f(c0, 63);
        DT[lane * 8 + wave] = d0; DT[(64 + lane) * 8 + wave] = d1; ACS[lane * 8 + wave] = c0; ACS[(64 + lane) * 8 + wave] = c1; }
}
PHASE_FN phase_ssd_states(unsigned char* wsarg, int L, LAS unsigned char* lds) {
    unsigned char* const WSQ = ld_ws(wsarg);
    int BID = blockIdx.x, GSZ = ld_grid(); OPAQUE_S(BID); OPAQUE_S(GSZ); OPAQUE_S(lds);
    int tid_o = threadIdx.x; OPAQUE_V(tid_o);
    const int tid = tid_o, lane = tid & 63, wave = tid >> 6, li = lane & 15, q = lane >> 4;
    const bf16* U = (const bf16*)(WSQ + WS_BIG); const bf16* XC = (const bf16*)(WSQ + WS_XC); float* ST = (float*)(WSQ + WS_BIG + BIG_U_BYTES); float* CD = (float*)(WSQ + WS_CD);
    LAS float* DT = (LAS float*)(lds + SL_DT); LAS float* ACS = (LAS float*)(lds + SL_ACS); LAS bf16* BI = (LAS bf16*)(lds + SL_BI);
    for (int it = BID; it < BATCH * NCH * 4; it += GSZ) {
        const int g = it & 3, c = (it >> 2) % NCH, b = (it >> 2) / NCH, m0 = b * SEQ + c * 128;
        ssd_dt_scan(L, U, m0, g, lds, wave, lane);
#pragma unroll
        for (int i = 0; i < 4; ++i) { const int ci = tid + 512 * i, row = ci >> 4, ch = ci & 15; *(LAS u32x4*)(BI + row * BI_STRIDE + 8 * ch) = *(const u32x4*)(XC + (size_t)(m0 + row) * 2560 + 1536 + g * 128 + 8 * ch); }
        __syncthreads();
        bf16x8 bfr[4];
#pragma unroll
        for (int ks = 0; ks < 4; ++ks) { const LAS bf16* p0 = BI + (32 * ks + 8 * q + (li >> 2)) * BI_STRIDE + 16 * wave + 4 * (li & 3); bfr[ks] = tr_read2(p0, p0 + 4 * BI_STRIDE); }
        u32x4 xr[2];
#pragma unroll
        for (int i = 0; i < 2; ++i) { const int ci = tid + 512 * i; xr[i] = *(const u32x4*)(XC + (size_t)(m0 + (ci >> 3)) * 2560 + (g * 6) * 64 + 8 * (ci & 7)); }
#pragma unroll 1
        for (int j = 0; j < 6; ++j) { const int h = g * 6 + j; LAS bf16* XI = (LAS bf16*)(lds + ((j & 1) ? SL_XI2 : SL_XI));
            { const float alast = ACS[127 * 8 + j];
#pragma unroll
              for (int i = 0; i < 2; ++i) { const int ci = tid + 512 * i, row = ci >> 3, ch = ci & 7;
                  const float wgt = DT[row * 8 + j] * __expf(alast - ACS[row * 8 + j]); u32x4 o;
#pragma unroll
                  for (int e = 0; e < 4; ++e) o[e] = pk2(__uint_as_float(xr[i][e] << 16) * wgt, __uint_as_float(xr[i][e] & 0xffff0000u) * wgt);
                  *(LAS u32x4*)(XI + row * XI_STRIDE + 8 * ch) = o; } }
            __syncthreads();
            if (j < 5) {
#pragma unroll
                for (int i = 0; i < 2; ++i) { const int ci = tid + 512 * i; xr[i] = *(const u32x4*)(XC + (size_t)(m0 + (ci >> 3)) * 2560 + (h + 1) * 64 + 8 * (ci & 7)); } }
            f32x4 acc[4];
#pragma unroll
            for (int pb = 0; pb < 4; ++pb) acc[pb] = (f32x4){0.f, 0.f, 0.f, 0.f};
#pragma unroll
            for (int ks = 0; ks < 4; ++ks)
#pragma unroll
                for (int pb = 0; pb < 4; ++pb) { const LAS bf16* p0 = XI + (32 * ks + 8 * q + (li >> 2)) * XI_STRIDE + 16 * pb + 4 * (li & 3); const bf16x8 afr = tr_read2(p0, p0 + 4 * XI_STRIDE);
                    acc[pb] = __builtin_amdgcn_mfma_f32_16x16x32_bf16(afr, bfr[ks], acc[pb], 0, 0, 0); }
            float* st = ST + ((size_t)((b * NCH + c) * 24 + h) * 64) * 128;
#pragma unroll
            for (int pb = 0; pb < 4; ++pb)
#pragma unroll
                for (int r = 0; r < 4; ++r) st[(size_t)(16 * pb + 4 * q + r) * 128 + 16 * wave + li] = acc[pb][r];
            if (tid == 0) CD[(b * NCH + c) * 24 + h] = __expf(ACS[127 * 8 + j]);
        }
        __syncthreads();
    }
}
PHASE_FN phase_ssd_scan(unsigned char* wsarg, bool dry = false) {
    unsigned char* const WSQ = ld_ws(wsarg);
    int BID = blockIdx.x, GSZ = ld_grid(); OPAQUE_S(BID); OPAQUE_S(GSZ);
    const float* ST = (const float*)(WSQ + WS_BIG + BIG_U_BYTES); const float* CD = (const float*)(WSQ + WS_CD); bf16* SO = dry ? (bf16*)(WSQ + WS_XF) : (bf16*)(WSQ + WS_PVB);
    int tid_o = threadIdx.x; OPAQUE_V(tid_o);
    const size_t gt = (size_t)BID * 512 + tid_o, GT = (size_t)GSZ * 512;
    static_assert(NCH % 8 == 0, "scan batch");
    for (size_t e = gt; e < (size_t)BATCH * 24 * 2048; e += GT) {
        const int b = (int)(e / (24 * 2048)), rem4 = (int)(e % (24 * 2048)), h = rem4 >> 11;
        f32x4 hs = {0.f, 0.f, 0.f, 0.f};
#pragma unroll 1
        for (int c0 = 0; c0 < NCH; c0 += 8) { f32x4 v[8]; float cd[8];
#pragma unroll
            for (int k = 0; k < 8; ++k) { v[k] = *(const f32x4*)(ST + ((size_t)(b * NCH + c0 + k) * 24 * 2048 + rem4) * 4); cd[k] = CD[(b * NCH + c0 + k) * 24 + h]; }
#pragma unroll
            for (int k = 0; k < 8; ++k) { u32x2 w; w.x = pk2(hs[0], hs[1]); w.y = pk2(hs[2], hs[3]); *(u32x2*)(SO + ((size_t)(b * NCH + c0 + k) * 24 * 2048 + rem4) * 4) = w; hs = hs * cd[k] + v[k]; } }
    }
}
PHASE_FN phase_ssd_out(unsigned char* wsarg, int L, LAS unsigned char* lds) {
    int BID = blockIdx.x, GSZ = ld_grid(); OPAQUE_S(BID); OPAQUE_S(GSZ); OPAQUE_S(lds);
    unsigned char* const WSQ = ld_ws(wsarg);
    int tid_o = threadIdx.x; OPAQUE_V(tid_o);
    const int tid = tid_o, lane = tid & 63, wave = tid >> 6, li = lane & 15, q = lane >> 4;
    const bf16* U = (const bf16*)(WSQ + WS_BIG); const bf16* XC = (const bf16*)(WSQ + WS_XC); const bf16* PVB = (const bf16*)(WSQ + WS_PVB); bf16* CAT = (bf16*)(WSQ + WS_CAT);
    const float* nw = inp(lds, I_NW) + (size_t)L * 1536;
    LAS float* DT = (LAS float*)(lds + SL_DT); LAS float* ACS = (LAS float*)(lds + SL_ACS); LAS bf16* CC = (LAS bf16*)(lds + SL_CI); LAS bf16* BC = (LAS bf16*)(lds + SL_BI);
    LAS bf16* XI = (LAS bf16*)(lds + SL_XI); LAS bf16* PV = (LAS bf16*)(lds + SL_PV);
    for (int it = BID; it < BATCH * NCH * 4; it += GSZ) {
        const int g = it & 3, c = (it >> 2) % NCH, b = (it >> 2) / NCH, m0 = b * SEQ + c * 128;
        u32x4 xr[2], pr[2];
#pragma unroll
        for (int i = 0; i < 2; ++i) { const int ci = tid + 512 * i; xr[i] = *(const u32x4*)(XC + (size_t)(m0 + (ci >> 3)) * 2560 + (g * 6) * 64 + 8 * (ci & 7)); pr[i] = *(const u32x4*)(PVB + (size_t)((b * NCH + c) * 24 + g * 6) * 8192 + 8 * ci); }
        ssd_dt_scan(L, U, m0, g, lds, wave, lane);
#pragma unroll
        for (int i = 0; i < 4; ++i) { const int ci = tid + 512 * i, row = ci >> 4, ch = ci & 15; const bf16* src = XC + (size_t)(m0 + row) * 2560 + 1536 + g * 128 + 8 * ch;
            *(LAS u32x4*)(BC + row * BI_STRIDE + 8 * ch) = *(const u32x4*)src; *(LAS u32x4*)(CC + row * BI_STRIDE + 8 * ch) = *(const u32x4*)(src + 512); }
        __syncthreads();
        float* YS = (float*)(WSQ + WS_YS) + (size_t)BID * (6 * 16 * 512) + tid; float ssq[4] = {0.f, 0.f, 0.f, 0.f};
#pragma unroll 1
        for (int j = 0; j < 6; ++j) { const int h = g * 6 + j;
#pragma unroll
            for (int i = 0; i < 2; ++i) { const int ci = tid + 512 * i, row = ci >> 3, ch = ci & 7; const float wgt = DT[row * 8 + j]; u32x4 o;
#pragma unroll
                for (int e = 0; e < 4; ++e) o[e] = pk2(__uint_as_float(xr[i][e] << 16) * wgt, __uint_as_float(xr[i][e] & 0xffff0000u) * wgt);
                *(LAS u32x4*)(XI + row * XI_STRIDE + 8 * ch) = o; *(LAS u32x4*)(PV + (ci >> 4) * 136 + 8 * (ci & 15)) = pr[i]; }
            __syncthreads();
            if (j < 5) {
#pragma unroll
                for (int i = 0; i < 2; ++i) { const int ci = tid + 512 * i; xr[i] = *(const u32x4*)(XC + (size_t)(m0 + (ci >> 3)) * 2560 + (h + 1) * 64 + 8 * (ci & 7)); pr[i] = *(const u32x4*)(PVB + (size_t)((b * NCH + c) * 24 + h + 1) * 8192 + 8 * ci); } }
            unsigned short zr[16];
#pragma unroll
            for (int pb = 0; pb < 4; ++pb)
#pragma unroll
                for (int r = 0; r < 4; ++r) zr[pb * 4 + r] = U[(size_t)(m0 + 16 * wave + 4 * q + r) * NU + UZ + h * 64 + 16 * pb + li];
            f32x4 acc[4];
#pragma unroll
            for (int pb = 0; pb < 4; ++pb) acc[pb] = (f32x4){0.f, 0.f, 0.f, 0.f};
#pragma unroll
            for (int ks = 0; ks < 4; ++ks) { const bf16x8 afr = *(const LAS bf16x8*)(CC + (16 * wave + li) * 136 + 32 * ks + 8 * q);
#pragma unroll
                for (int pb = 0; pb < 4; ++pb) { const bf16x8 bfr = *(const LAS bf16x8*)(PV + (16 * pb + li) * 136 + 32 * ks + 8 * q); acc[pb] = __builtin_amdgcn_mfma_f32_16x16x32_bf16(afr, bfr, acc[pb], 0, 0, 0); } }
#pragma unroll
            for (int r = 0; r < 4; ++r) { const float e = __expf(ACS[(16 * wave + 4 * q + r) * 8 + j]);
#pragma unroll
                for (int pb = 0; pb < 4; ++pb) acc[pb][r] *= e; }
            int l_o = 16 * wave + li; OPAQUE_V(l_o); const int l_a = l_o; const float acs_l = ACS[l_a * 8 + j];
            const float ddt = inp(lds, I_SD)[L * 24 + h] * rcp_f(DT[l_a * 8 + j]);
#pragma unroll
            for (int ks2 = 0; ks2 < 4; ++ks2) {
                if (2 * ks2 <= wave) {
                    f32x4 c0 = {0.f, 0.f, 0.f, 0.f}, c1 = {0.f, 0.f, 0.f, 0.f};
#pragma unroll
                    for (int ks = 0; ks < 4; ++ks) { const bf16x8 bfr = *(const LAS bf16x8*)(CC + (16 * wave + li) * 136 + 32 * ks + 8 * q);
                        const bf16x8 a0 = *(const LAS bf16x8*)(BC + (32 * ks2 + li) * 136 + 32 * ks + 8 * q), a1 = *(const LAS bf16x8*)(BC + (32 * ks2 + 16 + li) * 136 + 32 * ks + 8 * q);
                        c0 = __builtin_amdgcn_mfma_f32_16x16x32_bf16(a0, bfr, c0, 0, 0, 0); c1 = __builtin_amdgcn_mfma_f32_16x16x32_bf16(a1, bfr, c1, 0, 0, 0); }
                    bf16x8 afr;
#pragma unroll
                    for (int e = 0; e < 8; ++e) { const int s = 32 * ks2 + (e < 4 ? 4 * q + e : 16 + 4 * q + (e - 4)); const float cbv_ = e < 4 ? c0[e & 3] : c1[e & 3];
                        const float gv = cbv_ * __expf(fminf(acs_l - ACS[s * 8 + j], 0.f)) * (float)min(max(l_a - s + 1, 0), 1) + ddt * (float)(1 - min(abs(l_a - s), 1)); afr[e] = (short)f2bf(gv); }
#pragma unroll
                    for (int pb = 0; pb < 4; ++pb) { const LAS bf16* p0 = XI + (32 * ks2 + 4 * q + (li >> 2)) * XI_STRIDE + 16 * pb + 4 * (li & 3);
                        const bf16x8 bfr = tr_read2(p0, p0 + 16 * XI_STRIDE); acc[pb] = __builtin_amdgcn_mfma_f32_16x16x32_bf16(afr, bfr, acc[pb], 0, 0, 0); } } }
#pragma unroll
            for (int pb = 0; pb < 4; ++pb)
#pragma unroll
                for (int r = 0; r < 4; ++r) { const float y = acc[pb][r] * silu_f(bf2f(zr[pb * 4 + r]));
                    YS[(j * 16 + pb * 4 + r) * 512] = y; ssq[r] += y * y; }
            __syncthreads();
        }
#pragma unroll
        for (int r = 0; r < 4; ++r) { float s = ssq[r]; s += shfl_f(s, lane ^ 1); s += shfl_f(s, lane ^ 2); s += shfl_f(s, lane ^ 4); s += shfl_f(s, lane ^ 8); ssq[r] = __builtin_amdgcn_rsqf(s * (1.f / 384.f) + RMS_EPS); }
#pragma unroll 1
        for (int j = 0; j < 6; ++j)
#pragma unroll
            for (int pb = 0; pb < 4; ++pb)
#pragma unroll
                for (int r = 0; r < 4; ++r) { const int l = 16 * wave + 4 * q + r, ch = (g * 6 + j) * 64 + 16 * pb + li; CAT[(size_t)(m0 + l) * CAT_PITCH + CAT_SSM + ch] = f2bf(YS[(j * 16 + pb * 4 + r) * 512] * ssq[r] * nw[ch]); }
    }
}

static_assert(DM % 1024 == 0, "phase_resln: DM must be a multiple of 1024");
template <bool GATE> PHASE_FN phase_resln(unsigned char* wsarg, float* outarg, int L, int which, LAS unsigned char* lds, bool dry = false) {
    unsigned char* const WSQ = ld_ws(wsarg);
    const float* x32 = (L == 0 && which == 0) ? inp(lds, I_X) : nullptr;
    bf16* xb = (bf16*)(WSQ + WS_XB); const bf16* fb = (const bf16*)(WSQ + WS_XF); const bf16* emb = (const bf16*)(WSQ + WS_EMB);
    float* out32 = (L == DEPTH - 1 && which == 2 && !dry) ? ld_out(outarg) : nullptr; bf16* xo = dry ? (bf16*)(WSQ + WS_CAT) : xb;
    const float* gam = inp(lds, which == 0 ? I_L1G : (which == 1 ? I_L2G : I_L3G)) + (size_t)L * DM; const float* bet = inp(lds, which == 0 ? I_L1B : (which == 1 ? I_L2B : I_L3B)) + (size_t)L * DM;
    int BID = blockIdx.x, GSZ = ld_grid(); OPAQUE_S(BID); OPAQUE_S(GSZ);
    int tid_o = threadIdx.x; OPAQUE_V(tid_o);
    const int lane = tid_o & 63, wave = __builtin_amdgcn_readfirstlane(tid_o >> 6), pair = wave >> 1, half = wave & 1;
    const bool q8 = (((which == 0) && ((UP_INT8 >> L) & 1)) || ((which == 1) && GATE_INT8) || ((which == 2) && L + 1 < DEPTH && ((IN_INT8 >> (L + 1)) & 1))) && !dry;
    unsigned char* const q8dst = WSQ + (which == 2 ? WS_X8I : WS_X8);
    LAS float* RS = (LAS float*)lds; LAS float* RQ = RS + 8;
    constexpr int NJ = DM / 1024;
    const int niter = (M + 4 * GSZ - 1) / (4 * GSZ);
    for (int itn = 0; itn < niter; ++itn) {
        const int m = (itn * GSZ + BID) * 4 + pair; const bool live = m < M;
        float v[NJ][8]; float s = 0.f;
        if (live) {
#pragma unroll
        for (int j = 0; j < NJ; ++j) { const size_t o = (size_t)m * DM + (size_t)((half * NJ + j) * 64 + lane) * 8;
            float xv[8];
            if (x32) { const f32x4 a = NT_LOAD((const f32x4*)(x32 + o)), b = NT_LOAD((const f32x4*)(x32 + o + 4)); xv[0] = a[0]; xv[1] = a[1]; xv[2] = a[2]; xv[3] = a[3]; xv[4] = b[0]; xv[5] = b[1]; xv[6] = b[2]; xv[7] = b[3]; }
            else { const u32x4 a = NT_LOAD((const u32x4*)(xb + o));
#pragma unroll
                for (int k = 0; k < 4; ++k) { xv[2 * k] = __uint_as_float(a[k] << 16); xv[2 * k + 1] = __uint_as_float(a[k] & 0xffff0000u); } }
            const u32x4 f = NT_LOAD((const u32x4*)(fb + o)); float fv[8];
#pragma unroll
            for (int k = 0; k < 4; ++k) { fv[2 * k] = __uint_as_float(f[k] << 16); fv[2 * k + 1] = __uint_as_float(f[k] & 0xffff0000u); }
            if (GATE) { const u32x4 e = NT_LOAD((const u32x4*)(emb + o));
#pragma unroll
                for (int k = 0; k < 4; ++k) { fv[2 * k] = __uint_as_float(e[k] << 16) * rcp_f(1.f + __expf(-fv[2 * k])); fv[2 * k + 1] = __uint_as_float(e[k] & 0xffff0000u) * rcp_f(1.f + __expf(-fv[2 * k + 1])); } }
#pragma unroll
            for (int k = 0; k < 8; ++k) { v[j][k] = DN_ALPHA * xv[k] + fv[k]; s += v[j][k]; } }
        }
        s = wave_sum(s, lane); if (lane == 0) RS[pair * 2 + half] = s;
        __syncthreads();
        const float mean = (RS[pair * 2] + RS[pair * 2 + 1]) * (1.f / DM); float s2 = 0.f;
        if (live) {
#pragma unroll
        for (int j = 0; j < NJ; ++j)
#pragma unroll
            for (int k = 0; k < 8; ++k) { v[j][k] -= mean; s2 += v[j][k] * v[j][k]; }
        }
        s2 = wave_sum(s2, lane); if (lane == 0) RQ[pair * 2 + half] = s2;
        __syncthreads();
        const float rstd = __builtin_amdgcn_rsqf((RQ[pair * 2] + RQ[pair * 2 + 1]) * (1.f / DM) + LN_EPS);
        float ymax = 0.f;
        if (live) {
#pragma unroll
        for (int j = 0; j < NJ; ++j) { const size_t c = (size_t)((half * NJ + j) * 64 + lane) * 8, o = (size_t)m * DM + c;
            const f32x4 g0 = *(const f32x4*)(gam + c), g1 = *(const f32x4*)(gam + c + 4), b0 = *(const f32x4*)(bet + c), b1 = *(const f32x4*)(bet + c + 4);
            float y[8];
#pragma unroll
            for (int k = 0; k < 4; ++k) { y[k] = v[j][k] * rstd * g0[k] + b0[k]; y[4 + k] = v[j][4 + k] * rstd * g1[k] + b1[k]; }
            if (out32) { *(f32x4*)(out32 + o) = (f32x4){y[0], y[1], y[2], y[3]}; *(f32x4*)(out32 + o + 4) = (f32x4){y[4], y[5], y[6], y[7]}; }
            else { u32x4 w; w.x = pk2(y[0], y[1]); w.y = pk2(y[2], y[3]); w.z = pk2(y[4], y[5]); w.w = pk2(y[6], y[7]); *(u32x4*)(xo + o) = w;
                   if ((GATE_FP8 && !GATE_INT8 && which == 1) || (QKV_FP8 && which == 2)) { u32x2 w8; w8.x = pk4_fp8(y[0], y[1], y[2], y[3]); w8.y = pk4_fp8(y[4], y[5], y[6], y[7]); *(u32x2*)(WSQ + WS_X8 + o) = w8; } }
            if (q8) {
#pragma unroll
                for (int k = 0; k < 8; ++k) { v[j][k] = y[k]; ymax = fmaxf(ymax, fabsf(y[k])); } } }
        }
        if (q8) {
            ymax = wave_max(ymax, lane); if (lane == 0) RS[16 + pair * 2 + half] = ymax;
            __syncthreads();
            const float rmx = fmaxf(fmaxf(RS[16 + pair * 2], RS[16 + pair * 2 + 1]), 1e-30f), iv = 127.f / rmx;
            if (live) {
#pragma unroll
                for (int j = 0; j < NJ; ++j) { const size_t o = (size_t)m * DM + (size_t)((half * NJ + j) * 64 + lane) * 8; u32x2 w8;
                    unsigned a = 0, b = 0;
#pragma unroll
                    for (int k = 0; k < 4; ++k) { a |= ((unsigned)(__float2int_rn(v[j][k] * iv) & 0xff)) << (8 * k); b |= ((unsigned)(__float2int_rn(v[j][4 + k] * iv) & 0xff)) << (8 * k); }
                    w8.x = a; w8.y = b; *(u32x2*)(q8dst + o) = w8; }
                if (half == 0 && lane == 0) ((float*)(WSQ + WS_SA))[m] = rmx * (1.f / 127.f); }
        }
    }
    __syncthreads();
}

constexpr int PH_PER_LAYER = 13, N_PHASES = DEPTH * PH_PER_LAYER;
#ifndef REP_G3
#define REP_G3 1
#endif
#ifndef REP_G4
#define REP_G4 1
#endif
#ifndef REP_SCAN
#define REP_SCAN 1
#endif
#ifndef REP_MISC
#define REP_MISC 1
#endif
#ifndef REP_BAR
#define REP_BAR 1
#endif
#ifndef GEMM_ALIGN
#define GEMM_ALIGN true
#endif
#ifndef GEMM_SP2
#define GEMM_SP2 true
#endif
#ifndef REP_GEMM
#define REP_GEMM 1
#endif
#ifndef ATTN_NAIVE
#define ATTN_NAIVE 0
#endif
#ifndef REP_W
#define REP_W 1
#endif
#ifndef REP_LN
#define REP_LN 1
#endif
#ifndef REP_ATT
#define REP_ATT 1
#endif
#ifndef REP_SSD1
#define REP_SSD1 1
#endif
#ifndef REP_SSD3
#define REP_SSD3 1
#endif
#ifndef REP_SC
#define REP_SC 1
#endif
#ifndef PHASE_MASK
#define PHASE_MASK 0x1fff
#endif
#if ONE_LAUNCH && !defined(EMU)
#define IN(k) ((PHASE_MASK >> (((k) % PH_PER_LAYER))) & 1)
#define SEAM(k) do { if ((k) + 1 < N_PHASES) { XcdBarrier b_; b_.bar = (unsigned*)(ld_ws(P.ws) + WS_CTL) + 4096; b_.x = xb_xcc_id(); b_.st = (volatile LAS unsigned*)(lds + MISC_OFF) + 8; for (int rb_ = 0; rb_ < REP_BAR; ++rb_) xcd_barrier(b_); } } while (0)
#else
#define IN(k) (((PHASE_MASK >> (((k) % PH_PER_LAYER))) & 1) && P.ph_lo <= (k) && (k) < P.ph_hi)
#define SEAM(k) do { if (IN(k) && IN((k) + 1)) { XcdBarrier b_; b_.bar = (unsigned*)(ld_ws(P.ws) + WS_CTL) + 4096; b_.x = xb_xcc_id(); b_.st = (volatile LAS unsigned*)(lds + MISC_OFF) + 8; xcd_barrier(b_); } } while (0)
#endif
template <int L> DI void layer_program(const Params& P, LAS unsigned char* lds) {
    {
        constexpr int pb = L * PH_PER_LAYER;
#define WSP unsigned char* const ws = ld_ws(P.ws); (void)ws
#define GEMM_PHASE(EPI, A_, B_, N_, K_, ...) GEMM_PHASE_R(0, 0, EPI, A_, B_, N_, K_, __VA_ARGS__)
#define GEMM_PHASE_X(F8_, EPI, A_, B_, N_, K_, ...) GEMM_PHASE_R(F8_, 0, EPI, A_, B_, N_, K_, __VA_ARGS__)
#define GEMM_PHASE_R(F8_, ROT_, EPI, A_, B_, N_, K_, ...) do { pg8::Gemm g{(const bf16*)(A_), (const bf16*)(B_), M, (N_), (K_)}; int bid_ = blockIdx.x, gsz_ = ld_grid(); if (ROT_) bid_ = (bid_ + gsz_ / 2) % gsz_; OPAQUE_S(bid_); OPAQUE_S(gsz_); auto lds_ = lds; OPAQUE_S(lds_); pg8::StaticOrder S; S.init(M, (N_), gsz_, bid_); \
            EPI E{__VA_ARGS__}; for (int rep = 0; rep < REP_GEMM; ++rep) pg8::gemm_phase<EPI, pg8::StaticOrder, GEMM_ALIGN, GEMM_SP2, F8_>(lds_, g, S, E); } while (0)
        if (IN(pb + 0)) for (int rep = 0; rep < REP_W; ++rep) phase_weights(P.ws, L, lds, rep);
        SEAM(pb + 0);
        if (IN(pb + 1)) { WSP;
            if (QKV_FP8) { GEMM_PHASE_X(1, pg8::EpiBf16<2>, ws + WS_X8, ws + WS_WIN, NQKV, DM / 2, (bf16*)(ws + WS_BIG), NU);
                           if constexpr ((IN_INT8 >> L) & 1) GEMM_PHASE_R(2, 1, pg8::EpiI8<0>, ws + WS_X8I, ws + WS_WIN + WINB_OFF, NREST, DM / 2, (bf16*)(ws + WS_BIG) + NQKV, NU, (const float*)(ws + WS_SA), (const float*)(ws + WS_SWI));
                           else GEMM_PHASE_R(0, 1, pg8::EpiBf16<0>, ws + WS_XB, ws + WS_WIN + WINB_OFF, NREST, DM, (bf16*)(ws + WS_BIG) + NQKV, NU); }
            else GEMM_PHASE(pg8::EpiBf16<0>, ws + WS_XB, ws + WS_WIN, NU, DM, (bf16*)(ws + WS_BIG), NU); }
        SEAM(pb + 1);
        if (IN(pb + 2)) { phase_rope(P.ws, lds); for (int rm_ = 0; rm_ < REP_MISC; ++rm_) { phase_conv(P.ws, L, lds); WSP; GEMM_PHASE(pg8::EpiBf16<0>, (const bf16*)(ws + WS_PB) + (size_t)L * M * DPLE, ws + WS_WPE, DM, DPLE, (bf16*)(ws + WS_EMB), DM); } }
        SEAM(pb + 2);
        if (IN(pb + 3)) { for (int rep = 0; rep < REP_SSD1; ++rep) phase_ssd_states(P.ws, L, lds); for (int rep = 0; rep < REP_ATT; ++rep) { if (ATTN_NAIVE) phase_attn_naive(P.ws, lds); else phase_attn_mfma(P.ws, lds); } for (int rep = 0; rep < REP_SC; ++rep) phase_shortconv(P.ws, L, lds); }
        SEAM(pb + 3);
        if (IN(pb + 4)) { for (int rs_ = 0; rs_ < REP_SCAN; ++rs_) phase_ssd_scan(P.ws, rs_ + 1 < REP_SCAN); phase_attn_mix(P.ws); }
        SEAM(pb + 4);
        if (IN(pb + 5)) for (int rep = 0; rep < REP_SSD3; ++rep) phase_ssd_out(P.ws, L, lds);
        SEAM(pb + 5);
        if (IN(pb + 6)) { WSP; if (ATT_FP8) GEMM_PHASE_X(3, pg8::EpiBf16<0>, ws + WS_CAT, ws + WS_WOUT, DM, CAT_PITCH, (bf16*)(ws + WS_XF), DM);
            else GEMM_PHASE(pg8::EpiBf16<0>, ws + WS_CAT, ws + WS_WOUT, DM, DMIX, (bf16*)(ws + WS_XF), DM); }
        SEAM(pb + 6);
        if (IN(pb + 7)) for (int rep = 0; rep < REP_LN; ++rep) phase_resln<false>(P.ws, P.out, L, 0, lds, rep + 1 < REP_LN);
        SEAM(pb + 7);
        if (IN(pb + 8)) for (int r3_ = 0; r3_ < REP_G3; ++r3_) { WSP; if constexpr ((UP_INT8 >> L) & 1) GEMM_PHASE_X(2, pg8::EpiI8<1>, ws + WS_X8, ws + WS_WUP, DFF, DM / 2, (bf16*)(ws + WS_BIG), DFF, (const float*)(ws + WS_SA), (const float*)(ws + WS_SW));
            else GEMM_PHASE(pg8::EpiBf16<1>, ws + WS_XB, ws + WS_WUP, DFF, DM, (bf16*)(ws + WS_BIG), DFF); }
        SEAM(pb + 8);
        if (IN(pb + 9)) for (int r4_ = 0; r4_ < REP_G4; ++r4_) { WSP; GEMM_PHASE(pg8::EpiBf16<0>, ws + WS_BIG, ws + WS_WDN, DM, DFF, (bf16*)(ws + WS_XF), DM); }
        SEAM(pb + 9);
        if (IN(pb + 10)) for (int rep = 0; rep < REP_LN; ++rep) phase_resln<false>(P.ws, P.out, L, 1, lds, rep + 1 < REP_LN);
        SEAM(pb + 10);
        if (IN(pb + 11)) { WSP; if (GATE_INT8) GEMM_PHASE_X(2, pg8::EpiI8<0>, ws + WS_X8, ws + WS_WGT, DM, DM / 2, (bf16*)(ws + WS_XF), DM, (const float*)(ws + WS_SA), (const float*)(ws + WS_SWG));
            else if (GATE_FP8) GEMM_PHASE_X(true, pg8::EpiBf16<2>, ws + WS_X8, ws + WS_WGT, DM, DM / 2, (bf16*)(ws + WS_XF), DM);
            else GEMM_PHASE(pg8::EpiBf16<0>, ws + WS_XB, ws + WS_WGT, DM, DM, (bf16*)(ws + WS_XF), DM); }
        SEAM(pb + 11);
        if (IN(pb + 12)) for (int rep = 0; rep < REP_LN; ++rep) phase_resln<true>(P.ws, P.out, L, 2, lds, rep + 1 < REP_LN);
        SEAM(pb + 12);
#undef WSP
#undef GEMM_PHASE
#undef GEMM_PHASE_X
#undef GEMM_PHASE_R
    }
}
#undef IN
#undef SEAM

__global__ void __launch_bounds__(512, 2) hymba_fwd(Params P) {
#ifdef EMU
    unsigned char* lds = emu::lds_base();
#else
    extern __shared__ __attribute__((aligned(16))) unsigned char lds_raw[];
    LAS unsigned char* lds = (LAS unsigned char*)lds_raw;
#endif
    volatile LAS unsigned* MISC = (volatile LAS unsigned*)(lds + MISC_OFF);
    for (int u = threadIdx.x; u < 64; u += 512) MISC[u] = 0u;
    { LAS unsigned long long* pt = (LAS unsigned long long*)(lds + PTAB_OFF);
#pragma unroll
      for (int i = 0; i < 21; ++i) if (threadIdx.x == i) pt[i] = (unsigned long long)(size_t)P.in[i]; }
    __syncthreads();
    if ((P.ph_hi - P.ph_lo) > 1) (void)xcd_barrier_post((unsigned*)(P.ws + WS_CTL) + 4096, MISC + 8);
    layer_program<0>(P, lds);
    layer_program<1>(P, lds);
    static_assert(DEPTH == 2, "layer_program instantiations");

}

extern "C" void kernel_launch(void* const* d_in, const int* in_sizes, int n_in, void* d_out, int out_size, void* d_ws, size_t ws_size, hipStream_t stream) {
    static int grid = 0;
    if (grid == 0) {
        if (n_in != 21 || ws_size < WS_END) { fprintf(stderr, "kernel_launch: expected 21 inputs and >= %zu bytes of workspace; got %d inputs, %zu bytes\n", (size_t)WS_END, n_in, ws_size); grid = -1; return; }
        int dev = 0, cus = 0, per_cu = 0;
        if (hipGetDevice(&dev) != hipSuccess || hipDeviceGetAttribute(&cus, hipDeviceAttributeMultiprocessorCount, dev) != hipSuccess) { grid = -1; return; }
        if (hipFuncSetAttribute((const void*)hymba_fwd, hipFuncAttributeMaxDynamicSharedMemorySize, LDS_BYTES) != hipSuccess) { fprintf(stderr, "kernel_launch: hipFuncSetAttribute failed\n"); grid = -1; return; }
        if (hipOccupancyMaxActiveBlocksPerMultiprocessor(&per_cu, (const void*)hymba_fwd, 512, LDS_BYTES) != hipSuccess || per_cu < 1) fprintf(stderr, "kernel_launch: occupancy query reports %d\n", per_cu);
        (void)hipGetLastError();
        grid = cus;
    }
    if (grid < 0) return;
    (void)in_sizes; (void)out_size;
    hipMemsetAsync((char*)d_ws + WS_CTL, 0, CTL_BYTES, stream);
    Params p{};
    for (int i = 0; i < 21; ++i) p.in[i] = (const float*)d_in[i];
    p.out = (float*)d_out; p.ws = (unsigned char*)d_ws; p.grid = grid; p.pad = 0;
#if ONE_LAUNCH
    p.ph_lo = 0; p.ph_hi = N_PHASES;
    hipLaunchKernelGGL(hymba_fwd, dim3(grid), dim3(512), LDS_BYTES, stream, p);
#else
    for (int k = 0; k < N_PHASES; ++k) { p.ph_lo = k; p.ph_hi = k + 1; hipLaunchKernelGGL(hymba_fwd, dim3(grid), dim3(512), LDS_BYTES, stream, p); }
#endif
}
```
